# Optimizing an MI355X kernel written in HIP

```python
import jax, jax.numpy as jnp
from jax import lax
import numpy as np

D_MODEL = 1024
BATCH = 8
SEQ = 8192
DEPTH = 4

CHUNK = 64
N_MIXERS = 2
LRU_WIDTH = D_MODEL
LRU_BLOCKS = 8
LRU_BLOCK = LRU_WIDTH // LRU_BLOCKS
CONV_WIDTH = 4
LRU_C = 8.0
FOX_HEADS = 16
FOX_HEAD_DIM = D_MODEL // FOX_HEADS
Q_BLOCK = 2 * CHUNK
D_FF = 7 * D_MODEL // 2
N_EXPERTS = 8
TOP_K = 2
RMS_EPS = 1e-6
N_LRU = (DEPTH + 1) // 2
N_FOX = DEPTH // 2
N_DENSE = (DEPTH + 1) // 2
N_MOE = DEPTH // 2

kernel_name = "hybrid_rglru_fox_moe_trunk"


def rms_norm(x, g):
    xf = x.astype(jnp.float32)
    y = xf * lax.rsqrt(jnp.mean(xf * xf, axis=-1, keepdims=True) + RMS_EPS)
    return (y * g.astype(jnp.float32)).astype(x.dtype)


def _lin_combine(c1, c2):
    a1, b1 = c1
    a2, b2 = c2
    return a1 * a2, a2 * b1 + b2


def rg_lru_mixer(h, w_in, conv_w, conv_b, w_a, b_a, w_x, b_x, log_lambda, w_out):
    B, S, _ = h.shape
    proj = h @ w_in
    y_branch, x_branch = jnp.split(proj, 2, axis=-1)
    y_branch = jax.nn.gelu(y_branch)
    xc = lax.conv_general_dilated(
        x_branch, conv_w[:, None, :].astype(x_branch.dtype), window_strides=(1,),
        padding=[(CONV_WIDTH - 1, 0)], dimension_numbers=('NWC', 'WIO', 'NWC'),
        feature_group_count=LRU_WIDTH) + conv_b
    xb = xc.reshape(B, S, LRU_BLOCKS, LRU_BLOCK)
    r = jax.nn.sigmoid(jnp.einsum('bshi,hij->bshj', xb, w_a).reshape(B, S, LRU_WIDTH) + b_a)
    gi = jax.nn.sigmoid(jnp.einsum('bshi,hij->bshj', xb, w_x).reshape(B, S, LRU_WIDTH) + b_x)
    log_a = -LRU_C * r.astype(jnp.float32) * jax.nn.softplus(-log_lambda.astype(jnp.float32))
    a = jnp.exp(log_a)
    mult = jnp.sqrt(-jnp.expm1(2.0 * log_a))
    b = mult * (gi * xc).astype(jnp.float32)
    _, hseq = lax.associative_scan(_lin_combine, (a, b), axis=1)
    return (hseq.astype(h.dtype) * y_branch) @ w_out


def fox_mixer(h, w_in, b_f, q_gain, k_gain, w_out):
    B, S, D = h.shape
    proj = h @ w_in
    q, k, v, g, f = jnp.split(proj, [D, 2 * D, 3 * D, 4 * D], axis=-1)
    q = rms_norm(q.reshape(B, S, FOX_HEADS, FOX_HEAD_DIM), q_gain)
    k = rms_norm(k.reshape(B, S, FOX_HEADS, FOX_HEAD_DIM), k_gain)
    v = v.reshape(B, S, FOX_HEADS, FOX_HEAD_DIM)
    log_f = jax.nn.log_sigmoid(f.astype(jnp.float32) + b_f.astype(jnp.float32))
    F = jnp.cumsum(log_f, axis=1).transpose(0, 2, 1)
    qh = q.transpose(0, 2, 1, 3)
    kh = k.transpose(0, 2, 1, 3)
    vh = v.transpose(0, 2, 1, 3)
    nb = S // Q_BLOCK
    q_blocks = qh.reshape(B, FOX_HEADS, nb, Q_BLOCK, FOX_HEAD_DIM).transpose(2, 0, 1, 3, 4)
    F_blocks = F.reshape(B, FOX_HEADS, nb, Q_BLOCK).transpose(2, 0, 1, 3)
    key_pos = jnp.arange(S)
    scale = FOX_HEAD_DIM ** -0.5

    def attend(args):
        qb, Fq, blk = args
        s = jnp.einsum('bhqd,bhkd->bhqk', qb, kh, preferred_element_type=jnp.float32) * scale
        s = s + Fq[..., None] - F[:, :, None, :]
        q_pos = blk * Q_BLOCK + jnp.arange(Q_BLOCK)
        s = jnp.where(key_pos[None, :] <= q_pos[:, None], s, -jnp.inf)
        p = jax.nn.softmax(s, axis=-1)
        return jnp.einsum('bhqk,bhkd->bhqd', p.astype(vh.dtype), vh)

    o = lax.map(attend, (q_blocks, F_blocks, jnp.arange(nb)))
    o = o.transpose(1, 0, 3, 2, 4).reshape(B, S, D)
    o = o * jax.nn.sigmoid(g)
    return o @ w_out


def swiglu(h, w_gate, w_up, w_down):
    return (jax.nn.silu(h @ w_gate) * (h @ w_up)) @ w_down


def moe_swiglu(h, router, w_gate, w_up, w_down):
    B, S, D = h.shape
    t = h.reshape(B * S, D)
    logits = (t @ router).astype(jnp.float32)
    top_v, top_i = lax.top_k(logits, TOP_K)
    w = jax.nn.softmax(top_v, axis=-1)
    combine = jnp.sum(jax.nn.one_hot(top_i, N_EXPERTS, dtype=jnp.float32) * w[..., None], axis=1)
    out = jnp.zeros_like(t)
    for e in range(N_EXPERTS):
        out = out + combine[:, e:e + 1].astype(t.dtype) * swiglu(t, w_gate[e], w_up[e], w_down[e])
    return out.reshape(B, S, D)


def setup_inputs(seed: int = 0) -> dict:
    key = jax.random.key(seed)
    ks = jax.random.split(key, 24)
    f32 = jnp.float32
    nrm = lambda k, shape, s: jax.random.normal(k, shape, f32) * s
    D = D_MODEL
    u = jax.random.uniform(ks[8], (N_LRU, LRU_WIDTH), f32, minval=0.9, maxval=0.999)
    a0 = u ** (1.0 / LRU_C)
    log_lambda = jnp.log(a0) - jnp.log1p(-a0)
    return {
        "x": nrm(ks[0], (BATCH, SEQ, D), 1.0),
        "norm_mix": 1.0 + nrm(ks[1], (DEPTH, D), 0.01),
        "norm_ffn": 1.0 + nrm(ks[2], (DEPTH, D), 0.01),
        "lru_w_in": nrm(ks[3], (N_LRU, D, 2 * LRU_WIDTH), D ** -0.5),
        "lru_conv_w": nrm(ks[4], (N_LRU, CONV_WIDTH, LRU_WIDTH), CONV_WIDTH ** -0.5),
        "lru_conv_b": nrm(ks[5], (N_LRU, LRU_WIDTH), 0.01),
        "lru_w_a": nrm(ks[6], (N_LRU, LRU_BLOCKS, LRU_BLOCK, LRU_BLOCK), LRU_BLOCK ** -0.5),
        "lru_b_a": nrm(ks[7], (N_LRU, LRU_WIDTH), 0.01),
        "lru_w_x": nrm(ks[9], (N_LRU, LRU_BLOCKS, LRU_BLOCK, LRU_BLOCK), LRU_BLOCK ** -0.5),
        "lru_b_x": nrm(ks[10], (N_LRU, LRU_WIDTH), 0.01),
        "lru_log_lambda": log_lambda,
        "lru_w_out": nrm(ks[11], (N_LRU, LRU_WIDTH, D), LRU_WIDTH ** -0.5),
        "fox_w_in": nrm(ks[12], (N_FOX, D, 4 * D + FOX_HEADS), D ** -0.5),
        "fox_b_f": jax.random.uniform(ks[13], (N_FOX, FOX_HEADS), f32, minval=1.0, maxval=6.0),
        "fox_q_gain": 1.0 + nrm(ks[14], (N_FOX, FOX_HEAD_DIM), 0.01),
        "fox_k_gain": 1.0 + nrm(ks[15], (N_FOX, FOX_HEAD_DIM), 0.01),
        "fox_w_out": nrm(ks[16], (N_FOX, D, D), D ** -0.5),
        "ffn_w_gate": nrm(ks[17], (N_DENSE, D, D_FF), D ** -0.5),
        "ffn_w_up": nrm(ks[18], (N_DENSE, D, D_FF), D ** -0.5),
        "ffn_w_down": nrm(ks[19], (N_DENSE, D_FF, D), D_FF ** -0.5),
        "moe_router": nrm(ks[20], (N_MOE, D, N_EXPERTS), D ** -0.5),
        "moe_w_gate": nrm(ks[21], (N_MOE, N_EXPERTS, D, D_FF), D ** -0.5),
        "moe_w_up": nrm(ks[22], (N_MOE, N_EXPERTS, D, D_FF), D ** -0.5),
        "moe_w_down": nrm(ks[23], (N_MOE, N_EXPERTS, D_FF, D), D_FF ** -0.5),
    }


def reference(x, norm_mix, norm_ffn, lru_w_in, lru_conv_w, lru_conv_b, lru_w_a, lru_b_a,
              lru_w_x, lru_b_x, lru_log_lambda, lru_w_out, fox_w_in, fox_b_f, fox_q_gain,
              fox_k_gain, fox_w_out, ffn_w_gate, ffn_w_up, ffn_w_down, moe_router,
              moe_w_gate, moe_w_up, moe_w_down):
    for i in range(DEPTH):
        j = i // 2
        hn = rms_norm(x, norm_mix[i])
        if i % N_MIXERS == 0:
            x = x + rg_lru_mixer(hn, lru_w_in[j], lru_conv_w[j], lru_conv_b[j], lru_w_a[j],
                                 lru_b_a[j], lru_w_x[j], lru_b_x[j], lru_log_lambda[j], lru_w_out[j])
        else:
            x = x + fox_mixer(hn, fox_w_in[j], fox_b_f[j], fox_q_gain[j], fox_k_gain[j], fox_w_out[j])
        hn = rms_norm(x, norm_ffn[i])
        if i % 2 == 0:
            x = x + swiglu(hn, ffn_w_gate[j], ffn_w_up[j], ffn_w_down[j])
        else:
            x = x + moe_swiglu(hn, moe_router[j], moe_w_gate[j], moe_w_up[j], moe_w_down[j])
    return x
```

```cpp
#include <hip/hip_runtime.h>
#include <cstdio>
#include <cstdint>

#ifndef MK_PER_PHASE
#define MK_PER_PHASE 0
#endif

constexpr int BATCH = 8, SEQ = 8192, D = 1024, T = BATCH * SEQ, NH = 16, HD = 64, FF = 3584, NE = 8;
constexpr int NWAVES = 8;
constexpr float RMS_EPS = 1e-6f;
constexpr float LOG2E = 1.4426950408889634f;

#define GAS __attribute__((address_space(1)))
#define LAS __attribute__((address_space(3)))
typedef unsigned short bf16;
typedef unsigned v4u __attribute__((ext_vector_type(4)));
typedef unsigned v2u __attribute__((ext_vector_type(2)));
typedef float f32x4 __attribute__((ext_vector_type(4)));
typedef float f32x2 __attribute__((ext_vector_type(2)));
typedef float f32x16 __attribute__((ext_vector_type(16)));
typedef short bf16x8 __attribute__((ext_vector_type(8)));
typedef short s16x4 __attribute__((ext_vector_type(4)));
typedef GAS unsigned gu32;
#define RLX_AGENT __ATOMIC_RELAXED, __HIP_MEMORY_SCOPE_AGENT
#define LDS_WAIT() asm volatile("s_waitcnt lgkmcnt(0)" ::: "memory")
#define VM_WAIT() asm volatile("s_waitcnt vmcnt(0)" ::: "memory")

__device__ __forceinline__ unsigned f2bf(float f) { unsigned u = __builtin_bit_cast(unsigned, f); return (u + 0x7fffu + ((u >> 16) & 1u)) >> 16; }
__device__ __forceinline__ unsigned pk2(float lo, float hi) { unsigned r; asm("v_cvt_pk_bf16_f32 %0, %1, %2" : "=v"(r) : "v"(lo), "v"(hi)); return r; }
__device__ __forceinline__ float bflo(unsigned w) { return __builtin_bit_cast(float, w << 16); }
__device__ __forceinline__ float bfhi(unsigned w) { return __builtin_bit_cast(float, w & 0xffff0000u); }
__device__ __forceinline__ unsigned cvt_pk_bf16(float lo, float hi) { unsigned r; asm volatile("v_cvt_pk_bf16_f32 %0, %1, %2" : "=v"(r) : "v"(lo), "v"(hi)); return r; }
typedef unsigned short xr_t;
__device__ __forceinline__ void xr_unpack8(const v4u& r, f32x4& a, f32x4& b) {
    a[0] = __uint_as_float(r.x << 16); a[1] = __uint_as_float(r.x & 0xffff0000u); a[2] = __uint_as_float(r.y << 16); a[3] = __uint_as_float(r.y & 0xffff0000u);
    b[0] = __uint_as_float(r.z << 16); b[1] = __uint_as_float(r.z & 0xffff0000u); b[2] = __uint_as_float(r.w << 16); b[3] = __uint_as_float(r.w & 0xffff0000u); }
__device__ __forceinline__ v4u xr_pack8(const f32x4& a, const f32x4& b) { v4u w; w.x = cvt_pk_bf16(a[0], a[1]); w.y = cvt_pk_bf16(a[2], a[3]); w.z = cvt_pk_bf16(b[0], b[1]); w.w = cvt_pk_bf16(b[2], b[3]); return w; }
__device__ __forceinline__ float fast_exp2(float x) { return __builtin_amdgcn_exp2f(x); }
__device__ __forceinline__ float fast_rcp(float x) { return __builtin_amdgcn_rcpf(x); }
__device__ __forceinline__ float sigmoidf_(float x) { return fast_rcp(1.0f + fast_exp2(-x * LOG2E)); }
__device__ __forceinline__ float q8(float x, float sc) { const float y = fminf(fmaxf(x * sc, -448.f), 448.f); const int p = __builtin_amdgcn_cvt_pk_fp8_f32(y, y, 0, false); return __builtin_amdgcn_cvt_f32_fp8(p, 0) * (1.0f / sc); }
__device__ __forceinline__ unsigned pack4_fp8(float a, float b, float c, float d, float sc) {
    a = fminf(fmaxf(a * sc, -448.f), 448.f); b = fminf(fmaxf(b * sc, -448.f), 448.f); c = fminf(fmaxf(c * sc, -448.f), 448.f); d = fminf(fmaxf(d * sc, -448.f), 448.f);
    int p = __builtin_amdgcn_cvt_pk_fp8_f32(a, b, 0, false); p = __builtin_amdgcn_cvt_pk_fp8_f32(c, d, p, true); return (unsigned)p;
}
#ifndef EMU_FP8
#define EMU_FP8 0
#endif
#ifndef FP8_LRUIN_J1
#define FP8_LRUIN_J1 1
#endif
#ifndef FP8_FOXIN_J0
#define FP8_FOXIN_J0 1
#endif
#ifndef FP8_FOXIN_J1
#define FP8_FOXIN_J1 1
#endif
#ifndef FP8_L2_FFN
#define FP8_L2_FFN 1
#endif
#ifndef FP8_MOE_J0
#define FP8_MOE_J0 1
#endif
#ifndef MOE_OVERLAP
#define MOE_OVERLAP 1
#endif
#ifndef FP8_LAST_MOE
#define FP8_LAST_MOE 1
#endif
__device__ __forceinline__ float wave_sum(float v) {
#pragma unroll
    for (int o = 1; o < 64; o <<= 1) v += __shfl_xor(v, o);
    return v;
}

namespace pg8 {
#define PG8_LAS __attribute__((address_space(3)))
constexpr int BM = 256, BK = 64, HALF = 128, HTB = HALF * BK * 2, STAGE_BYTES = 8 * HTB, NXCD = 8, WGM = 8;
__host__ __device__ __forceinline__ int lds_byte(int r, int c) { const int st = (r >> 4) * 2 + (c >> 5), rr = r & 15, cc = c & 31, ob = rr * 64 + cc * 2; return st * 1024 + (ob ^ (((ob >> 9) & 1) << 5)); }
__host__ __device__ __forceinline__ void stage_rc(int b, int& R, int& C) { const int st = b / 1024, sb = b % 1024, swz = sb ^ (((sb >> 9) & 1) << 5); R = (st >> 1) * 16 + swz / 64; C = (st & 1) * 32 + (swz % 64) / 2; }
__host__ __device__ __forceinline__ int perm32(int rho) { const int n = rho >> 4, i = rho & 15; return 8 * (i >> 2) + 4 * n + (i & 3); }

typedef int v8i_t __attribute__((ext_vector_type(8)));
typedef int v4i_t __attribute__((ext_vector_type(4)));
__device__ __forceinline__ v8i_t cat8(bf16x8 lo, bf16x8 hi) { const v4i_t a = __builtin_bit_cast(v4i_t, lo), b = __builtin_bit_cast(v4i_t, hi); return __builtin_shufflevector(a, b, 0, 1, 2, 3, 4, 5, 6, 7); }
struct Unit { int pm, pn; };
struct StaticOrder {
    int nM, nN, nwg, G, c, isp, csk;
    __device__ void init(int nM_, int nN_, int G_, int c_) { nM = nM_; nN = nN_; nwg = nM * nN; G = G_; c = c_; isp = 0x7fffffff; csk = 0; }
    __device__ void split(int isp_, int csk_) { isp = isp_; csk = csk_; }
    __device__ bool next(int i, Unit& u) const {
        long L;
        if (i < isp) L = (long)i * G + c; else { if (c < csk) return false; L = (long)isp * G + (long)(i - isp) * (G - csk) + (c - csk); }
        if (L >= nwg) return false;
        int wgid = (int)L; { const int q = nwg / NXCD, r = nwg % NXCD, xcd = wgid % NXCD, off = wgid / NXCD; wgid = (xcd < r ? xcd * (q + 1) : r * (q + 1) + (xcd - r) * q) + off; }
        const int nig = WGM * nN, gid = wgid / nig, fm = gid * WGM, gsz = (nM - fm) < WGM ? (nM - fm) : WGM;
        u.pm = fm + ((wgid % nig) % gsz); u.pn = (wgid % nig) / gsz; return true;
    }
};

template <bool GATHER_, bool EXPERT_, bool FP8_ = false> struct GemmT {
    static constexpr bool GATHER = GATHER_, EXPERT = EXPERT_, FP8 = FP8_;
    const bf16* A; const bf16* Bt; int lda, ldb, nt;
    long a_pn, b_pn;
    const unsigned* list;
    const unsigned* tile_e; long b_e;
    int scA = 0x7f7f7f7f, scB = 0x7f7f7f7f;
    __device__ __forceinline__ const char* a_tile(const Unit& u) const { return (const char*)(A + (GATHER ? 0 : (size_t)u.pm * BM * lda) + (size_t)u.pn * a_pn); }
    __device__ __forceinline__ const char* b_tile(const Unit& u) const {
        size_t off = (size_t)u.pn * b_pn;
        if (EXPERT) { const unsigned e = (unsigned)__builtin_amdgcn_readfirstlane((int)__hip_atomic_load(tile_e + u.pm, RLX_AGENT)); off += (size_t)e * b_e; }
        return (const char*)(Bt + off);
    }
    __device__ __forceinline__ void a_voff(const Unit& u, const int (&sR)[2], const int (&sC)[2], unsigned (&vo)[2][2]) const {
        if (GATHER) {
            unsigned idx[2][2];
#pragma unroll
            for (int h = 0; h < 2; ++h)
#pragma unroll
                for (int i = 0; i < 2; ++i) idx[h][i] = list[u.pm * BM + h * HALF + sR[i]];
            asm volatile("s_waitcnt vmcnt(0)" ::: "memory");
#pragma unroll
            for (int h = 0; h < 2; ++h)
#pragma unroll
                for (int i = 0; i < 2; ++i) vo[h][i] = ((idx[h][i] & 0xffffu) * (unsigned)lda + (unsigned)sC[i]) * 2u;
        } else {
#pragma unroll
            for (int h = 0; h < 2; ++h)
#pragma unroll
                for (int i = 0; i < 2; ++i) vo[h][i] = (unsigned)((h * HALF + sR[i]) * lda + sC[i]) * 2u;
        }
    }
};

template <class Epi, class Sched, class GD, bool ALIGN_EPI>
__device__ __forceinline__ void gemm_phase(PG8_LAS unsigned char* lds, const GD& g, const Sched& S, const Epi& E) {
    int tid = threadIdx.x; asm volatile("" : "+v"(tid));
    const int wid = __builtin_amdgcn_readfirstlane(tid >> 6), lane = tid & 63, wr = wid >> 2, wc = wid & 3, fr = lane & 15, fq = lane >> 4;
    int nt = g.nt; asm volatile("" : "+s"(nt));
    int sR[2], sC[2]; unsigned voffB[2];
#pragma unroll
    for (int i = 0; i < 2; ++i) { int R, C; stage_rc(tid * 16 + i * 8192, R, C); sR[i] = R; sC[i] = C; const int Rb = Epi::PERM ? ((R & ~31) + perm32(R & 31)) : R;
        voffB[i] = (unsigned)(Rb * g.ldb + C) * 2u; }
    const size_t kstep = (size_t)(BK * 2);
    const size_t hstepB = (size_t)HALF * g.ldb * 2;
    const size_t hstepA = (size_t)HALF * g.lda * 2;
    unsigned voffA[2];
#pragma unroll
    for (int i = 0; i < 2; ++i) voffA[i] = (unsigned)(sR[i] * g.lda + sC[i]) * 2u;
    const unsigned ldsw = (unsigned)wid * 1024u;
    const int aoff = lds_byte(wr * 64 + fr, fq * 8), boff = lds_byte(wc * 32 + fr, fq * 8);
#define PG8_SA(b, h) (((b) * 2 + (h)) * HTB)
#define PG8_SB(b, h) ((4 + (b) * 2 + (h)) * HTB)
#define PG8_STAGE(bufoff, gbase, voff) do { _Pragma("unroll") for (int _i = 0; _i < 2; ++_i) \
        __builtin_amdgcn_global_load_lds((const unsigned*)((const char*)(gbase) + (voff)[_i]), (PG8_LAS unsigned*)(lds + (bufoff) + ldsw + _i * 8192), 16, 0, 0); } while (0)
#define PG8_STAGE_A(bufoff, gbase, h, VA) do { if constexpr (GD::GATHER) { PG8_STAGE(bufoff, gbase, VA[h]); } else { PG8_STAGE(bufoff, (gbase) + (h) * hstepA, voffA); } } while (0)
#define PG8_LDA(dst, b, h) do { _Pragma("unroll") for (int m = 0; m < 4; ++m) _Pragma("unroll") for (int k = 0; k < 2; ++k) dst[m][k] = *(const PG8_LAS bf16x8*)(lds + PG8_SA(b, h) + aoff + m * 2048 + k * 1024); } while (0)
#define PG8_LDB(dst, b, h) do { _Pragma("unroll") for (int n = 0; n < 2; ++n) _Pragma("unroll") for (int k = 0; k < 2; ++k) dst[n][k] = *(const PG8_LAS bf16x8*)(lds + PG8_SB(b, h) + boff + n * 2048 + k * 1024); } while (0)
#define PG8_MMA(ai, bj, At, Bt) do { __builtin_amdgcn_s_setprio(1); \
        if constexpr (GD::FP8) { _Pragma("unroll") for (int m = 0; m < 4; ++m) _Pragma("unroll") for (int n = 0; n < 2; ++n) \
            asm volatile("v_mfma_scale_f32_16x16x128_f8f6f4 %0, %1, %2, %0, %3, %4 op_sel_hi:[0,0,0]" : "+v"(acc[ai][bj][m][n]) : "v"(cat8(Bt[n][0], Bt[n][1])), "v"(cat8(At[m][0], At[m][1])), "v"(vscB), "v"(vscA)); } \
        else { _Pragma("unroll") for (int m = 0; m < 4; ++m) _Pragma("unroll") for (int n = 0; n < 2; ++n) _Pragma("unroll") for (int k = 0; k < 2; ++k) \
            acc[ai][bj][m][n] = __builtin_amdgcn_mfma_f32_16x16x32_bf16(Bt[n][k], At[m][k], acc[ai][bj][m][n], 0, 0, 0); } \
        __builtin_amdgcn_s_setprio(0); } while (0)
#define PG8_WAIT_V(n) asm volatile("s_waitcnt vmcnt(" #n ")" ::: "memory")
#define PG8_WAIT_L(n) asm volatile("s_waitcnt lgkmcnt(" #n ")" ::: "memory")
#define PG8_BAR __builtin_amdgcn_s_barrier()
#define PG8_SCHED __builtin_amdgcn_sched_barrier(0)
    Unit cur, nxt; int ui = 0;
    if (!S.next(0, cur)) return;
    int vscA = g.scA, vscB = g.scB; asm volatile("" : "+v"(vscA), "+v"(vscB));
    f32x4 acc[2][2][4][2];
#pragma unroll
    for (int a = 0; a < 2; ++a)
#pragma unroll
        for (int b = 0; b < 2; ++b)
#pragma unroll
            for (int m = 0; m < 4; ++m)
#pragma unroll
                for (int n = 0; n < 2; ++n) acc[a][b][m][n] = (f32x4){0.f, 0.f, 0.f, 0.f};
    bf16x8 At[4][2], B0[2][2], B1[2][2];
    const char* cA = g.a_tile(cur); const char* cB = g.b_tile(cur);
    unsigned vAc[2][2], vAn[2][2];
    if constexpr (GD::GATHER) g.a_voff(cur, sR, sC, vAc);
    else {
#pragma unroll
        for (int h = 0; h < 2; ++h)
#pragma unroll
            for (int i = 0; i < 2; ++i) vAc[h][i] = 0u;
    }
#pragma unroll
    for (int h = 0; h < 2; ++h)
#pragma unroll
        for (int i = 0; i < 2; ++i) vAn[h][i] = vAc[h][i];
    PG8_STAGE(PG8_SB(0, 0), cB, voffB); PG8_STAGE(PG8_SB(0, 1), cB + hstepB, voffB); PG8_STAGE_A(PG8_SA(0, 0), cA, 0, vAc); PG8_STAGE_A(PG8_SA(0, 1), cA, 1, vAc);
    if (wr == 1) PG8_BAR;
    PG8_WAIT_V(2); PG8_BAR;
    PG8_STAGE(PG8_SB(1, 0), cB + kstep, voffB); PG8_STAGE_A(PG8_SA(1, 0), cA + kstep, 0, vAc); PG8_STAGE(PG8_SB(1, 1), cB + hstepB + kstep, voffB);
    PG8_WAIT_V(6); PG8_BAR;
    for (;;) {
        const bool has_next = S.next(ui + 1, nxt);
        const char* nA = has_next ? g.a_tile(nxt) : cA; const char* nB = has_next ? g.b_tile(nxt) : cB;
        for (int t = 0; t < nt; t += 2) {
            const bool last = (t == nt - 2);
            const char* a1 = cA + (size_t)(t + 1) * kstep;
            const char* a2 = last ? nA : cA + (size_t)(t + 2) * kstep; const char* b2 = last ? nB : cB + (size_t)(t + 2) * kstep;
            const char* a3 = a2 + kstep; const char* b3 = b2 + kstep;
            if (GD::GATHER && last && has_next) g.a_voff(nxt, sR, sC, vAn);
            PG8_LDB(B0, 0, 0); PG8_LDB(B1, 0, 1); PG8_SCHED; PG8_LDA(At, 0, 0); PG8_STAGE_A(PG8_SA(1, 1), a1, 1, vAc);
            PG8_WAIT_V(8); PG8_WAIT_L(0); PG8_BAR; PG8_MMA(0, 0, At, B0); PG8_MMA(0, 1, At, B1); PG8_BAR; PG8_SCHED;
            PG8_LDA(At, 0, 1); PG8_STAGE(PG8_SB(0, 0), b2, voffB); PG8_STAGE(PG8_SB(0, 1), b2 + hstepB, voffB); PG8_STAGE_A(PG8_SA(0, 0), a2, 0, vAn);
            PG8_WAIT_V(8); PG8_WAIT_L(0); PG8_BAR; PG8_MMA(1, 0, At, B0); PG8_MMA(1, 1, At, B1); PG8_BAR; PG8_SCHED;
            PG8_LDB(B0, 1, 0); PG8_LDB(B1, 1, 1); PG8_SCHED; PG8_LDA(At, 1, 0); PG8_STAGE_A(PG8_SA(0, 1), a2, 1, vAn);
            PG8_WAIT_V(8); PG8_WAIT_L(0); PG8_BAR; PG8_MMA(0, 0, At, B0); PG8_MMA(0, 1, At, B1); PG8_BAR; PG8_SCHED;
            PG8_LDA(At, 1, 1); PG8_STAGE(PG8_SB(1, 0), b3, voffB); PG8_STAGE(PG8_SB(1, 1), b3 + hstepB, voffB); PG8_STAGE_A(PG8_SA(1, 0), a3, 0, vAn);
            PG8_WAIT_V(8); PG8_WAIT_L(0); PG8_BAR; PG8_MMA(1, 0, At, B0); PG8_MMA(1, 1, At, B1); PG8_BAR; PG8_SCHED;
        }
        if constexpr (ALIGN_EPI) { if (wr == 0) PG8_BAR; }
        if constexpr (GD::FP8) asm volatile("s_nop 15\n\ts_nop 7" ::: "memory");
        E(acc, cur, wr, wc, fr, fq);
        if (!has_next) break;
#pragma unroll
        for (int a = 0; a < 2; ++a)
#pragma unroll
            for (int b = 0; b < 2; ++b)
#pragma unroll
                for (int m = 0; m < 4; ++m)
#pragma unroll
                    for (int n = 0; n < 2; ++n) acc[a][b][m][n] = (f32x4){0.f, 0.f, 0.f, 0.f};
        cur = nxt; cA = nA; cB = nB; ++ui;
#pragma unroll
        for (int h = 0; h < 2; ++h)
#pragma unroll
            for (int i = 0; i < 2; ++i) vAc[h][i] = vAn[h][i];
        if constexpr (ALIGN_EPI) { if (wr == 1) PG8_BAR; }
    }
    PG8_WAIT_V(0);
    if constexpr (!ALIGN_EPI) { if (wr == 0) PG8_BAR; }
    PG8_BAR;
#undef PG8_SA
#undef PG8_SB
#undef PG8_STAGE
#undef PG8_STAGE_A
#undef PG8_LDA
#undef PG8_LDB
#undef PG8_MMA
#undef PG8_WAIT_V
#undef PG8_WAIT_L
#undef PG8_BAR
#undef PG8_SCHED
}

__device__ __forceinline__ float gelu_tanh(float v) { const float z2 = (2.0f * 0.7978845608028654f * LOG2E) * (v + 0.044715f * v * v * v); return v * fast_rcp(1.0f + fast_exp2(-z2)); }

constexpr int XCH_OFF = 131072 + 1024;
__device__ __forceinline__ float row_rs(const float* ssp, int row, int fq) {
    float p = ssp[(size_t)fq * T + row]; p += __shfl_xor(p, 16); p += __shfl_xor(p, 32);
    return __builtin_amdgcn_rsqf(p * (1.0f / D) + RMS_EPS);
}
__device__ __forceinline__ void row_rs8(const float* ssp, int row0, int fq, float (&rs)[2][4]) {
    if (!ssp) {
#pragma unroll
        for (int ai = 0; ai < 2; ++ai)
#pragma unroll
            for (int m = 0; m < 4; ++m) rs[ai][m] = 1.0f;
        return; }
    float p[2][4];
#pragma unroll
    for (int ai = 0; ai < 2; ++ai)
#pragma unroll
        for (int m = 0; m < 4; ++m) p[ai][m] = ssp[(size_t)fq * T + row0 + ai * HALF + m * 16];
#pragma unroll
    for (int ai = 0; ai < 2; ++ai)
#pragma unroll
        for (int m = 0; m < 4; ++m) { float q = p[ai][m]; q += __shfl_xor(q, 16); q += __shfl_xor(q, 32); rs[ai][m] = __builtin_amdgcn_rsqf(q * (1.0f / D) + RMS_EPS); }
}
struct EpiLruIn {
    static constexpr bool PERM = true;
    bf16* Y; bf16* XB; const float* ss;
    __device__ __forceinline__ void operator()(const f32x4 (&acc)[2][2][4][2], const Unit& u, int wr, int wc, int fr, int fq) const {
        int row0 = u.pm * BM + wr * 64 + fr; asm volatile("" : "+v"(row0)); const bool act = (u.pn < 4);
        bf16* base = act ? Y : XB; const int col0 = (u.pn & 3) * BM + wc * 32 + 8 * fq;
        float rs8[2][4]; row_rs8(ss, row0, fq, rs8);
#pragma unroll
        for (int ai = 0; ai < 2; ++ai)
#pragma unroll
            for (int m = 0; m < 4; ++m) { bf16* rowp = base + (size_t)(row0 + ai * HALF + m * 16) * D + col0;
                const float rs = rs8[ai][m];
#pragma unroll
                for (int bj = 0; bj < 2; ++bj) { f32x4 v0 = acc[ai][bj][m][0] * rs, v1 = acc[ai][bj][m][1] * rs;
                    if (act) {
#pragma unroll
                        for (int j = 0; j < 4; ++j) { v0[j] = gelu_tanh(v0[j]); v1[j] = gelu_tanh(v1[j]); } }
                    v4u w; w.x = cvt_pk_bf16(v0[0], v0[1]); w.y = cvt_pk_bf16(v0[2], v0[3]); w.z = cvt_pk_bf16(v1[0], v1[1]); w.w = cvt_pk_bf16(v1[2], v1[3]);
                    *(v4u*)(rowp + bj * HALF) = w; }
                asm volatile("" ::: "memory"); }
    }
};
struct EpiGate {
    static constexpr bool PERM = false;
    const bf16* XC; const float* ba; const float* bx; const float* c8; unsigned* AB;
    __device__ __forceinline__ void operator()(const f32x4 (&acc)[2][2][4][2], const Unit& u, int wr, int wc, int fr, int fq) const {
        int row0 = u.pm * BM + wr * 64 + fr; asm volatile("" : "+v"(row0)); const int ch0 = u.pn * HALF + wc * 32 + 4 * fq;
        v2u xall[2][2][4];
#pragma unroll
        for (int n = 0; n < 2; ++n)
#pragma unroll
            for (int ai = 0; ai < 2; ++ai)
#pragma unroll
                for (int m = 0; m < 4; ++m) xall[n][ai][m] = *(const v2u*)(XC + (size_t)(row0 + ai * HALF + m * 16) * D + ch0 + 16 * n);
#pragma unroll
        for (int n = 0; n < 2; ++n) {
            const f32x4 vba = *(const f32x4*)(ba + ch0 + 16 * n), vbx = *(const f32x4*)(bx + ch0 + 16 * n), vc8 = *(const f32x4*)(c8 + ch0 + 16 * n);
#pragma unroll
            for (int ai = 0; ai < 2; ++ai)
#pragma unroll
                for (int m = 0; m < 4; ++m) { const size_t ro = (size_t)(row0 + ai * HALF + m * 16) * D + ch0 + 16 * n;
                    const v2u xw = xall[n][ai][m];
                    const float xc[4] = {bflo(xw.x), bfhi(xw.x), bflo(xw.y), bfhi(xw.y)}; v4u o;
#pragma unroll
                    for (int j = 0; j < 4; ++j) { const float r = sigmoidf_(acc[ai][0][m][n][j] + vba[j]), gi = sigmoidf_(acc[ai][1][m][n][j] + vbx[j]);
                        const float la2 = -vc8[j] * r, a2 = fast_exp2(2.0f * la2), mult = __builtin_amdgcn_sqrtf(fmaxf(1.0f - a2, 0.f));
                        o[j] = pk2(mult * gi * xc[j], la2); }
                    *(v4u*)(AB + ro) = o;
                    if (m & 1) asm volatile("" ::: "memory"); }
        }
    }
};
struct EpiResid {
    static constexpr bool PERM = true;
    const xr_t* xin; xr_t* out;
    const float* gnext; bf16* hn; float* ssp; PG8_LAS unsigned char* lds;
    float h8s = 0.f;
    __device__ __forceinline__ void operator()(const f32x4 (&acc)[2][2][4][2], const Unit& u, int wr, int wc, int fr, int fq) const {
        int row0 = u.pm * BM + wr * 64 + fr; asm volatile("" : "+v"(row0)); const int col0 = u.pn * BM + wc * 32 + 8 * fq;
        PG8_LAS float* xch = (PG8_LAS float*)(lds + XCH_OFF);
        f32x4 gv[2][2];
        if (hn) {
#pragma unroll
            for (int bj = 0; bj < 2; ++bj)
#pragma unroll
                for (int n = 0; n < 2; ++n) gv[bj][n] = *(const f32x4*)(gnext + col0 + bj * HALF + 4 * n); }
        v4u xq[4][2];
#pragma unroll
        for (int q = 0; q < 4; ++q)
#pragma unroll
            for (int bj = 0; bj < 2; ++bj) xq[q][bj] = *(const v4u*)(xin + (size_t)(row0 + q * 16) * D + col0 + bj * HALF);
#pragma unroll
        for (int g8 = 0; g8 < 8; ++g8) { const int ai = g8 >> 2, m = g8 & 3; const int row = row0 + ai * HALF + m * 16; const size_t ro = (size_t)row * D + col0; float sq = 0.f;
                f32x4 xc[2][2];
#pragma unroll
                for (int bj = 0; bj < 2; ++bj) xr_unpack8(xq[g8 & 3][bj], xc[bj][0], xc[bj][1]);
                if (g8 < 4) { const size_t rn = (size_t)(row0 + HALF + (g8 & 3) * 16) * D + col0;
#pragma unroll
                    for (int bj = 0; bj < 2; ++bj) xq[g8 & 3][bj] = *(const v4u*)(xin + rn + bj * HALF); }
#pragma unroll
                for (int bj = 0; bj < 2; ++bj) { f32x4 o[2];
#pragma unroll
                    for (int n = 0; n < 2; ++n) o[n] = xc[bj][n] + acc[ai][bj][m][n];
                    *(v4u*)(out + ro + bj * HALF) = xr_pack8(o[0], o[1]);
                    if (hn) { sq += (o[0][0] * o[0][0] + o[0][1] * o[0][1]) + (o[0][2] * o[0][2] + o[0][3] * o[0][3]) + (o[1][0] * o[1][0] + o[1][1] * o[1][1]) + (o[1][2] * o[1][2] + o[1][3] * o[1][3]);
                        const f32x4 h0 = o[0] * gv[bj][0], h1 = o[1] * gv[bj][1];
                        if (h8s != 0.f) { v2u w; w.x = pack4_fp8(h0[0], h0[1], h0[2], h0[3], h8s); w.y = pack4_fp8(h1[0], h1[1], h1[2], h1[3], h8s); *(v2u*)((unsigned char*)hn + ro + bj * HALF) = w; }
                        else { v4u w; w.x = cvt_pk_bf16(h0[0], h0[1]); w.y = cvt_pk_bf16(h0[2], h0[3]); w.z = cvt_pk_bf16(h1[0], h1[1]); w.w = cvt_pk_bf16(h1[2], h1[3]);
                        *(v4u*)(hn + ro + bj * HALF) = w; } } }
                if (hn) { sq += __shfl_xor(sq, 16); sq += __shfl_xor(sq, 32); if (fq == 0) xch[wc * 256 + ai * HALF + wr * 64 + m * 16 + fr] = sq; }
                asm volatile("" ::: "memory"); }
        if (hn) {
            asm volatile("s_waitcnt lgkmcnt(0)" ::: "memory"); __builtin_amdgcn_s_barrier(); asm volatile("" ::: "memory");
            const int t = (wr * 4 + wc) * 64 + fq * 16 + fr;
            if (t < 256) ssp[(size_t)u.pn * T + u.pm * BM + t] = (xch[t] + xch[256 + t]) + (xch[512 + t] + xch[768 + t]);
        }
    }
};
struct EpiFoxIn {
    static constexpr bool PERM = true;
    bf16* base; size_t kstride; const float* qg; const float* kg; float c2;
    const float* ss;
    const float* bfv; float* LOGF;
    __device__ __forceinline__ void operator()(const f32x4 (&acc)[2][2][4][2], const Unit& u, int wr, int wc, int fr, int fq) const {
        const int kind = u.pn >> 2, head = 4 * (u.pn & 3) + wc; int row0 = u.pm * BM + wr * 64 + fr; asm volatile("" : "+v"(row0));
        float rs8[2][4]; row_rs8(ss, row0, fq, rs8);
        if (kind == 4) {
            if (wc == 0) { f32x4 bb[2];
#pragma unroll
                for (int n = 0; n < 2; ++n) bb[n] = *(const f32x4*)(bfv + 8 * (fq & 1) + 4 * n);
#pragma unroll
                for (int ai = 0; ai < 2; ++ai)
#pragma unroll
                    for (int m = 0; m < 4; ++m) { const int row = row0 + ai * HALF + m * 16; const float rs = rs8[ai][m];
                        if (fq < 2) {
#pragma unroll
                            for (int n = 0; n < 2; ++n) { f32x4 o;
#pragma unroll
                                for (int j = 0; j < 4; ++j) { const float z = acc[ai][0][m][n][j] * rs + bb[n][j]; o[j] = fminf(z, 0.f) - log1pf(__expf(-fabsf(z))); }
                                *(f32x4*)(LOGF + (size_t)row * 16 + 8 * fq + 4 * n) = o; } } } }
            return;
        }
        bf16* tb = base + (size_t)kind * kstride + head * HD + 8 * fq;
        f32x4 gn[2][2];
        if (kind < 2) { const float* gp = (kind == 0 ? qg : kg) + 8 * fq;
#pragma unroll
            for (int bj = 0; bj < 2; ++bj)
#pragma unroll
                for (int n = 0; n < 2; ++n) gn[bj][n] = *(const f32x4*)(gp + 32 * bj + 4 * n); }
        const float sc = (kind == 0) ? c2 : 1.0f;
#pragma unroll
        for (int ai = 0; ai < 2; ++ai)
#pragma unroll
            for (int m = 0; m < 4; ++m) { const int row = row0 + ai * HALF + m * 16; bf16* rowp = tb + (size_t)row * D;
                const float rsx = rs8[ai][m];
                f32x4 v[2][2];
#pragma unroll
                for (int bj = 0; bj < 2; ++bj)
#pragma unroll
                    for (int n = 0; n < 2; ++n) v[bj][n] = acc[ai][bj][m][n] * rsx;
                if (kind < 2) { float s2 = 0.f;
#pragma unroll
                    for (int bj = 0; bj < 2; ++bj)
#pragma unroll
                        for (int n = 0; n < 2; ++n) s2 += (v[bj][n][0] * v[bj][n][0] + v[bj][n][1] * v[bj][n][1]) + (v[bj][n][2] * v[bj][n][2] + v[bj][n][3] * v[bj][n][3]);
                    s2 += __shfl_xor(s2, 16); s2 += __shfl_xor(s2, 32);
                    const float rs = __builtin_amdgcn_rsqf(s2 * (1.0f / HD) + RMS_EPS) * sc;
#pragma unroll
                    for (int bj = 0; bj < 2; ++bj)
#pragma unroll
                        for (int n = 0; n < 2; ++n) v[bj][n] = v[bj][n] * rs * gn[bj][n];
                } else if (kind == 3) {
#pragma unroll
                    for (int bj = 0; bj < 2; ++bj)
#pragma unroll
                        for (int n = 0; n < 2; ++n)
#pragma unroll
                            for (int j = 0; j < 4; ++j) v[bj][n][j] = sigmoidf_(v[bj][n][j]);
                }
#pragma unroll
                for (int bj = 0; bj < 2; ++bj) { v4u w; w.x = cvt_pk_bf16(v[bj][0][0], v[bj][0][1]); w.y = cvt_pk_bf16(v[bj][0][2], v[bj][0][3]); w.z = cvt_pk_bf16(v[bj][1][0], v[bj][1][1]); w.w = cvt_pk_bf16(v[bj][1][2], v[bj][1][3]);
                    *(v4u*)(rowp + 32 * bj) = w; }
                asm volatile("" ::: "memory"); }
    }
};
struct EpiSwiglu {
    static constexpr bool PERM = true;
    bf16* Hb; int ldh; const float* ss; float hq;
    __device__ __forceinline__ void operator()(const f32x4 (&acc)[2][2][4][2], const Unit& u, int wr, int wc, int fr, int fq) const {
        int row0 = u.pm * BM + wr * 64 + fr; asm volatile("" : "+v"(row0)); const int col0 = u.pn * HALF + wc * 32 + 8 * fq;
        float rs8[2][4]; row_rs8(ss, row0, fq, rs8);
#pragma unroll
        for (int ai = 0; ai < 2; ++ai)
#pragma unroll
            for (int m = 0; m < 4; ++m) { bf16* rowp = Hb + (size_t)(row0 + ai * HALF + m * 16) * ldh + col0; float h[8];
                const float rs = rs8[ai][m];
#pragma unroll
                for (int n = 0; n < 2; ++n)
#pragma unroll
                    for (int j = 0; j < 4; ++j) { const float gv = acc[ai][0][m][n][j] * rs, uv = acc[ai][1][m][n][j] * rs; h[4 * n + j] = gv * uv * fast_rcp(1.0f + fast_exp2(-gv * LOG2E));
#if EMU_FP8
                        if (hq != 0.f) h[4 * n + j] = q8(h[4 * n + j], hq);
#endif
                    }
                v4u w; w.x = cvt_pk_bf16(h[0], h[1]); w.y = cvt_pk_bf16(h[2], h[3]); w.z = cvt_pk_bf16(h[4], h[5]); w.w = cvt_pk_bf16(h[6], h[7]);
                *(v4u*)rowp = w;
                asm volatile("" ::: "memory"); }
    }
};
struct EpiNull {
    static constexpr bool PERM = true;
    float* sink;
    __device__ __forceinline__ void operator()(const f32x4 (&acc)[2][2][4][2], const Unit& u, int wr, int wc, int fr, int fq) const {
        float s = 0.f;
#pragma unroll
        for (int ai = 0; ai < 2; ++ai)
#pragma unroll
            for (int bj = 0; bj < 2; ++bj)
#pragma unroll
                for (int m = 0; m < 4; ++m)
#pragma unroll
                    for (int n = 0; n < 2; ++n) s += acc[ai][bj][m][n][0] + acc[ai][bj][m][n][1] + acc[ai][bj][m][n][2] + acc[ai][bj][m][n][3];
        if (s == 12345.678f) *sink = s;
    }
};
struct EpiSwiglu8 {
    static constexpr bool PERM = true;
    unsigned char* H8; int ldh; float hs; const float* ss = nullptr;
    __device__ __forceinline__ void operator()(const f32x4 (&acc)[2][2][4][2], const Unit& u, int wr, int wc, int fr, int fq) const {
        int row0 = u.pm * BM + wr * 64 + fr; asm volatile("" : "+v"(row0)); const int col0 = u.pn * HALF + wc * 32 + 8 * fq;
        float rs8[2][4]; row_rs8(ss, row0, fq, rs8);
#pragma unroll
        for (int ai = 0; ai < 2; ++ai)
#pragma unroll
            for (int m = 0; m < 4; ++m) { unsigned char* rowp = H8 + (size_t)(row0 + ai * HALF + m * 16) * ldh + col0; float h[8];
                const float rs = rs8[ai][m];
#pragma unroll
                for (int n = 0; n < 2; ++n)
#pragma unroll
                    for (int j = 0; j < 4; ++j) { const float gv = acc[ai][0][m][n][j] * rs, uv = acc[ai][1][m][n][j] * rs; h[4 * n + j] = gv * uv * fast_rcp(1.0f + fast_exp2(-gv * LOG2E)); }
                v2u w; w.x = pack4_fp8(h[0], h[1], h[2], h[3], hs); w.y = pack4_fp8(h[4], h[5], h[6], h[7], hs);
                *(v2u*)rowp = w;
                asm volatile("" ::: "memory"); }
    }
};
struct EpiScatter {
    static constexpr bool PERM = true; static constexpr int NST = 0;
    const xr_t* xr; xr_t* xw; float* fout; const unsigned* list; const float* listw;
    const float* gnext; bf16* hn; float* ssp; PG8_LAS unsigned char* lds;
    float h8s = 0.f;
    __device__ __forceinline__ void operator()(const f32x4 (&acc)[2][2][4][2], const Unit& u, int wr, int wc, int fr, int fq) const {
        int row0 = u.pm * BM + wr * 64 + fr; asm volatile("" : "+v"(row0)); const int col0 = u.pn * BM + wc * 32 + 8 * fq;
        PG8_LAS float* xch = (PG8_LAS float*)(lds + XCH_OFF);
        unsigned idx8[8]; float w8[8];
#pragma unroll
        for (int g8 = 0; g8 < 8; ++g8) { const int row = row0 + (g8 >> 2) * HALF + (g8 & 3) * 16; idx8[g8] = list[row]; w8[g8] = listw[row]; }
        v4u xq[4][2];
#pragma unroll
        for (int q = 0; q < 4; ++q) { const size_t r0 = (size_t)(idx8[q] & 0xffffu) * D + col0;
#pragma unroll
          for (int bj = 0; bj < 2; ++bj) xq[q][bj] = *(const v4u*)(xr + r0 + bj * HALF); }
#pragma unroll
        for (int g8 = 0; g8 < 8; ++g8) { const int ai = g8 >> 2, m = g8 & 3; const unsigned idx = idx8[g8]; const float w = w8[g8]; const bool valid = (idx & 0x80000000u) != 0u;
                const int tok = (int)(idx & 0xffffu); const size_t ro = (size_t)tok * D + col0; float sq = 0.f;
                f32x4 xc[2][2];
#pragma unroll
                for (int bj = 0; bj < 2; ++bj) xr_unpack8(xq[g8 & 3][bj], xc[bj][0], xc[bj][1]);
                if (g8 < 4) { const size_t rn = (size_t)(idx8[g8 + 4] & 0xffffu) * D + col0;
#pragma unroll
                    for (int bj = 0; bj < 2; ++bj) xq[g8 & 3][bj] = *(const v4u*)(xr + rn + bj * HALF); }
                if (valid) {
#pragma unroll
                    for (int bj = 0; bj < 2; ++bj) { f32x4 o[2];
#pragma unroll
                        for (int n = 0; n < 2; ++n) o[n] = xc[bj][n] + acc[ai][bj][m][n] * w;
                        if (fout) { *(f32x4*)(fout + ro + bj * HALF) = o[0]; *(f32x4*)(fout + ro + bj * HALF + 4) = o[1]; }
                        else *(v4u*)(xw + ro + bj * HALF) = xr_pack8(o[0], o[1]);
                        if (hn) { sq += (o[0][0] * o[0][0] + o[0][1] * o[0][1]) + (o[0][2] * o[0][2] + o[0][3] * o[0][3]) + (o[1][0] * o[1][0] + o[1][1] * o[1][1]) + (o[1][2] * o[1][2] + o[1][3] * o[1][3]);
                            const f32x4 g0 = *(const f32x4*)(gnext + col0 + bj * HALF), g1 = *(const f32x4*)(gnext + col0 + bj * HALF + 4);
                            const f32x4 h0 = o[0] * g0, h1 = o[1] * g1;
                            if (h8s != 0.f) { v2u w2; w2.x = pack4_fp8(h0[0], h0[1], h0[2], h0[3], h8s); w2.y = pack4_fp8(h1[0], h1[1], h1[2], h1[3], h8s); *(v2u*)((unsigned char*)hn + ro + bj * HALF) = w2; }
                            else { v4u w4; w4.x = cvt_pk_bf16(h0[0], h0[1]); w4.y = cvt_pk_bf16(h0[2], h0[3]); w4.z = cvt_pk_bf16(h1[0], h1[1]); w4.w = cvt_pk_bf16(h1[2], h1[3]);
                            *(v4u*)(hn + ro + bj * HALF) = w4; } }
                        asm volatile("" ::: "memory"); } }
                if (hn) { sq += __shfl_xor(sq, 16); sq += __shfl_xor(sq, 32); if (fq == 0) xch[wc * 256 + ai * HALF + wr * 64 + m * 16 + fr] = sq; }
                asm volatile("" ::: "memory"); }
        if (hn) {
            asm volatile("s_waitcnt lgkmcnt(0)" ::: "memory"); __builtin_amdgcn_s_barrier(); asm volatile("" ::: "memory");
            const int t = (wr * 4 + wc) * 64 + fq * 16 + fr;
            if (t < 256) { const unsigned idx = list[u.pm * BM + t];
                if (idx & 0x80000000u) ssp[(size_t)u.pn * T + (idx & 0xffffu)] = (xch[t] + xch[256 + t]) + (xch[512 + t] + xch[768 + t]); }
        }
    }
};
}

#define XB_TMO      128
#define XB_XCNT(j)  (256  + 64 * (j))
#define XB_XSUB(j)  (1280 + 64 * (j))
#define XB_XGEN(j)  (2304 + 64 * (j))
#define XB_TOP      3328
#define XB_TOPGEN   3392
#define XCD_BAR_WORDS 3456
#define XB_SPIN_CAP (1u << 21)
__device__ __forceinline__ unsigned xb_ld(unsigned* p)              { return __hip_atomic_load(p, __ATOMIC_RELAXED, __HIP_MEMORY_SCOPE_AGENT); }
__device__ __forceinline__ unsigned xb_add(unsigned* p, unsigned v) { return __hip_atomic_fetch_add(p, v, __ATOMIC_RELAXED, __HIP_MEMORY_SCOPE_AGENT); }
__device__ __forceinline__ unsigned xb_xcc_id() { return (unsigned)__builtin_amdgcn_s_getreg((3 << 11) | 20) & 0xFu; }
#define XB_SPIN(cond, bar) do { unsigned _sp = 0; while (cond) { __builtin_amdgcn_s_sleep(1); \
    if ((++_sp & 255u) == 0u) { if (xb_ld(&(bar)[XB_TMO])) break; if (_sp > XB_SPIN_CAP) { atomicAdd(&(bar)[XB_TMO], 1u); break; } } } } while (0)
struct XcdBarrier { unsigned* bar; unsigned x; volatile LAS unsigned* st; };
__device__ __forceinline__ XcdBarrier xcd_barrier_post(unsigned* bar, volatile LAS unsigned* st) {
    XcdBarrier b; b.bar = bar; b.x = xb_xcc_id(); b.st = st;
    if (threadIdx.x == 0) (void)xb_add(&bar[XB_XCNT(b.x)], 1u);
    return b;
}
__device__ __forceinline__ void xcd_barrier_complete(unsigned* bar, unsigned x, unsigned& nloc, unsigned& nx) {
    const unsigned G = gridDim.x * gridDim.y * gridDim.z;
    unsigned sum, cnt, mine, sp = 0u;
    for (;;) {
        sum = 0u; cnt = 0u; mine = 0u;
#pragma unroll
        for (unsigned j = 0; j < 16; ++j) { const unsigned c = xb_ld(&bar[XB_XCNT(j)]); sum += c; cnt += (c > 0u) ? 1u : 0u; mine = (j == x) ? c : mine; }
        if (sum == G) break;
        __builtin_amdgcn_s_sleep(1);
        if ((++sp & 255u) == 0u) { if (xb_ld(&bar[XB_TMO])) break; if (sp > XB_SPIN_CAP) { atomicAdd(&bar[XB_TMO], 1u); break; } }
    }
    nloc = mine > 0u ? mine : 1u; nx = cnt > 0u ? cnt : 1u;
}
__device__ __forceinline__ void xcd_barrier(const XcdBarrier& b) {
    asm volatile("s_waitcnt vmcnt(0)" ::: "memory");
    __syncthreads();
    if (threadIdx.x == 0) {
        unsigned* bar = b.bar; asm volatile("" : "+s"(bar));
        __builtin_amdgcn_s_waitcnt(0);
        unsigned nloc = b.st[0], nx = b.st[1];
        if (nloc == 0u) { xcd_barrier_complete(bar, b.x, nloc, nx); b.st[0] = nloc; b.st[1] = nx; }
        const unsigned old = xb_add(&bar[XB_XSUB(b.x)], 1u);
        const unsigned gen = old / nloc;
        if (old + 1u == (gen + 1u) * nloc) {
            __builtin_amdgcn_fence(__ATOMIC_RELEASE, "agent");
            asm volatile("s_waitcnt vmcnt(0)" ::: "memory");
            const unsigned og = xb_add(&bar[XB_TOP], 1u);
            const unsigned tg = og / nx;
            if (og + 1u == (tg + 1u) * nx) xb_add(&bar[XB_TOPGEN], 1u);
            else XB_SPIN(xb_ld(&bar[XB_TOPGEN]) == tg, bar);
            __builtin_amdgcn_fence(__ATOMIC_ACQUIRE, "agent");
            xb_add(&bar[XB_XGEN(b.x)], 1u);
            asm volatile("s_waitcnt vmcnt(0)" ::: "memory");
        } else {
            XB_SPIN(xb_ld(&bar[XB_XGEN(b.x)]) == gen, bar);
            __builtin_amdgcn_fence(__ATOMIC_ACQUIRE, "agent");
            asm volatile("s_waitcnt vmcnt(0)" ::: "memory");
        }
    }
    __syncthreads();
}

constexpr size_t MiB = 1u << 20;
constexpr size_t WS_CTL = 0, CTL_ZERO_BYTES = 1 * MiB;
constexpr size_t WS_F2 = 1 * MiB;
constexpr size_t WS_LOGF = 5 * MiB;
constexpr size_t WS_AGG = 9 * MiB;
constexpr size_t WS_TOPE = 13 * MiB;
constexpr size_t WS_TOPW = 13 * MiB + 256 * 1024;
constexpr size_t WS_SMALL = 13 * MiB + 768 * 1024;
constexpr size_t SM_CNT = 0, SM_TILE = 16384, SM_NT = 16384 + 8192, SM_C8 = 16384 + 8192 + 256, SM_T0 = SM_C8 + 4096;
constexpr int CW_QCTR = 2048;
constexpr float SKIP_THR = 64.0f;
constexpr int LISTCAP = 264 * 256;
constexpr size_t WS_LIST = 14 * MiB;
constexpr size_t WS_LISTW = 15 * MiB;
constexpr size_t WS_WL = 16 * MiB;
constexpr size_t WL_IN = 0, WL_G = 4 * MiB, WL_OUT = 5 * MiB, WL_W1 = 8 * MiB, WL_W2 = 22 * MiB;
constexpr size_t WS_WF = 48 * MiB;
constexpr size_t WF_IN = 0, WF_OUT = 9 * MiB, WF_W1 = 11 * MiB, WF_W2 = 123 * MiB;
constexpr size_t WS_SS = 228 * MiB;
constexpr size_t WS_HN = 232 * MiB;
constexpr size_t WS_ACT = 360 * MiB;
constexpr size_t ACT_SLOT = 128 * MiB;
constexpr size_t WS_END = 1000 * MiB;
static_assert(WS_WL + WL_W2 + (size_t)D * FF * 2 <= WS_WF && WS_WF + WF_W2 + (size_t)NE * D * FF * 2 <= WS_SS && WS_SS + 12 * (size_t)T * 4 <= WS_HN && WS_HN + (size_t)T * D * 2 <= WS_ACT && WS_ACT + 5 * ACT_SLOT <= WS_END, "d_ws map");
constexpr int CW_BAR = 4096;

constexpr int RING_BYTES = 131072, MISC_OFF = RING_BYTES + 320, LDS_BYTES = 147456;

struct Args {
    const float* in[24]; float* out; unsigned char* ws; int ph_lo, ph_hi;
};

__device__ __forceinline__ const float* inp(int k) {
    int kk = k; asm volatile("" : "+s"(kk));
    const __attribute__((address_space(4))) unsigned long long* tab = (const __attribute__((address_space(4))) unsigned long long*)__builtin_amdgcn_kernarg_segment_ptr();
    return (const float*)(uintptr_t)tab[kk];
}
struct Frame {
    LAS unsigned char* lds; unsigned char* ldsg;
    int tid, lane, wave, G, vcu, bx;
};

struct CvtJob { const float* src; bf16* dst; int pitch, dpitch; float qs; float f8;    };
__device__ __forceinline__ void cvt_load(const CvtJob& jb, float (&r)[32], int lane) {
    const float* p = jb.src + (size_t)(lane >> 5) * jb.pitch + (lane & 31);
#pragma unroll
    for (int i = 0; i < 32; ++i) r[i] = p[(size_t)(2 * i) * jb.pitch];
#if EMU_FP8
    if (jb.qs != 0.f) {
#pragma unroll
        for (int i = 0; i < 32; ++i) r[i] = q8(r[i], jb.qs); }
#endif
}
__device__ __forceinline__ void cvt_store(const CvtJob& jb, const float (&r)[32], LAS float* scr, int lane) {
#pragma unroll
    for (int i = 0; i < 32; ++i) scr[(2 * i + (lane >> 5)) * 33 + (lane & 31)] = r[i];
    LDS_WAIT(); asm volatile("" ::: "memory");
    const int c = lane & 7;
    if (jb.f8 != 0.f) {
#pragma unroll
        for (int j = 0; j < 4; ++j) { const int n = (lane >> 3) + 8 * j; const LAS float* s = scr + (8 * c) * 33 + n;
            v2u o; o.x = pack4_fp8(s[0 * 33], s[1 * 33], s[2 * 33], s[3 * 33], jb.f8); o.y = pack4_fp8(s[4 * 33], s[5 * 33], s[6 * 33], s[7 * 33], jb.f8);
            *(GAS v2u*)((unsigned char*)jb.dst + (size_t)n * jb.dpitch + 8 * c) = o; }
    } else {
#pragma unroll
    for (int j = 0; j < 4; ++j) { const int n = (lane >> 3) + 8 * j; const LAS float* s = scr + (8 * c) * 33 + n;
        v4u o; o.x = pk2(s[0 * 33], s[1 * 33]); o.y = pk2(s[2 * 33], s[3 * 33]); o.z = pk2(s[4 * 33], s[5 * 33]); o.w = pk2(s[6 * 33], s[7 * 33]);
        *(GAS v4u*)(jb.dst + (size_t)n * jb.dpitch + 8 * c) = o; }
    }
    LDS_WAIT(); asm volatile("" ::: "memory");
}
enum { MAP_NAT = 0, MAP_FOXIN = 1, MAP_GU = 2 };
__device__ __forceinline__ int map_row(int kind, int n0, int half) {
    if (kind == MAP_NAT) return n0;
    if (kind == MAP_FOXIN) { const int tile = n0 >> 8, c = n0 & 255, wc = c >> 6, bj = (c >> 5) & 1; return tile * 256 + bj * 128 + wc * 32; }
    return (n0 >> 7) * 256 + half * 128 + (n0 & 127);
}
__device__ __forceinline__ CvtJob cvt_mk(const float* W, int N, int pitch, bf16* WT, int dpitch, int kind, int half, int drow_base, int idx) {
    const int nblk = N / 32, kb = idx / nblk, nb = idx % nblk;
    CvtJob jb; jb.src = W + (size_t)(64 * kb) * pitch + 32 * nb; jb.dst = WT + (size_t)(drow_base + map_row(kind, 32 * nb, half)) * dpitch + 64 * kb; jb.pitch = pitch; jb.dpitch = dpitch; jb.qs = 0.f; jb.f8 = 0.f; return jb;
}
__device__ __forceinline__ CvtJob cvt_mk8(const float* W, int N, int pitch, unsigned char* WT8, int K, int kind, int half, int drow_base, int idx, float sc) {
    const int nblk = N / 32, kb = idx / nblk, nb = idx % nblk;
    CvtJob jb; jb.src = W + (size_t)(64 * kb) * pitch + 32 * nb; jb.dst = (bf16*)(WT8 + (size_t)(drow_base + map_row(kind, 32 * nb, half)) * K + 64 * kb); jb.pitch = pitch; jb.dpitch = K; jb.qs = 0.f; jb.f8 = sc; return jb;
}
constexpr int CVT_L_TOTAL = 1024 + 128 + 512 + 3 * 1792, CVT_F_TOTAL = 2048 + 512 + NE * 3 * 1792;
__device__ __forceinline__ CvtJob cvt_decode_lru(int it, int j, unsigned char* wreg) {
    bf16* Win_t = (bf16*)(wreg + WL_IN); bf16* Wg_t = (bf16*)(wreg + WL_G); bf16* Wout_t = (bf16*)(wreg + WL_OUT); bf16* W1_t = (bf16*)(wreg + WL_W1); bf16* W2_t = (bf16*)(wreg + WL_W2);
    if (it < 1024) { if (FP8_LRUIN_J1 && j == 1) return cvt_mk8(inp(3) + (size_t)j * D * 2 * D, 2 * D, 2 * D, (unsigned char*)Win_t, D, MAP_NAT, 0, 0, it, 64.f);
        return cvt_mk(inp(3) + (size_t)j * D * 2 * D, 2 * D, 2 * D, Win_t, D, MAP_NAT, 0, 0, it); }
    it -= 1024;
    if (it < 128) { const int m = it >> 3, hb = m >> 1, gx = m & 1; return cvt_mk(inp(gx ? 8 : 6) + ((size_t)j * 8 + hb) * 128 * 128, 128, 128, Wg_t, 128, MAP_NAT, 0, 256 * hb + 128 * gx, it & 7); }
    it -= 128;
    if (it < 512) return cvt_mk(inp(11) + (size_t)j * D * D, D, D, Wout_t, D, MAP_NAT, 0, 0, it);
    it -= 512;
    if (FP8_L2_FFN && j == 1) {
        if (it < 1792) return cvt_mk8(inp(17) + (size_t)j * D * FF, FF, FF, (unsigned char*)W1_t, D, MAP_GU, 0, 0, it, 64.f);
        it -= 1792;
        if (it < 1792) return cvt_mk8(inp(18) + (size_t)j * D * FF, FF, FF, (unsigned char*)W1_t, D, MAP_GU, 1, 0, it, 64.f);
        it -= 1792;
        return cvt_mk8(inp(19) + (size_t)j * FF * D, D, D, (unsigned char*)W2_t, FF, MAP_NAT, 0, 0, it, 128.f);
    }
    const bool q = (EMU_FP8 >= 2 && j == 1) || EMU_FP8 >= 3;
    if (it < 1792) { CvtJob jb = cvt_mk(inp(17) + (size_t)j * D * FF, FF, FF, W1_t, D, MAP_GU, 0, 0, it); if (q) jb.qs = 64.f; return jb; }
    it -= 1792;
    if (it < 1792) { CvtJob jb = cvt_mk(inp(18) + (size_t)j * D * FF, FF, FF, W1_t, D, MAP_GU, 1, 0, it); if (q) jb.qs = 64.f; return jb; }
    it -= 1792;
    { CvtJob jb = cvt_mk(inp(19) + (size_t)j * FF * D, D, D, W2_t, FF, MAP_NAT, 0, 0, it); if (q) jb.qs = 128.f; return jb; }
}
__device__ __forceinline__ CvtJob cvt_decode_fox(int it, int j, unsigned char* wreg) {
    bf16* Win_t = (bf16*)(wreg + WF_IN); bf16* Wout_t = (bf16*)(wreg + WF_OUT); bf16* W1_t = (bf16*)(wreg + WF_W1); bf16* W2_t = (bf16*)(wreg + WF_W2);
    if (it < 2048) { if (FP8_FOXIN_J1 && (j == 1 || FP8_FOXIN_J0)) return cvt_mk8(inp(12) + (size_t)j * D * (4 * D + NH), 4 * D, 4 * D + NH, (unsigned char*)Win_t, D, MAP_FOXIN, 0, 0, it, 64.f);
        return cvt_mk(inp(12) + (size_t)j * D * (4 * D + NH), 4 * D, 4 * D + NH, Win_t, D, MAP_FOXIN, 0, 0, it); }
    it -= 2048;
    if (it < 512) return cvt_mk(inp(16) + (size_t)j * D * D, D, D, Wout_t, D, MAP_NAT, 0, 0, it);
    it -= 512;
    const int e = it / (3 * 1792), q = it % (3 * 1792), m = q / 1792, idx = q % 1792;
    CvtJob jb;
    if (FP8_LAST_MOE && (j == 1 || FP8_MOE_J0)) {
        if (m == 0) return cvt_mk8(inp(21) + ((size_t)j * NE + e) * D * FF, FF, FF, (unsigned char*)W1_t, D, MAP_GU, 0, e * 2 * FF, idx, 64.f);
        if (m == 1) return cvt_mk8(inp(22) + ((size_t)j * NE + e) * D * FF, FF, FF, (unsigned char*)W1_t, D, MAP_GU, 1, e * 2 * FF, idx, 64.f);
        return cvt_mk8(inp(23) + ((size_t)j * NE + e) * FF * D, D, D, (unsigned char*)W2_t, FF, MAP_NAT, 0, e * D, idx, 128.f);
    }
    if (m == 0) jb = cvt_mk(inp(21) + ((size_t)j * NE + e) * D * FF, FF, FF, W1_t, D, MAP_GU, 0, e * 2 * FF, idx);
    else if (m == 1) jb = cvt_mk(inp(22) + ((size_t)j * NE + e) * D * FF, FF, FF, W1_t, D, MAP_GU, 1, e * 2 * FF, idx);
    else jb = cvt_mk(inp(23) + ((size_t)j * NE + e) * FF * D, D, D, W2_t, FF, MAP_NAT, 0, e * D, idx);
    if ((EMU_FP8 && j == 1) || EMU_FP8 >= 3) jb.qs = (m == 2) ? 128.f : 64.f;
    return jb;
}
template <bool FOX>
__device__ __forceinline__ void cvt_phase(Frame& F, int j, unsigned char* wreg) {
    const int gw = F.vcu * NWAVES + F.wave, NGW = F.G * NWAVES, total = FOX ? CVT_F_TOTAL : CVT_L_TOTAL;
    LAS float* scr = (LAS float*)(F.lds + F.wave * 16384);
    if (gw >= total) return;
    float ra[32], rb[32];
    CvtJob ja = FOX ? cvt_decode_fox(gw, j, wreg) : cvt_decode_lru(gw, j, wreg), jb2 = ja;
    cvt_load(ja, ra, F.lane);
    for (int it = gw; it < total; it += NGW) {
        const int nx = it + NGW; const bool more = nx < total;
        if (more) { jb2 = FOX ? cvt_decode_fox(nx, j, wreg) : cvt_decode_lru(nx, j, wreg); cvt_load(jb2, rb, F.lane); }
        cvt_store(ja, ra, scr, F.lane);
        ja = jb2;
#pragma unroll
        for (int i = 0; i < 32; ++i) ra[i] = rb[i];
    }
}

template <int NP, bool XB16 = false>
__device__ __forceinline__ void norm_phase(Frame& F, const float* xin, const float* gain, bf16* HN, const float* Wp, int wp_pitch,
                                           const float* bfv, float* LOGF, unsigned* TOPE, float* TOPW, unsigned* CNT, float hq = 0.f, xr_t* xcopy = nullptr) {
    LAS float* Wl = (LAS float*)(F.lds);
    LAS int* cnts = (LAS int*)(F.lds + 65536);
    if (NP > 0) {
        for (int idx = F.tid; idx < NP * 1024; idx += NWAVES * 64) { const int c = idx / NP, j = idx % NP; Wl[j * 1024 + c] = Wp[(size_t)c * wp_pitch + j]; }
        if (NP == 8 && F.tid < 16) cnts[F.tid] = 0;
        __syncthreads();
    }
    f32x4 gv[4];
#pragma unroll
    for (int j = 0; j < 4; ++j) gv[j] = *(const f32x4*)(gain + 4 * F.lane + 256 * j);
    const int rbase = F.bx * 256 + F.wave * 32;
    f32x4 vn[4]; v2u vb[4];
    if (XB16) { const GAS v2u* xr = (const GAS v2u*)((const xr_t*)xin + (size_t)rbase * D) + F.lane;
#pragma unroll
      for (int j = 0; j < 4; ++j) vb[j] = xr[64 * j]; }
    else { const GAS f32x4* xr = (const GAS f32x4*)(xin + (size_t)rbase * D) + F.lane;
#pragma unroll
      for (int j = 0; j < 4; ++j) vn[j] = xr[64 * j]; }
    for (int i = 0; i < 32; ++i) {
        const int m = rbase + i;
        f32x4 v[4];
        if (XB16) {
#pragma unroll
            for (int j = 0; j < 4; ++j) { v[j].x = __uint_as_float(vb[j].x << 16); v[j].y = __uint_as_float(vb[j].x & 0xffff0000u); v[j].z = __uint_as_float(vb[j].y << 16); v[j].w = __uint_as_float(vb[j].y & 0xffff0000u); }
            if (i + 1 < 32) { const GAS v2u* xr = (const GAS v2u*)((const xr_t*)xin + (size_t)(m + 1) * D) + F.lane;
#pragma unroll
                for (int j = 0; j < 4; ++j) vb[j] = xr[64 * j]; }
        } else {
#pragma unroll
            for (int j = 0; j < 4; ++j) v[j] = vn[j];
            if (i + 1 < 32) { const GAS f32x4* xr = (const GAS f32x4*)(xin + (size_t)(m + 1) * D) + F.lane;
#pragma unroll
                for (int j = 0; j < 4; ++j) vn[j] = xr[64 * j]; }
            if (xcopy) { GAS v2u* xc = (GAS v2u*)(xcopy + (size_t)m * D) + F.lane;
#pragma unroll
                for (int j = 0; j < 4; ++j) { v2u w; w.x = cvt_pk_bf16(v[j].x, v[j].y); w.y = cvt_pk_bf16(v[j].z, v[j].w); xc[64 * j] = w; } }
        }
        float s = 0.f;
#pragma unroll
        for (int j = 0; j < 4; ++j) s += (v[j].x * v[j].x + v[j].y * v[j].y) + (v[j].z * v[j].z + v[j].w * v[j].w);
        const float rs = 1.0f / __builtin_sqrtf(wave_sum(s) * (1.0f / D) + RMS_EPS);
#pragma unroll
        for (int j = 0; j < 4; ++j) v[j] = v[j] * rs * gv[j];
        GAS unsigned long long* o8 = (GAS unsigned long long*)(HN + (size_t)m * D) + F.lane;
#if EMU_FP8
        if (hq != 0.f) {
#pragma unroll
            for (int j = 0; j < 4; ++j) o8[64 * j] = (unsigned long long)pk2(q8(v[j].x, hq), q8(v[j].y, hq)) | ((unsigned long long)pk2(q8(v[j].z, hq), q8(v[j].w, hq)) << 32);
        } else
#endif
        if (hq < 0.f) {
            GAS unsigned* o4 = (GAS unsigned*)((unsigned char*)HN + (size_t)m * D) + F.lane;
#pragma unroll
            for (int j = 0; j < 4; ++j) o4[64 * j] = pack4_fp8(v[j].x, v[j].y, v[j].z, v[j].w, -hq);
        } else
#pragma unroll
        for (int j = 0; j < 4; ++j) o8[64 * j] = (unsigned long long)pk2(v[j].x, v[j].y) | ((unsigned long long)pk2(v[j].z, v[j].w) << 32);
        if (NP > 0) {
            float mine = 0.f;
#pragma unroll 2
            for (int p = 0; p < NP; ++p) { float a = 0.f;
#pragma unroll
                for (int j = 0; j < 4; ++j) { const f32x4 w = *(const LAS f32x4*)(Wl + p * 1024 + 4 * F.lane + 256 * j); a += (v[j].x * w.x + v[j].y * w.y) + (v[j].z * w.z + v[j].w * w.w); }
                a = wave_sum(a); if (F.lane == p) mine = a; }
            if (NP == 16) {
                if (F.lane < 16) { const float z = mine + bfv[F.lane]; const float ls = fminf(z, 0.f) - log1pf(__expf(-fabsf(z))); LOGF[(size_t)m * 16 + F.lane] = ls; }
            } else {
                float lg[8];
#pragma unroll
                for (int p = 0; p < 8; ++p) lg[p] = __shfl(mine, p);
                int i1 = 0; float l1 = lg[0];
#pragma unroll
                for (int p = 1; p < 8; ++p) if (lg[p] > l1) { l1 = lg[p]; i1 = p; }
                int i2 = (i1 == 0) ? 1 : 0; float l2 = (i1 == 0) ? lg[1] : lg[0];
#pragma unroll
                for (int p = 1; p < 8; ++p) if (p != i1 && lg[p] > l2) { l2 = lg[p]; i2 = p; }
                const float w1 = 1.0f / (1.0f + __expf(l2 - l1)), w2 = 1.0f - w1;
                if (F.lane == 0) { TOPE[m] = (unsigned)i1 | ((unsigned)i2 << 8); TOPW[2 * (size_t)m] = w1; TOPW[2 * (size_t)m + 1] = w2;
                    atomicAdd((int*)&cnts[i1], 1); atomicAdd((int*)&cnts[8 + i2], 1); }
            }
        }
    }
    if (NP == 8) { __syncthreads(); if (F.tid < 16) CNT[F.bx * 16 + F.tid] = (unsigned)cnts[F.tid]; }
    __syncthreads();
}

__device__ __forceinline__ void norm0_phase(Frame& F, const float* xin, const float* gain, bf16* HN, xr_t* XR) {
    f32x4 gv[4];
#pragma unroll
    for (int j = 0; j < 4; ++j) gv[j] = *(const f32x4*)(gain + 4 * F.lane + 256 * j);
    const int rbase = F.bx * 256 + F.wave * 32;
    f32x4 nb[4][4];
#pragma unroll
    for (int r = 0; r < 4; ++r) { const GAS f32x4* xr = (const GAS f32x4*)(xin + (size_t)(rbase + r) * D) + F.lane;
#pragma unroll
        for (int j = 0; j < 4; ++j) nb[r][j] = xr[64 * j]; }
    for (int g = 0; g < 8; ++g) {
        f32x4 v[4][4];
#pragma unroll
        for (int r = 0; r < 4; ++r)
#pragma unroll
            for (int j = 0; j < 4; ++j) v[r][j] = nb[r][j];
        if (g + 1 < 8) {
#pragma unroll
            for (int r = 0; r < 4; ++r) { const GAS f32x4* xr = (const GAS f32x4*)(xin + (size_t)(rbase + 4 * (g + 1) + r) * D) + F.lane;
#pragma unroll
                for (int j = 0; j < 4; ++j) nb[r][j] = xr[64 * j]; } }
        float ss[4];
#pragma unroll
        for (int r = 0; r < 4; ++r) { float s = 0.f;
#pragma unroll
            for (int j = 0; j < 4; ++j) s += (v[r][j].x * v[r][j].x + v[r][j].y * v[r][j].y) + (v[r][j].z * v[r][j].z + v[r][j].w * v[r][j].w);
            ss[r] = s; }
#pragma unroll
        for (int o = 1; o < 64; o <<= 1) {
#pragma unroll
            for (int r = 0; r < 4; ++r) ss[r] += __shfl_xor(ss[r], o); }
#pragma unroll
        for (int r = 0; r < 4; ++r) { const int m = rbase + 4 * g + r;
            const float rs = 1.0f / __builtin_sqrtf(ss[r] * (1.0f / D) + RMS_EPS);
            GAS v2u* xc = (GAS v2u*)(XR + (size_t)m * D) + F.lane; GAS v2u* o8 = (GAS v2u*)(HN + (size_t)m * D) + F.lane;
#pragma unroll
            for (int j = 0; j < 4; ++j) { v2u w; w.x = cvt_pk_bf16(v[r][j].x, v[r][j].y); w.y = cvt_pk_bf16(v[r][j].z, v[r][j].w); xc[64 * j] = w;
                const f32x4 h = v[r][j] * rs * gv[j]; v2u w2; w2.x = pk2(h.x, h.y); w2.y = pk2(h.z, h.w); o8[64 * j] = w2; } }
    }
}

__device__ __forceinline__ void router_phase(Frame& F, const xr_t* xin, const float* gain, unsigned char* HN8, const float* Wp, unsigned* TOPE, float* TOPW, unsigned* CNT, float hs) {
    LAS float* Wl = (LAS float*)(F.lds);
    LAS int* cnts = (LAS int*)(F.lds + 65536);
    for (int idx = F.tid; idx < NE * 1024; idx += NWAVES * 64) { const int c = idx / NE, p = idx % NE; Wl[p * 1024 + c] = Wp[(size_t)c * NE + p] * gain[c]; }
    if (F.tid < 16) cnts[F.tid] = 0;
    __syncthreads();
    f32x4 gv[4];
#pragma unroll
    for (int j = 0; j < 4; ++j) gv[j] = *(const f32x4*)(gain + 4 * F.lane + 256 * j);
    const int rbase = F.bx * 256 + F.wave * 32;
    const bool up1 = (F.lane & 1) != 0, up2 = (F.lane & 2) != 0, up4 = (F.lane & 4) != 0;
    v2u nb[4][4];
#pragma unroll
    for (int r = 0; r < 4; ++r) { const GAS v2u* xr = (const GAS v2u*)(xin + (size_t)(rbase + r) * D) + F.lane;
#pragma unroll
        for (int j = 0; j < 4; ++j) nb[r][j] = xr[64 * j]; }
    for (int g = 0; g < 8; ++g) {
        f32x4 v[4][4];
#pragma unroll
        for (int r = 0; r < 4; ++r)
#pragma unroll
            for (int j = 0; j < 4; ++j) { v[r][j].x = __uint_as_float(nb[r][j].x << 16); v[r][j].y = __uint_as_float(nb[r][j].x & 0xffff0000u); v[r][j].z = __uint_as_float(nb[r][j].y << 16); v[r][j].w = __uint_as_float(nb[r][j].y & 0xffff0000u); }
        if (g + 1 < 8) {
#pragma unroll
            for (int r = 0; r < 4; ++r) { const GAS v2u* xr = (const GAS v2u*)(xin + (size_t)(rbase + 4 * (g + 1) + r) * D) + F.lane;
#pragma unroll
                for (int j = 0; j < 4; ++j) nb[r][j] = xr[64 * j]; } }
        float a[4][8];
#pragma unroll
        for (int p = 0; p < 8; ++p) { f32x4 w[4];
#pragma unroll
            for (int j = 0; j < 4; ++j) w[j] = *(const LAS f32x4*)(Wl + p * 1024 + 4 * F.lane + 256 * j);
#pragma unroll
            for (int r = 0; r < 4; ++r) { float t = 0.f;
#pragma unroll
                for (int j = 0; j < 4; ++j) t += (v[r][j].x * w[j].x + v[r][j].y * w[j].y) + (v[r][j].z * w[j].z + v[r][j].w * w[j].w);
                a[r][p] = t; } }
        float d[4], ss[4];
#pragma unroll
        for (int r = 0; r < 4; ++r) { float s = 0.f;
#pragma unroll
            for (int j = 0; j < 4; ++j) s += (v[r][j].x * v[r][j].x + v[r][j].y * v[r][j].y) + (v[r][j].z * v[r][j].z + v[r][j].w * v[r][j].w);
            ss[r] = s; }
#pragma unroll
        for (int r = 0; r < 4; ++r) { float b4[4], c2[2];
#pragma unroll
            for (int k = 0; k < 4; ++k) { const float snd = up1 ? a[r][k] : a[r][k + 4], kept = up1 ? a[r][k + 4] : a[r][k]; b4[k] = kept + __shfl_xor(snd, 1); }
#pragma unroll
            for (int k = 0; k < 2; ++k) { const float snd = up2 ? b4[k] : b4[k + 2], kept = up2 ? b4[k + 2] : b4[k]; c2[k] = kept + __shfl_xor(snd, 2); }
            { const float snd = up4 ? c2[0] : c2[1], kept = up4 ? c2[1] : c2[0]; d[r] = kept + __shfl_xor(snd, 4); } }
#pragma unroll
        for (int o = 8; o < 64; o <<= 1) {
#pragma unroll
            for (int r = 0; r < 4; ++r) d[r] += __shfl_xor(d[r], o); }
#pragma unroll
        for (int o = 1; o < 64; o <<= 1) {
#pragma unroll
            for (int r = 0; r < 4; ++r) ss[r] += __shfl_xor(ss[r], o); }
#pragma unroll
        for (int r = 0; r < 4; ++r) {
            const int m = rbase + 4 * g + r;
            const float rs = 1.0f / __builtin_sqrtf(ss[r] * (1.0f / D) + RMS_EPS);
            GAS unsigned* o4 = (GAS unsigned*)(HN8 + (size_t)m * D) + F.lane;
#pragma unroll
            for (int j = 0; j < 4; ++j) { const f32x4 h = v[r][j] * rs * gv[j]; o4[64 * j] = pack4_fp8(h.x, h.y, h.z, h.w, hs); }
            float lg[8];
#pragma unroll
            for (int p = 0; p < 8; ++p) lg[p] = __shfl(d[r], (p >> 2) | (((p >> 1) & 1) << 1) | ((p & 1) << 2)) * rs;
            int i1 = 0; float l1 = lg[0];
#pragma unroll
            for (int p = 1; p < 8; ++p) if (lg[p] > l1) { l1 = lg[p]; i1 = p; }
            int i2 = (i1 == 0) ? 1 : 0; float l2 = (i1 == 0) ? lg[1] : lg[0];
#pragma unroll
            for (int p = 1; p < 8; ++p) if (p != i1 && lg[p] > l2) { l2 = lg[p]; i2 = p; }
            const float w1 = 1.0f / (1.0f + __expf(l2 - l1)), w2 = 1.0f - w1;
            if (F.lane == 0) { TOPE[m] = (unsigned)i1 | ((unsigned)i2 << 8); TOPW[2 * (size_t)m] = w1; TOPW[2 * (size_t)m + 1] = w2;
                atomicAdd((int*)&cnts[i1], 1); atomicAdd((int*)&cnts[8 + i2], 1); }
        }
    }
    __syncthreads(); if (F.tid < 16) CNT[F.bx * 16 + F.tid] = (unsigned)cnts[F.tid];
    __syncthreads();
}

__device__ __forceinline__ void split3(float v, unsigned& w01, unsigned& w2) {
    const unsigned t0 = f2bf(v); const float r1 = v - __builtin_bit_cast(float, t0 << 16);
    const unsigned t1 = f2bf(r1); const float r2 = r1 - __builtin_bit_cast(float, t1 << 16);
    w01 = t0 | (t1 << 16); w2 = f2bf(r2);
}
__device__ __forceinline__ void cumsum_phase(Frame& F, const float* LOGF, float* F2, int* T0, bf16* QX, bf16* KX, const float* qg, const float* kg) {
    if (F.bx >= BATCH * NH) return;
    const int b = F.bx >> 4, h = F.bx & 15;
    LAS float* sh = (LAS float*)(F.lds);
    LAS float* Fls = (LAS float*)(F.lds + 1024);
    float mq = fabsf(qg[F.lane]), mk = fabsf(kg[F.lane]);
#pragma unroll
    for (int o = 1; o < 64; o <<= 1) { mq = fmaxf(mq, __shfl_xor(mq, o)); mk = fmaxf(mk, __shfl_xor(mk, o)); }
    const float mfix = 8.0f * mq * mk * LOG2E * 1.02f;
    float v[16]; float run = 0.f;
#pragma unroll
    for (int k = 0; k < 16; ++k) { run += LOGF[((size_t)b * SEQ + 16 * F.tid + k) * 16 + h]; v[k] = run; }
    float inc = run;
#pragma unroll
    for (int o = 1; o < 64; o <<= 1) { const float t = __shfl_up(inc, o); if (F.lane >= o) inc += t; }
    if (F.lane == 63) sh[F.wave] = inc;
    __syncthreads();
    float pre = inc - run;
    for (int w = 0; w < F.wave; ++w) pre += sh[w];
    float* o = F2 + (size_t)F.bx * SEQ + 16 * F.tid;
    v4u* qx = (v4u*)(QX + ((size_t)F.bx * SEQ + 16 * F.tid) * 8); v4u* kx = (v4u*)(KX + ((size_t)F.bx * SEQ + 16 * F.tid) * 16);
#pragma unroll
    for (int k = 0; k < 16; k += 4) { const f32x4 q = (f32x4){(pre + v[k]) * LOG2E, (pre + v[k + 1]) * LOG2E, (pre + v[k + 2]) * LOG2E, (pre + v[k + 3]) * LOG2E};
        *(f32x4*)(o + k) = q; *(LAS f32x4*)(Fls + 16 * F.tid + k) = q;
#pragma unroll
        for (int e = 0; e < 4; ++e) { unsigned a01, a2, b01, b2; split3(q[e] - mfix, a01, a2); split3(-q[e], b01, b2);
            qx[k + e] = (v4u){a01, a2 | 0x3f800000u, 0x3f803f80u, 0u};
            kx[2 * (k + e)] = (v4u){0x3f803f80u, 0x3f80u | (b01 << 16), (b01 >> 16) | (b2 << 16), 0u};
            kx[2 * (k + e) + 1] = (v4u){0u, 0u, 0u, 0u}; } }
    __syncthreads();
    if (F.tid < 32) { const int qb = F.tid; const float target = Fls[256 * qb] + SKIP_THR; int lo_ = 0, hi_ = 4 * qb;
        while (lo_ < hi_) { const int mid = (lo_ + hi_) >> 1; if (Fls[64 * mid + 63] <= target) hi_ = mid; else lo_ = mid + 1; }
        T0[F.bx * 32 + qb] = lo_; }
    __syncthreads();
}

__device__ __forceinline__ void conv_phase(Frame& F, const bf16* XB, const float* cw, const float* cb, bf16* XC) {
    const int gt = F.bx * (NWAVES * 64) + F.tid, cg = gt & 127, c0 = cg * 8;
    float w[4][8], bias[8];
#pragma unroll
    for (int j = 0; j < 4; ++j)
#pragma unroll
        for (int c = 0; c < 8; ++c) w[j][c] = cw[j * D + c0 + c];
#pragma unroll
    for (int c = 0; c < 8; ++c) bias[c] = cb[c0 + c];
    const int nchunk_threads = (F.G * NWAVES * 64) >> 7;
    for (int chunk = gt >> 7; chunk < T / 16; chunk += nchunk_threads) {
        const int t0 = chunk * 16, s0 = t0 & (SEQ - 1);
        float xw[3][8];
#pragma unroll
        for (int r = 0; r < 3; ++r) {
            if (s0 == 0) {
#pragma unroll
                for (int c = 0; c < 8; ++c) xw[r][c] = 0.f;
            } else { const v4u q = *(const v4u*)(XB + (size_t)(t0 - 3 + r) * D + c0);
                xw[r][0] = bflo(q.x); xw[r][1] = bfhi(q.x); xw[r][2] = bflo(q.y); xw[r][3] = bfhi(q.y); xw[r][4] = bflo(q.z); xw[r][5] = bfhi(q.z); xw[r][6] = bflo(q.w); xw[r][7] = bfhi(q.w); }
        }
        v4u qr[16];
#pragma unroll
        for (int i = 0; i < 16; ++i) qr[i] = *(const v4u*)(XB + (size_t)(t0 + i) * D + c0);
#pragma unroll
        for (int i = 0; i < 16; ++i) {
            const v4u q = qr[i];
            float x3[8] = {bflo(q.x), bfhi(q.x), bflo(q.y), bfhi(q.y), bflo(q.z), bfhi(q.z), bflo(q.w), bfhi(q.w)};
            float o[8];
#pragma unroll
            for (int c = 0; c < 8; ++c) o[c] = bias[c] + w[0][c] * xw[0][c] + w[1][c] * xw[1][c] + w[2][c] * xw[2][c] + w[3][c] * x3[c];
            v4u ov; ov.x = pk2(o[0], o[1]); ov.y = pk2(o[2], o[3]); ov.z = pk2(o[4], o[5]); ov.w = pk2(o[6], o[7]);
            *(v4u*)(XC + (size_t)(t0 + i) * D + c0) = ov;
#pragma unroll
            for (int c = 0; c < 8; ++c) { xw[0][c] = xw[1][c]; xw[1][c] = xw[2][c]; xw[2][c] = x3[c]; }
        }
    }
}

constexpr int SCH = 128, NCH = SEQ / SCH;
__device__ __forceinline__ void scan_agg_phase(Frame& F, const unsigned* AB, float* AGG) {
    for (int item = F.bx; item < BATCH * NCH; item += F.G) {
        const size_t t0 = (size_t)item * SCH; const int ch = 2 * F.tid;
        float h0 = 0.f, h1 = 0.f, A0 = 1.f, A1 = 1.f;
        const unsigned* p = AB + t0 * D + ch;
        v2u qa[8], qb[8];
#pragma unroll
        for (int k = 0; k < 8; ++k) qa[k] = *(const v2u*)(p + (size_t)k * D);
        for (int t = 0; t < SCH; t += 16) {
#pragma unroll
            for (int k = 0; k < 8; ++k) qb[k] = *(const v2u*)(p + (size_t)(t + 8 + k) * D);
#pragma unroll
            for (int k = 0; k < 8; ++k) { const float a0 = fast_exp2(bfhi(qa[k].x)), a1 = fast_exp2(bfhi(qa[k].y));
                h0 = a0 * h0 + bflo(qa[k].x); h1 = a1 * h1 + bflo(qa[k].y); A0 *= a0; A1 *= a1; }
            if (t + 16 < SCH) {
#pragma unroll
                for (int k = 0; k < 8; ++k) qa[k] = *(const v2u*)(p + (size_t)(t + 16 + k) * D); }
#pragma unroll
            for (int k = 0; k < 8; ++k) { const float a0 = fast_exp2(bfhi(qb[k].x)), a1 = fast_exp2(bfhi(qb[k].y));
                h0 = a0 * h0 + bflo(qb[k].x); h1 = a1 * h1 + bflo(qb[k].y); A0 *= a0; A1 *= a1; }
        }
        *(f32x4*)(AGG + ((size_t)item * D + ch) * 2) = (f32x4){A0, h0, A1, h1};
    }
}
__device__ __forceinline__ void scan_out_phase(Frame& F, const unsigned* AB, const float* AGG, const bf16* Y, bf16* HY) {
    for (int item = F.bx; item < BATCH * NCH; item += F.G) {
        const int c = item & (NCH - 1); const size_t t0 = (size_t)item * SCH; const int ch = 2 * F.tid;
        float h0 = 0.f, h1 = 0.f;
        const float* ag = AGG + ((size_t)(item - c) * D + ch) * 2;
        const unsigned* p = AB + t0 * D + ch; const bf16* yp = Y + t0 * D + ch; bf16* op = HY + t0 * D + ch;
        v2u qa[8], qb[8]; unsigned ya[8], yb[8];
#pragma unroll
        for (int k = 0; k < 8; ++k) { qa[k] = *(const v2u*)(p + (size_t)k * D); ya[k] = *(const unsigned*)(yp + (size_t)k * D); }
        { int cc = 0;
          for (; cc + 8 <= c; cc += 8) { f32x4 g[8];
#pragma unroll
              for (int k = 0; k < 8; ++k) g[k] = *(const f32x4*)(ag + (size_t)(cc + k) * D * 2);
#pragma unroll
              for (int k = 0; k < 8; ++k) { h0 = g[k].x * h0 + g[k].y; h1 = g[k].z * h1 + g[k].w; } }
          for (; cc < c; ++cc) { const f32x4 g = *(const f32x4*)(ag + (size_t)cc * D * 2); h0 = g.x * h0 + g.y; h1 = g.z * h1 + g.w; } }
        for (int t = 0; t < SCH; t += 16) {
#pragma unroll
            for (int k = 0; k < 8; ++k) { qb[k] = *(const v2u*)(p + (size_t)(t + 8 + k) * D); yb[k] = *(const unsigned*)(yp + (size_t)(t + 8 + k) * D); }
            unsigned oa[8];
#pragma unroll
            for (int k = 0; k < 8; ++k) { const float a0 = fast_exp2(bfhi(qa[k].x)), a1 = fast_exp2(bfhi(qa[k].y));
                h0 = a0 * h0 + bflo(qa[k].x); h1 = a1 * h1 + bflo(qa[k].y); oa[k] = pk2(h0 * bflo(ya[k]), h1 * bfhi(ya[k])); }
            if (t + 16 < SCH) {
#pragma unroll
                for (int k = 0; k < 8; ++k) { qa[k] = *(const v2u*)(p + (size_t)(t + 16 + k) * D); ya[k] = *(const unsigned*)(yp + (size_t)(t + 16 + k) * D); } }
#pragma unroll
            for (int k = 0; k < 8; ++k) *(unsigned*)(op + (size_t)(t + k) * D) = oa[k];
#pragma unroll
            for (int k = 0; k < 8; ++k) { const float a0 = fast_exp2(bfhi(qb[k].x)), a1 = fast_exp2(bfhi(qb[k].y));
                h0 = a0 * h0 + bflo(qb[k].x); h1 = a1 * h1 + bflo(qb[k].y); oa[k] = pk2(h0 * bflo(yb[k]), h1 * bfhi(yb[k])); }
#pragma unroll
            for (int k = 0; k < 8; ++k) *(unsigned*)(op + (size_t)(t + 8 + k) * D) = oa[k];
        }
    }
}

__device__ __forceinline__ void moe_build_phase(Frame& F, const unsigned* TOPE, const float* TOPW, unsigned* CNT, unsigned* LIST, float* LISTW, unsigned* TILE, unsigned* NTL) {
    LAS int* sh = (LAS int*)(F.lds);
    const int bx = F.bx;
    { const int slot = F.tid & 15, grp = F.tid >> 4; int tot = 0, off = 0;
      for (int c = grp; c < F.G; c += 32) { const int v = (int)__hip_atomic_load(CNT + c * 16 + slot, RLX_AGENT); if (c < bx) off += v; tot += v; }
      sh[128 + grp * 16 + slot] = tot; sh[128 + 512 + grp * 16 + slot] = off; }
    __syncthreads();
    if (F.tid < 16) { int tot = 0, off = 0; for (int g2 = 0; g2 < 32; ++g2) { tot += sh[128 + g2 * 16 + F.tid]; off += sh[128 + 512 + g2 * 16 + F.tid]; } sh[F.tid] = tot; sh[16 + F.tid] = off; }
    __syncthreads();
    if (F.tid < 2) { const int p = F.tid; int a = 0; for (int e = 0; e < 8; ++e) { sh[32 + p * 8 + e] = a; a += (sh[p * 8 + e] + 255) & ~255; } sh[48 + p] = a >> 8; }
    __syncthreads();
    const int p = F.tid >> 8, i = F.tid & 255, t = bx * 256 + i;
    const unsigned te = TOPE[t]; const int e = (int)((te >> (8 * p)) & 0xffu); const float w = TOPW[2 * (size_t)t + p];
    int rank = 0;
    const unsigned long long lt = (F.lane == 0) ? 0ull : (~0ull >> (64 - F.lane));
#pragma unroll
    for (int ee = 0; ee < 8; ++ee) { const unsigned long long mk = __ballot(e == ee); if (e == ee) rank = __popcll(mk & lt); if (F.lane == 0) sh[64 + F.wave * 8 + ee] = __popcll(mk); }
    __syncthreads();
    int wpre = 0; for (int w2 = (F.wave & 4); w2 < F.wave; ++w2) wpre += sh[64 + w2 * 8 + e];
    const int pos = sh[32 + p * 8 + e] + sh[16 + p * 8 + e] + wpre + rank;
    LIST[(size_t)p * LISTCAP + pos] = (unsigned)t | 0x80000000u; LISTW[(size_t)p * LISTCAP + pos] = w;
    if (bx < 16) { const int pp = bx >> 3, ee = bx & 7; const int st = sh[32 + pp * 8 + ee], n = sh[pp * 8 + ee], cap = (n + 255) & ~255;
        for (int k = n + F.tid; k < cap; k += NWAVES * 64) { LIST[(size_t)pp * LISTCAP + st + k] = 0u; LISTW[(size_t)pp * LISTCAP + st + k] = 0.f; }
        for (int k = F.tid; k < (cap >> 8); k += NWAVES * 64) TILE[pp * 272 + (st >> 8) + k] = (unsigned)ee;
        if (ee == 0 && F.tid == 0) NTL[pp] = (unsigned)sh[48 + pp]; }
    __syncthreads();
}

namespace fa {
constexpr int KSLOT = 10240, VSLOT = 8192, NKS = 4, NVS = 3;
constexpr int L_K = 0, L_V = NKS * KSLOT, L_WS = L_V + NVS * VSLOT, L_OST = L_WS + NWAVES * 256, L_END = L_OST + NWAVES * 4096;
__device__ __forceinline__ int crow(int r, int hi) { return (r & 3) + 8 * (r >> 2) + 4 * hi; }
__device__ __forceinline__ void glds16(const void* gsrc, unsigned lds_dst) { unsigned keep;
    asm volatile("s_mov_b32 %0, m0\n\ts_mov_b32 m0, %2\n\ts_nop 0\n\tglobal_load_lds_dwordx4 %1, off\n\ts_mov_b32 m0, %0" : "=&s"(keep) : "v"(gsrc), "s"(lds_dst) : "memory"); }
__device__ __forceinline__ void glds16s(const void* sbase, unsigned voff, unsigned lds_dst) { unsigned keep;
    asm volatile("s_mov_b32 %0, m0\n\ts_mov_b32 m0, %3\n\ts_nop 0\n\tglobal_load_lds_dwordx4 %1, %2\n\ts_mov_b32 m0, %0" : "=&s"(keep) : "v"(voff), "s"(sbase), "s"(lds_dst) : "memory"); }
__device__ __forceinline__ void glds4(const void* gsrc, unsigned lds_dst) { unsigned keep;
    asm volatile("s_mov_b32 %0, m0\n\ts_mov_b32 m0, %2\n\ts_nop 0\n\tglobal_load_lds_dword %1, off\n\ts_mov_b32 m0, %0" : "=&s"(keep) : "v"(gsrc), "s"(lds_dst) : "memory"); }
#define FA_WAIT_BAR() asm volatile("s_waitcnt vmcnt(0) lgkmcnt(0)\n\ts_barrier" ::: "memory")

__device__ __forceinline__ void qkt(f32x16& p0, f32x16& p1, const LAS unsigned char* kb, const bf16x8 (&qr)[5]) {
    p0 = f32x16{}; p1 = f32x16{};
#pragma unroll
    for (int d0 = 0; d0 < 5; ++d0) {
        const bf16x8 b0 = *(const LAS bf16x8*)(kb + d0 * 2048);
        const bf16x8 b1 = *(const LAS bf16x8*)(kb + d0 * 2048 + 512);
        p0 = __builtin_amdgcn_mfma_f32_32x32x16_bf16(b0, qr[d0], p0, 0, 0, 0); p1 = __builtin_amdgcn_mfma_f32_32x32x16_bf16(b1, qr[d0], p1, 0, 0, 0); }
}

__device__ __forceinline__ void attn_unit(int b, int h, int qb, const bf16* Q, const bf16* K, const bf16* V, const bf16* Gt, bf16* O, const bf16* QX, const bf16* KX, LAS unsigned char* lds, unsigned lds0, int tid, int t0, gu32* qhead, LAS unsigned* uq) {
    const int lane = tid & 63, r32 = lane & 31, hi = lane >> 5; const int wid = __builtin_amdgcn_readfirstlane(tid >> 6);
    const size_t rowbase = (size_t)b * SEQ; const int q0 = qb * 256; const int bh = b * NH + h;
    const bf16* Qw = Q + (rowbase + q0 + wid * 32) * D + h * HD;
    const bf16* Kh = K + rowbase * D + h * HD; const bf16* Vh = V + rowbase * D + h * HD;
    const int NT = (q0 + 256) / 64;
    t0 -= (NT - t0) & 1;
    const bf16* ksrc = Kh + (size_t)lane * D + wid * 8;
    const bf16* vsrc = Vh + (size_t)(16 * (wid & 3) + (lane >> 2)) * D + (wid >> 2) * 32 + (lane & 3) * 8;
    const bf16* xsrc = KX + ((size_t)bh * SEQ + lane) * 16 + (wid & 1) * 8;
    const unsigned kdst = lds0 + L_K + wid * 1024, vdst = lds0 + L_V + wid * 1024, xdst = lds0 + L_K + 8192 + (wid & 1) * 1024;
#define FA_DMAK(t_) do { const int sk_ = ((t_) % NKS); \
        glds16(ksrc + (size_t)(t_) * 64 * D, (unsigned)__builtin_amdgcn_readfirstlane((int)(kdst + sk_ * KSLOT))); \
        if (wid < 2) glds16(xsrc + (size_t)(t_) * 64 * 16, (unsigned)__builtin_amdgcn_readfirstlane((int)(xdst + sk_ * KSLOT))); } while (0)
#define FA_DMAV(t_) do { const int sv_ = ((t_) % NVS); \
        glds16(vsrc + (size_t)(t_) * 64 * D, (unsigned)__builtin_amdgcn_readfirstlane((int)(vdst + sv_ * VSLOT))); } while (0)
    FA_DMAK(t0); FA_DMAV(t0);
    if (t0 + 1 < NT) FA_DMAK(t0 + 1);
    if (t0 + 2 < NT) FA_DMAK(t0 + 2);
    bf16x8 qr[5];
#pragma unroll
    for (int d0 = 0; d0 < 4; ++d0) qr[d0] = *(const bf16x8*)(Qw + (size_t)r32 * D + d0 * 16 + hi * 8);
    { const bf16x8 qx = *(const bf16x8*)(QX + ((size_t)bh * SEQ + q0 + wid * 32 + r32) * 8); qr[4] = hi ? (bf16x8){0, 0, 0, 0, 0, 0, 0, 0} : qx; }
    f32x16 o[2]; o[0] = f32x16{}; o[1] = f32x16{};
    float lsum = 0.f;
    const int qrel = wid * 32 + r32;
    const LAS unsigned char* kbase = lds + L_K + hi * 1024 + r32 * 16;
    const LAS unsigned char* vbp = lds + L_V + ((lane >> 4) & 1) * 32 + (lane & 3) * 8 + (4 * hi + ((lane & 15) >> 2)) * 64;
    FA_WAIT_BAR();
#define FA_SB() __builtin_amdgcn_sched_barrier(0)
#define FA_EX4(P, B) do { P[B] = fast_exp2(P[B]); P[B + 1] = fast_exp2(P[B + 1]); P[B + 2] = fast_exp2(P[B + 2]); P[B + 3] = fast_exp2(P[B + 3]); asm volatile("" : "+v"(P)); } while (0)
#define FA_KLD(j, T_) do { const LAS unsigned char* kb_ = kbase + ((T_) % NKS) * KSLOT; kf[2 * (j)] = *(const LAS bf16x8*)(kb_ + (j) * 2048); kf[2 * (j) + 1] = *(const LAS bf16x8*)(kb_ + (j) * 2048 + 512); } while (0)
#define FA_MASK(C0, C1, T_) do { if ((T_) >= NT - 4) { const int kb2_ = 64 * (T_) - q0 + 4 * hi; \
        _Pragma("unroll") for (int r = 0; r < 16; ++r) { const int kv = kb2_ + (r & 3) + 8 * (r >> 2); if (kv > qrel) C0[r] = -INFINITY; if (kv + 32 > qrel) C1[r] = -INFINITY; } } } while (0)
#define FA_VRD(i, VB) do { lo[i] = __builtin_bit_cast(s16x4, __builtin_amdgcn_ds_read_tr16_b64_v4i16((LAS s16x4*)((VB) + ((i) >> 2) * 4096 + ((i) & 3) * 1024))); \
        hh[i] = __builtin_bit_cast(s16x4, __builtin_amdgcn_ds_read_tr16_b64_v4i16((LAS s16x4*)((VB) + ((i) >> 2) * 4096 + ((i) & 3) * 1024 + 512))); } while (0)
#define FA_PK(k) (bf16x8){lo[k][0], lo[k][1], lo[k][2], lo[k][3], hh[k][0], hh[k][1], hh[k][2], hh[k][3]}
#define FA_AD4(P, B) do { sacc += (P[B] + P[B + 1]) + (P[B + 2] + P[B + 3]); asm volatile("" : "+v"(sacc)); } while (0)
#define FA_ENDWAIT(T_) do { const int nfl_ = (((T_) + 3 < NT) ? ((wid < 2) ? 2 : 1) : 0) + (((T_) + 1 < NT) ? 1 : 0); \
        if (nfl_ == 3) asm volatile("s_waitcnt vmcnt(3) lgkmcnt(0)\n\ts_barrier" ::: "memory"); \
        else if (nfl_ == 2) asm volatile("s_waitcnt vmcnt(2) lgkmcnt(0)\n\ts_barrier" ::: "memory"); \
        else if (nfl_ == 1) asm volatile("s_waitcnt vmcnt(1) lgkmcnt(0)\n\ts_barrier" ::: "memory"); \
        else FA_WAIT_BAR(); } while (0)
    bf16x8 kf[10];
    f32x16 c0, c1;
    s16x4 lo[8], hh[8]; v4u pw0, pw1, pw2, pw3;
    {
#pragma unroll
        for (int j = 0; j < 5; ++j) FA_KLD(j, t0);
        c0 = f32x16{}; c1 = f32x16{};
#pragma unroll
        for (int d0 = 0; d0 < 5; ++d0) { c0 = __builtin_amdgcn_mfma_f32_32x32x16_bf16(kf[2 * d0], qr[d0], c0, 0, 0, 0); c1 = __builtin_amdgcn_mfma_f32_32x32x16_bf16(kf[2 * d0 + 1], qr[d0], c1, 0, 0, 0); }
        FA_SB();
        if (t0 + 3 < NT) FA_DMAK(t0 + 3);
        if (t0 + 1 < NT) FA_DMAV(t0 + 1);
        FA_MASK(c0, c1, t0);
        FA_EX4(c0, 0); FA_EX4(c0, 4); FA_EX4(c0, 8); FA_EX4(c0, 12); FA_EX4(c1, 0); FA_EX4(c1, 4); FA_EX4(c1, 8); FA_EX4(c1, 12);
        if (t0 + 1 < NT) {
#pragma unroll
            for (int j = 0; j < 3; ++j) FA_KLD(j, t0 + 1);
        }
        FA_SB(); FA_ENDWAIT(t0); FA_SB();
    }
#define FA_STEP(T_, C0, C1, P0, P1) do { \
        const LAS unsigned char* vb = vbp + (((T_) - 1) % NVS) * VSLOT; \
        float sacc = 0.f; \
        FA_VRD(0, vb); FA_SB(); C0 = __builtin_amdgcn_mfma_f32_32x32x16_bf16(kf[0], qr[0], f32x16{}, 0, 0, 0); FA_AD4(P0, 0); pw0.x = cvt_pk_bf16(P0[0], P0[1]); pw0.y = cvt_pk_bf16(P0[2], P0[3]); FA_SB(); \
        FA_VRD(4, vb); FA_SB(); C1 = __builtin_amdgcn_mfma_f32_32x32x16_bf16(kf[1], qr[0], f32x16{}, 0, 0, 0); FA_AD4(P0, 4); pw0.z = cvt_pk_bf16(P0[4], P0[5]); pw0.w = cvt_pk_bf16(P0[6], P0[7]); FA_SB(); \
        FA_KLD(3, (T_)); FA_SB(); \
        FA_VRD(1, vb); FA_SB(); C0 = __builtin_amdgcn_mfma_f32_32x32x16_bf16(kf[2], qr[1], C0, 0, 0, 0); FA_AD4(P0, 8); pw1.x = cvt_pk_bf16(P0[8], P0[9]); pw1.y = cvt_pk_bf16(P0[10], P0[11]); FA_SB(); \
        FA_VRD(5, vb); FA_SB(); C1 = __builtin_amdgcn_mfma_f32_32x32x16_bf16(kf[3], qr[1], C1, 0, 0, 0); FA_AD4(P0, 12); pw1.z = cvt_pk_bf16(P0[12], P0[13]); pw1.w = cvt_pk_bf16(P0[14], P0[15]); FA_SB(); \
        FA_KLD(4, (T_)); FA_SB(); \
        FA_VRD(2, vb); FA_SB(); C0 = __builtin_amdgcn_mfma_f32_32x32x16_bf16(kf[4], qr[2], C0, 0, 0, 0); FA_AD4(P1, 0); pw2.x = cvt_pk_bf16(P1[0], P1[1]); pw2.y = cvt_pk_bf16(P1[2], P1[3]); FA_SB(); \
        FA_VRD(6, vb); FA_SB(); C1 = __builtin_amdgcn_mfma_f32_32x32x16_bf16(kf[5], qr[2], C1, 0, 0, 0); FA_AD4(P1, 4); pw2.z = cvt_pk_bf16(P1[4], P1[5]); pw2.w = cvt_pk_bf16(P1[6], P1[7]); FA_SB(); \
        FA_VRD(3, vb); FA_SB(); C0 = __builtin_amdgcn_mfma_f32_32x32x16_bf16(kf[6], qr[3], C0, 0, 0, 0); FA_AD4(P1, 8); pw3.x = cvt_pk_bf16(P1[8], P1[9]); pw3.y = cvt_pk_bf16(P1[10], P1[11]); FA_SB(); \
        FA_VRD(7, vb); FA_SB(); C1 = __builtin_amdgcn_mfma_f32_32x32x16_bf16(kf[7], qr[3], C1, 0, 0, 0); FA_AD4(P1, 12); pw3.z = cvt_pk_bf16(P1[12], P1[13]); pw3.w = cvt_pk_bf16(P1[14], P1[15]); FA_SB(); \
        C0 = __builtin_amdgcn_mfma_f32_32x32x16_bf16(kf[8], qr[4], C0, 0, 0, 0); \
        C1 = __builtin_amdgcn_mfma_f32_32x32x16_bf16(kf[9], qr[4], C1, 0, 0, 0); FA_SB(); \
        lsum += sacc; \
        if ((T_) + 3 < NT) FA_DMAK((T_) + 3); \
        if ((T_) + 1 < NT) FA_DMAV((T_) + 1); \
        FA_MASK(C0, C1, (T_)); \
        FA_SB(); \
        const bool more = ((T_) + 1 < NT); \
        o[0] = __builtin_amdgcn_mfma_f32_32x32x16_bf16(__builtin_bit_cast(bf16x8, pw0), FA_PK(0), o[0], 0, 0, 0); FA_EX4(C0, 0); FA_SB(); \
        o[1] = __builtin_amdgcn_mfma_f32_32x32x16_bf16(__builtin_bit_cast(bf16x8, pw0), FA_PK(4), o[1], 0, 0, 0); FA_EX4(C0, 4); FA_SB(); \
        if (more) FA_KLD(0, (T_) + 1); FA_SB(); \
        o[0] = __builtin_amdgcn_mfma_f32_32x32x16_bf16(__builtin_bit_cast(bf16x8, pw1), FA_PK(1), o[0], 0, 0, 0); FA_EX4(C0, 8); FA_SB(); \
        if (more) FA_KLD(1, (T_) + 1); FA_SB(); \
        o[1] = __builtin_amdgcn_mfma_f32_32x32x16_bf16(__builtin_bit_cast(bf16x8, pw1), FA_PK(5), o[1], 0, 0, 0); FA_EX4(C0, 12); FA_SB(); \
        if (more) FA_KLD(2, (T_) + 1); FA_SB(); \
        o[0] = __builtin_amdgcn_mfma_f32_32x32x16_bf16(__builtin_bit_cast(bf16x8, pw2), FA_PK(2), o[0], 0, 0, 0); FA_EX4(C1, 0); FA_SB(); \
        o[1] = __builtin_amdgcn_mfma_f32_32x32x16_bf16(__builtin_bit_cast(bf16x8, pw2), FA_PK(6), o[1], 0, 0, 0); FA_EX4(C1, 4); FA_SB(); \
        o[0] = __builtin_amdgcn_mfma_f32_32x32x16_bf16(__builtin_bit_cast(bf16x8, pw3), FA_PK(3), o[0], 0, 0, 0); FA_EX4(C1, 8); FA_SB(); \
        o[1] = __builtin_amdgcn_mfma_f32_32x32x16_bf16(__builtin_bit_cast(bf16x8, pw3), FA_PK(7), o[1], 0, 0, 0); FA_EX4(C1, 12); FA_SB(); \
        FA_ENDWAIT((T_)); FA_SB(); \
    } while (0)
    f32x16 d0, d1;
    int t = t0 + 1;
    FA_STEP(t, d0, d1, c0, c1); ++t;
    for (; t + 1 < NT; t += 2) { FA_STEP(t, c0, c1, d0, d1); FA_STEP(t + 1, d0, d1, c0, c1); }
#undef FA_STEP
    {
        const LAS unsigned char* vb = vbp + ((NT - 1) % NVS) * VSLOT;
#pragma unroll
        for (int i = 0; i < 8; ++i) FA_VRD(i, vb);
        float sacc = 0.f;
        FA_AD4(d0, 0); FA_AD4(d0, 4); FA_AD4(d0, 8); FA_AD4(d0, 12); FA_AD4(d1, 0); FA_AD4(d1, 4); FA_AD4(d1, 8); FA_AD4(d1, 12);
        lsum += sacc;
        pw0 = (v4u){cvt_pk_bf16(d0[0], d0[1]), cvt_pk_bf16(d0[2], d0[3]), cvt_pk_bf16(d0[4], d0[5]), cvt_pk_bf16(d0[6], d0[7])};
        pw1 = (v4u){cvt_pk_bf16(d0[8], d0[9]), cvt_pk_bf16(d0[10], d0[11]), cvt_pk_bf16(d0[12], d0[13]), cvt_pk_bf16(d0[14], d0[15])};
        pw2 = (v4u){cvt_pk_bf16(d1[0], d1[1]), cvt_pk_bf16(d1[2], d1[3]), cvt_pk_bf16(d1[4], d1[5]), cvt_pk_bf16(d1[6], d1[7])};
        pw3 = (v4u){cvt_pk_bf16(d1[8], d1[9]), cvt_pk_bf16(d1[10], d1[11]), cvt_pk_bf16(d1[12], d1[13]), cvt_pk_bf16(d1[14], d1[15])};
        FA_SB();
        o[0] = __builtin_amdgcn_mfma_f32_32x32x16_bf16(__builtin_bit_cast(bf16x8, pw0), FA_PK(0), o[0], 0, 0, 0);
        o[1] = __builtin_amdgcn_mfma_f32_32x32x16_bf16(__builtin_bit_cast(bf16x8, pw0), FA_PK(4), o[1], 0, 0, 0);
        o[0] = __builtin_amdgcn_mfma_f32_32x32x16_bf16(__builtin_bit_cast(bf16x8, pw1), FA_PK(1), o[0], 0, 0, 0);
        o[1] = __builtin_amdgcn_mfma_f32_32x32x16_bf16(__builtin_bit_cast(bf16x8, pw1), FA_PK(5), o[1], 0, 0, 0);
        o[0] = __builtin_amdgcn_mfma_f32_32x32x16_bf16(__builtin_bit_cast(bf16x8, pw2), FA_PK(2), o[0], 0, 0, 0);
        o[1] = __builtin_amdgcn_mfma_f32_32x32x16_bf16(__builtin_bit_cast(bf16x8, pw2), FA_PK(6), o[1], 0, 0, 0);
        o[0] = __builtin_amdgcn_mfma_f32_32x32x16_bf16(__builtin_bit_cast(bf16x8, pw3), FA_PK(3), o[0], 0, 0, 0);
        o[1] = __builtin_amdgcn_mfma_f32_32x32x16_bf16(__builtin_bit_cast(bf16x8, pw3), FA_PK(7), o[1], 0, 0, 0);
        FA_SB();
    }
#undef FA_SB
#undef FA_EX4
#undef FA_KLD
#undef FA_MASK
#undef FA_VRD
#undef FA_PK
#undef FA_AD4
#undef FA_ENDWAIT
#undef FA_DMAK
#undef FA_DMAV
    unsigned nxt_ticket = 0u; if (tid == 0) nxt_ticket = __hip_atomic_fetch_add(qhead, 1u, RLX_AGENT);
    bf16* Ow = O + (rowbase + q0 + wid * 32) * D + h * HD; const bf16* Gw = Gt + (rowbase + q0 + wid * 32) * D + h * HD;
    v4u gq4[4];
#pragma unroll
    for (int i = 0; i < 4; ++i) gq4[i] = *(const v4u*)(Gw + (size_t)(i * 8 + (lane >> 3)) * D + (lane & 7) * 8);
    { auto rr = __builtin_amdgcn_permlane32_swap(__float_as_uint(lsum), __float_as_uint(lsum), false, false); lsum = __uint_as_float(rr[0]) + __uint_as_float(rr[1]); }
    LAS float* wsf = (LAS float*)(lds + L_WS) + wid * 64;
    if (hi == 0) wsf[r32] = lsum;
    asm volatile("s_waitcnt lgkmcnt(0)" ::: "memory");
    float rli[16];
#pragma unroll
    for (int r = 0; r < 16; ++r) rli[r] = fast_rcp(wsf[crow(r, hi)]);
    LAS bf16* stg = (LAS bf16*)(lds + L_OST) + wid * 2048;
#pragma unroll
    for (int r = 0; r < 16; ++r) { const int orow = crow(r, hi);
#pragma unroll
        for (int d0 = 0; d0 < 2; ++d0) stg[orow * 64 + d0 * 32 + r32] = (bf16)f2bf(o[d0][r] * rli[r]); }
    asm volatile("s_waitcnt lgkmcnt(0)" ::: "memory");
#pragma unroll
    for (int i = 0; i < 4; ++i) { const int row = i * 8 + (lane >> 3), chn = lane & 7; const v4u v = *(const LAS v4u*)(stg + row * 64 + chn * 8); const v4u gq = gq4[i];
        v4u w; w.x = pk2(bflo(v.x) * bflo(gq.x), bfhi(v.x) * bfhi(gq.x)); w.y = pk2(bflo(v.y) * bflo(gq.y), bfhi(v.y) * bfhi(gq.y)); w.z = pk2(bflo(v.z) * bflo(gq.z), bfhi(v.z) * bfhi(gq.z)); w.w = pk2(bflo(v.w) * bflo(gq.w), bfhi(v.w) * bfhi(gq.w));
        *(v4u*)(Ow + (size_t)row * D + chn * 8) = w; }
    if (tid == 0) *uq = nxt_ticket;
    FA_WAIT_BAR();
}
}

__device__ __forceinline__ void attn_phase(Frame& F, const bf16* Q, const bf16* K, const bf16* V, const bf16* Gt, bf16* O, const bf16* QX, const bf16* KX, const int* T0, const float* bfv, gu32* qctr) {
    const unsigned lds0 = (unsigned)(uintptr_t)F.ldsg;
    int myrank = 99;
    if (F.lane < NH) { const float mine = bfv[F.lane]; myrank = 0; for (int h2 = 0; h2 < NH; ++h2) { const float o = bfv[h2]; myrank += (o > mine || (o == mine && h2 < F.lane)) ? 1 : 0; } }
    LAS unsigned* uq = (LAS unsigned*)(F.lds + fa::L_END);
    const int x0 = (int)(xb_xcc_id() & 7u);
    LAS int* t0tab = (LAS int*)(F.lds + fa::L_END + 64);
    for (int qi = 0; qi < BATCH; ++qi) {
        const int b = (x0 + qi) & (BATCH - 1);
        __syncthreads();
        t0tab[F.tid] = __hip_atomic_load(T0 + b * NH * 32 + F.tid, RLX_AGENT);
        if (F.tid == 0) *uq = __hip_atomic_fetch_add(qctr + b, 1u, RLX_AGENT);
        __syncthreads();
        for (;;) {
            const int u = __builtin_amdgcn_readfirstlane((int)*uq);
            if (u >= NH * 32) break;
            const int r = u >> 5, qb = 31 - (u & 31);
            const unsigned long long mk_ = __ballot(myrank == r);
            const int h = __builtin_amdgcn_readfirstlane((int)__builtin_ctzll(mk_));
            const int t0 = __builtin_amdgcn_readfirstlane(t0tab[h * 32 + qb]);
            fa::attn_unit(b, h, qb, Q, K, V, Gt, O, QX, KX, F.lds, lds0, F.tid, t0, qctr + b, uq);
        }
    }
}

constexpr int NPH_PAIR = 19, NPH = 2 * NPH_PAIR;
#define OPAQUE_S(x) asm volatile("" : "+s"(x))
__global__ void __launch_bounds__(NWAVES * 64, 2) trunk_fwd(Args args) {
    extern __shared__ __attribute__((aligned(16))) unsigned char lds_raw[];
    const int tid0 = threadIdx.x;
    volatile LAS unsigned* MISC = (volatile LAS unsigned*)((LAS unsigned char*)lds_raw + MISC_OFF);
    for (int u = tid0; u < (LDS_BYTES - RING_BYTES) / 4; u += NWAVES * 64) ((LAS unsigned*)((LAS unsigned char*)lds_raw + RING_BYTES))[u] = 0u;
    __syncthreads();
    const int lo = args.ph_lo, hi = args.ph_hi;
    const bool use_bar = (hi - lo) > 1;
    XcdBarrier bar; bar.bar = (unsigned*)(args.ws + WS_CTL) + CW_BAR; bar.x = 0; bar.st = nullptr;
    if (use_bar) bar = xcd_barrier_post((unsigned*)(args.ws + WS_CTL) + CW_BAR, MISC + 8);

#ifndef PROBE_NULL_EPI
#define PROBE_NULL_EPI 0
#endif
#ifndef PROBE_DUP_MASK
#define PROBE_DUP_MASK 0u
#endif
#define PHASE(k) (lo <= base + (k) && base + (k) < hi)
#define DUP(k) (((PROBE_DUP_MASK) >> (k)) & 1u)
#define PHASE_FOR(k) for (int rep_ = 0; rep_ < (PHASE(k) ? 1 + (int)DUP(k) : 0); ++rep_)
#define SEAM(k) do { if (PHASE(k) && base + (k) + 1 < hi) xcd_barrier(bar); } while (0)
#define PH_BEGIN if (rep_) xcd_barrier(bar); unsigned char* ws = args.ws; OPAQUE_S(ws); int bx = blockIdx.x; OPAQUE_S(bx); float* xo = args.out; OPAQUE_S(xo); \
        Frame F; { int t_ = threadIdx.x; asm volatile("" : "+v"(t_)); F.lds = (LAS unsigned char*)lds_raw; F.ldsg = lds_raw; F.tid = t_; F.lane = t_ & 63; F.wave = __builtin_amdgcn_readfirstlane(t_ >> 6); \
          F.G = gridDim.x; F.bx = bx; F.vcu = (F.G % 8 == 0) ? (bx % 8) * (F.G / 8) + bx / 8 : bx; } \
        unsigned char* act = ws + WS_ACT; unsigned char* wl = ws + WS_WL; unsigned char* wf = ws + WS_WF; unsigned char* small = ws + WS_SMALL; bf16* HN = (bf16*)(ws + WS_HN); (void)act; (void)wl; (void)wf; (void)small; (void)HN; (void)bx; (void)xo;

    for (int j = 0; j < 2; ++j) {
        const int base = j * NPH_PAIR;
        PHASE_FOR(0) { PH_BEGIN
            cvt_phase<false>(F, j, wl);
            cvt_phase<true>(F, j, wf);
            if (bx == 0) { float* C8 = (float*)(small + SM_C8); const float* ll = inp(10) + (size_t)j * D; for (int c = F.tid; c < D; c += NWAVES * 64) { const float L = ll[c]; C8[c] = 8.0f * LOG2E * log1pf(__expf(-L)); } }
            if (bx == 1) { bf16* Wf = (bf16*)(wf + WF_IN) + (size_t)4 * D * D; unsigned char* Wf8 = (unsigned char*)(wf + WF_IN) + (size_t)4 * D * D; const float* src = inp(12) + (size_t)j * D * (4 * D + NH) + 4 * D;
                const bool f8 = FP8_FOXIN_J1 && (j == 1 || FP8_FOXIN_J0);
                for (int k = F.tid; k < D; k += NWAVES * 64) { const f32x4* p = (const f32x4*)(src + (size_t)k * (4 * D + NH));
#pragma unroll
                    for (int q4 = 0; q4 < 4; ++q4) { const f32x4 v = p[q4];
#pragma unroll
                        for (int e = 0; e < 4; ++e) { if (f8) Wf8[(size_t)(4 * q4 + e) * D + k] = (unsigned char)(pack4_fp8(v[e], 0.f, 0.f, 0.f, 64.f) & 0xffu); else Wf[(size_t)(4 * q4 + e) * D + k] = (bf16)f2bf(v[e]); } } } }
            __syncthreads();
            if (j == 0) norm0_phase(F, inp(0), inp(1), HN, (xr_t*)xo);
        }
        SEAM(0);
        PHASE_FOR(1) { PH_BEGIN
            pg8::StaticOrder S; S.init(T / 256, 2 * D / 256, F.G, bx);
            pg8::EpiLruIn E{(bf16*)(act), (bf16*)(act + ACT_SLOT), (j == 0) ? (const float*)nullptr : (const float*)(ws + WS_SS) + 8 * (size_t)T};
            if (FP8_LRUIN_J1 && j == 1) {
                pg8::GemmT<false, false, true> g8{HN, (bf16*)(wl + WL_IN), D / 2, D / 2, D / 128, 0, (long)256 * (D / 2), nullptr, nullptr, 0, 0x7d7d7d7d, 0x79797979};
                pg8::gemm_phase<pg8::EpiLruIn, pg8::StaticOrder, pg8::GemmT<false, false, true>, true>(F.lds, g8, S, E);
            } else {
                pg8::GemmT<false, false> g{HN, (bf16*)(wl + WL_IN), D, D, D / 64, 0, (long)256 * D, nullptr, nullptr, 0};
                pg8::gemm_phase<pg8::EpiLruIn, pg8::StaticOrder, pg8::GemmT<false, false>, true>(F.lds, g, S, E);
            }
        }
        SEAM(1);
        PHASE_FOR(2) { PH_BEGIN
            conv_phase(F, (const bf16*)(act + ACT_SLOT), inp(4) + (size_t)j * 4 * D, inp(5) + (size_t)j * D, (bf16*)(act + 2 * ACT_SLOT)); }
        SEAM(2);
        PHASE_FOR(3) { PH_BEGIN
            bf16* XC = (bf16*)(act + 2 * ACT_SLOT);
            pg8::GemmT<false, false> g{XC, (bf16*)(wl + WL_G), D, 128, 2, 128, (long)256 * 128, nullptr, nullptr, 0};
            pg8::StaticOrder S; S.init(T / 256, 8, F.G, bx);
            pg8::EpiGate E{XC, inp(7) + (size_t)j * D, inp(9) + (size_t)j * D, (const float*)(small + SM_C8), (unsigned*)(act + 3 * ACT_SLOT)};
            pg8::gemm_phase<pg8::EpiGate, pg8::StaticOrder, pg8::GemmT<false, false>, true>(F.lds, g, S, E);
        }
        SEAM(3);
        PHASE_FOR(4) { PH_BEGIN scan_agg_phase(F, (const unsigned*)(act + 3 * ACT_SLOT), (float*)(ws + WS_AGG)); }
        SEAM(4);
        PHASE_FOR(5) { PH_BEGIN scan_out_phase(F, (const unsigned*)(act + 3 * ACT_SLOT), (const float*)(ws + WS_AGG), (const bf16*)(act), (bf16*)(act + ACT_SLOT)); }
        SEAM(5);
        PHASE_FOR(6) { PH_BEGIN
            pg8::GemmT<false, false> g{(bf16*)(act + ACT_SLOT), (bf16*)(wl + WL_OUT), D, D, D / 64, 0, (long)256 * D, nullptr, nullptr, 0};
            pg8::StaticOrder S; S.init(T / 256, D / 256, F.G, bx);
            pg8::EpiResid E{(const xr_t*)xo, (xr_t*)xo, inp(2) + (size_t)(2 * j) * D, HN, (float*)(ws + WS_SS), F.lds, (FP8_L2_FFN && j == 1) ? 4.f : 0.f};
            pg8::gemm_phase<pg8::EpiResid, pg8::StaticOrder, pg8::GemmT<false, false>, true>(F.lds, g, S, E);
        }
        SEAM(6);
        PHASE_FOR(7) { PH_BEGIN
            pg8::StaticOrder S; S.init(T / 256, 2 * FF / 256, F.G, bx);
            if (FP8_L2_FFN && j == 1) {
                pg8::GemmT<false, false, true> g8{HN, (bf16*)(wl + WL_W1), D / 2, D / 2, D / 128, 0, (long)256 * (D / 2), nullptr, nullptr, 0, 0x7d7d7d7d, 0x79797979};
                pg8::EpiSwiglu8 E8{(unsigned char*)(act), FF, 8.f, (const float*)(ws + WS_SS)};
                pg8::gemm_phase<pg8::EpiSwiglu8, pg8::StaticOrder, pg8::GemmT<false, false, true>, true>(F.lds, g8, S, E8);
            } else {
                pg8::GemmT<false, false> g{HN, (bf16*)(wl + WL_W1), D, D, D / 64, 0, (long)256 * D, nullptr, nullptr, 0};
                pg8::EpiSwiglu E{(bf16*)(act), FF, (const float*)(ws + WS_SS), ((EMU_FP8 >= 2 && j == 1) || EMU_FP8 >= 3) ? 8.f : 0.f};
                pg8::gemm_phase<pg8::EpiSwiglu, pg8::StaticOrder, pg8::GemmT<false, false>, true>(F.lds, g, S, E);
            }
        }
        SEAM(7);
        PHASE_FOR(8) { PH_BEGIN
            pg8::StaticOrder S; S.init(T / 256, D / 256, F.G, bx);
            pg8::EpiResid E{(const xr_t*)xo, (xr_t*)xo, inp(1) + (size_t)(2 * j + 1) * D, HN, (float*)(ws + WS_SS) + 4 * (size_t)T, F.lds, (FP8_FOXIN_J1 && (j == 1 || FP8_FOXIN_J0)) ? 4.f : 0.f};
            if (FP8_L2_FFN && j == 1) {
                pg8::GemmT<false, false, true> g8{(bf16*)(act), (bf16*)(wl + WL_W2), FF / 2, FF / 2, FF / 128, 0, (long)256 * (FF / 2), nullptr, nullptr, 0, 0x7c7c7c7c, 0x78787878};
                pg8::gemm_phase<pg8::EpiResid, pg8::StaticOrder, pg8::GemmT<false, false, true>, true>(F.lds, g8, S, E);
            } else {
                pg8::GemmT<false, false> g{(bf16*)(act), (bf16*)(wl + WL_W2), FF, FF, FF / 64, 0, (long)256 * FF, nullptr, nullptr, 0};
                pg8::gemm_phase<pg8::EpiResid, pg8::StaticOrder, pg8::GemmT<false, false>, true>(F.lds, g, S, E);
            }
        }
        SEAM(8);
        PHASE_FOR(9) { PH_BEGIN
            pg8::GemmT<false, false> g{HN, (bf16*)(wf + WF_IN), D, D, D / 64, 0, (long)256 * D, nullptr, nullptr, 0};
            pg8::StaticOrder S; S.init(T / 256, 4 * D / 256 + 1, F.G, bx);
            pg8::EpiFoxIn E{(bf16*)(act), (size_t)T * D, inp(14) + (size_t)j * HD, inp(15) + (size_t)j * HD, 0.125f * LOG2E, (const float*)(ws + WS_SS) + 4 * (size_t)T, inp(13) + (size_t)j * NH, (float*)(ws + WS_LOGF)};
#if PROBE_NULL_EPI
            if (rep_) { pg8::EpiNull E0{(float*)(ws + WS_AGG)}; pg8::gemm_phase<pg8::EpiNull, pg8::StaticOrder, pg8::GemmT<false, false>, true>(F.lds, g, S, E0); } else
#endif
            if (FP8_FOXIN_J1 && (j == 1 || FP8_FOXIN_J0)) {
                pg8::GemmT<false, false, true> g8{HN, (bf16*)(wf + WF_IN), D / 2, D / 2, D / 128, 0, (long)256 * (D / 2), nullptr, nullptr, 0, 0x7d7d7d7d, 0x79797979};
                pg8::gemm_phase<pg8::EpiFoxIn, pg8::StaticOrder, pg8::GemmT<false, false, true>, true>(F.lds, g8, S, E);
            } else
            pg8::gemm_phase<pg8::EpiFoxIn, pg8::StaticOrder, pg8::GemmT<false, false>, true>(F.lds, g, S, E);
        }
        SEAM(9);
        PHASE_FOR(10) { PH_BEGIN cumsum_phase(F, (const float*)(ws + WS_LOGF), (float*)(ws + WS_F2), (int*)(small + SM_T0), (bf16*)(act + 4 * ACT_SLOT + 32 * MiB), (bf16*)(act + 4 * ACT_SLOT), inp(14) + (size_t)j * HD, inp(15) + (size_t)j * HD); }
        SEAM(10);
        PHASE_FOR(11) { PH_BEGIN attn_phase(F, (const bf16*)(act), (const bf16*)(act + ACT_SLOT), (const bf16*)(act + 2 * ACT_SLOT), (const bf16*)(act + 3 * ACT_SLOT), HN, (const bf16*)(act + 4 * ACT_SLOT + 32 * MiB), (const bf16*)(act + 4 * ACT_SLOT), (const int*)(small + SM_T0), inp(13) + (size_t)j * NH, (gu32*)(ws + WS_CTL) + CW_QCTR + 64 * j + 16 * rep_); }
        SEAM(11);
        PHASE_FOR(12) { PH_BEGIN
            pg8::GemmT<false, false> g{HN, (bf16*)(wf + WF_OUT), D, D, D / 64, 0, (long)256 * D, nullptr, nullptr, 0};
            pg8::StaticOrder S; S.init(T / 256, D / 256, F.G, bx);
            pg8::EpiResid E{(const xr_t*)xo, (xr_t*)xo, nullptr, nullptr, nullptr, F.lds};
            pg8::gemm_phase<pg8::EpiResid, pg8::StaticOrder, pg8::GemmT<false, false>, true>(F.lds, g, S, E);
        }
        SEAM(12);
        PHASE_FOR(13) { PH_BEGIN
            if (FP8_LAST_MOE && (j == 1 || FP8_MOE_J0)) router_phase(F, (const xr_t*)xo, inp(2) + (size_t)(2 * j + 1) * D, (unsigned char*)HN, inp(20) + (size_t)j * D * NE, (unsigned*)(ws + WS_TOPE), (float*)(ws + WS_TOPW), (unsigned*)(small + SM_CNT), 4.f);
            else norm_phase<8, true>(F, xo, inp(2) + (size_t)(2 * j + 1) * D, HN, inp(20) + (size_t)j * D * NE, NE, nullptr, nullptr, (unsigned*)(ws + WS_TOPE), (float*)(ws + WS_TOPW), (unsigned*)(small + SM_CNT), (FP8_LAST_MOE && (j == 1 || FP8_MOE_J0)) ? -4.f : (((EMU_FP8 && j == 1) || EMU_FP8 >= 3) ? 4.f : 0.f)); }
        SEAM(13);
        PHASE_FOR(14) { PH_BEGIN moe_build_phase(F, (const unsigned*)(ws + WS_TOPE), (const float*)(ws + WS_TOPW), (unsigned*)(small + SM_CNT), (unsigned*)(ws + WS_LIST), (float*)(ws + WS_LISTW), (unsigned*)(small + SM_TILE) + j * 2 * 272, (unsigned*)(small + SM_NT) + j * 2); }
        SEAM(14);
#pragma unroll
        for (int p = 0; p < 2; ++p) {
            PHASE_FOR(15 + 2 * p) { PH_BEGIN
                unsigned* TILE = (unsigned*)(small + SM_TILE) + j * 2 * 272 + p * 272; unsigned* NTL = (unsigned*)(small + SM_NT) + j * 2 + p;
                const int ntl = __builtin_amdgcn_readfirstlane((int)__hip_atomic_load(NTL, RLX_AGENT));
                pg8::StaticOrder S; S.init(ntl, 2 * FF / 256, F.G, bx);
                if (FP8_LAST_MOE && (j == 1 || FP8_MOE_J0)) {
                    if (MOE_OVERLAP && p == 1) {
                        const int ntl0 = __builtin_amdgcn_readfirstlane((int)__hip_atomic_load((unsigned*)(small + SM_NT) + j * 2, RLX_AGENT));
                        const int ntail = ntl0 * (D / 256) - 4 * F.G, rnd = (ntl * (2 * FF / 256)) / F.G;
                        if (ntail > 0 && ntail <= F.G / 2 && rnd > 3) S.split(rnd - 3, ntail);
                    }
                    pg8::GemmT<true, true, true> g{HN, (bf16*)(wf + WF_W1), D / 2, D / 2, D / 128, 0, (long)256 * (D / 2), (const unsigned*)(ws + WS_LIST) + (size_t)p * LISTCAP, TILE, (long)2 * FF * (D / 2), 0x7d7d7d7d, 0x79797979};
                    pg8::EpiSwiglu8 E{(unsigned char*)(act) + (MOE_OVERLAP ? (size_t)p * LISTCAP * FF : (size_t)0), FF, 8.f};
                    pg8::gemm_phase<pg8::EpiSwiglu8, pg8::StaticOrder, pg8::GemmT<true, true, true>, true>(F.lds, g, S, E);
                } else {
                    pg8::GemmT<true, true> g{HN, (bf16*)(wf + WF_W1), D, D, D / 64, 0, (long)256 * D, (const unsigned*)(ws + WS_LIST) + (size_t)p * LISTCAP, TILE, (long)2 * FF * D};
                    pg8::EpiSwiglu E{(bf16*)(act), FF, nullptr, ((EMU_FP8 && j == 1) || EMU_FP8 >= 3) ? 8.f : 0.f};
                    pg8::gemm_phase<pg8::EpiSwiglu, pg8::StaticOrder, pg8::GemmT<true, true>, true>(F.lds, g, S, E);
                }
            }
            SEAM(15 + 2 * p);
            PHASE_FOR(16 + 2 * p) { PH_BEGIN
                unsigned* TILE = (unsigned*)(small + SM_TILE) + j * 2 * 272 + p * 272; unsigned* NTL = (unsigned*)(small + SM_NT) + j * 2 + p;
                const int ntl = __builtin_amdgcn_readfirstlane((int)__hip_atomic_load(NTL, RLX_AGENT));
                pg8::StaticOrder S; S.init(ntl, D / 256, F.G, bx);
                const bool fuse = (p == 1) && (j == 0);
                xr_t* XR2 = (xr_t*)(act + 480 * MiB);
                pg8::EpiScatter E{(j == 1 && p == 1) ? (const xr_t*)XR2 : (const xr_t*)xo, (j == 1 && p == 0) ? XR2 : (xr_t*)xo, (j == 1 && p == 1) ? xo : (float*)nullptr, (const unsigned*)(ws + WS_LIST) + (size_t)p * LISTCAP, (const float*)(ws + WS_LISTW) + (size_t)p * LISTCAP,
                                  fuse ? inp(1) + (size_t)(2 * j + 2) * D : (const float*)nullptr, fuse ? HN : (bf16*)nullptr, fuse ? (float*)(ws + WS_SS) + 8 * (size_t)T : (float*)nullptr, F.lds, FP8_LRUIN_J1 ? 4.f : 0.f};
                if (FP8_LAST_MOE && (j == 1 || FP8_MOE_J0)) {
                    pg8::GemmT<false, true, true> g{(bf16*)(act + (MOE_OVERLAP ? (size_t)p * LISTCAP * FF : (size_t)0)), (bf16*)(wf + WF_W2), FF / 2, FF / 2, FF / 128, 0, (long)256 * (FF / 2), nullptr, TILE, (long)D * (FF / 2), 0x7c7c7c7c, 0x78787878};
                    pg8::gemm_phase<pg8::EpiScatter, pg8::StaticOrder, pg8::GemmT<false, true, true>, true>(F.lds, g, S, E);
                } else {
                    pg8::GemmT<false, true> g{(bf16*)(act), (bf16*)(wf + WF_W2), FF, FF, FF / 64, 0, (long)256 * FF, nullptr, TILE, (long)D * FF};
                    pg8::gemm_phase<pg8::EpiScatter, pg8::StaticOrder, pg8::GemmT<false, true>, true>(F.lds, g, S, E);
                }
            }
            if (MOE_OVERLAP && p == 0 && FP8_LAST_MOE && (j == 1 || FP8_MOE_J0)) { if (PHASE(16) && PHASE(17)) __syncthreads(); else SEAM(16); }
            else SEAM(16 + 2 * p);
        }
    }
#undef PHASE
#undef SEAM
#undef PH_BEGIN
}

extern "C" void kernel_launch(void* const* d_in, const int* in_sizes, int n_in, void* d_out, int out_size, void* d_ws, size_t ws_size, hipStream_t stream) {
    static int grid = 0;
    if (grid == 0) {
        if (n_in != 24 || in_sizes[0] != T * D || out_size != T * D || ws_size < WS_END) { fprintf(stderr, "kernel_launch: unexpected problem (n_in %d in0 %d out %d ws %zu)\n", n_in, n_in > 0 ? in_sizes[0] : -1, out_size, ws_size); grid = -1; return; }
        int dev = 0, cus = 0, per_cu = 0;
        if (hipGetDevice(&dev) != hipSuccess || hipDeviceGetAttribute(&cus, hipDeviceAttributeMultiprocessorCount, dev) != hipSuccess) { grid = -1; return; }
        if (hipFuncSetAttribute((const void*)trunk_fwd, hipFuncAttributeMaxDynamicSharedMemorySize, LDS_BYTES) != hipSuccess) { fprintf(stderr, "kernel_launch: hipFuncSetAttribute failed\n"); grid = -1; return; }
        if (hipOccupancyMaxActiveBlocksPerMultiprocessor(&per_cu, (const void*)trunk_fwd, NWAVES * 64, LDS_BYTES) != hipSuccess || per_cu < 1)
            fprintf(stderr, "kernel_launch: occupancy query reports %d workgroups per CU\n", per_cu);
        (void)hipGetLastError();
        grid = cus;
        if (grid != 256) { fprintf(stderr, "kernel_launch: %d CUs; this kernel is built for 256\n", grid); grid = -1; return; }
    }
    if (grid < 0) return;
    if (hipMemsetAsync((char*)d_ws + WS_CTL, 0, CTL_ZERO_BYTES, stream) != hipSuccess) return;
    Args a{};
    for (int i = 0; i < 24; ++i) a.in[i] = (const float*)d_in[i];
    a.out = (float*)d_out; a.ws = (unsigned char*)d_ws;
#if MK_PER_PHASE
    for (int ph = 0; ph < NPH; ++ph) { a.ph_lo = ph; a.ph_hi = ph + 1; hipLaunchKernelGGL(trunk_fwd, dim3(grid), dim3(NWAVES * 64), LDS_BYTES, stream, a); }
#else
    a.ph_lo = 0; a.ph_hi = NPH;
    hipLaunchKernelGGL(trunk_fwd, dim3(grid), dim3(NWAVES * 64), LDS_BYTES, stream, a);
#endif
    const hipError_t le = hipPeekAtLastError();
    if (le != hipSuccess) fprintf(stderr, "kernel_launch: launch failed: %s\n", hipGetErrorName(le));
}
```

```cpp
#include <hip/hip_runtime.h>
#include <cstdio>
#include <cstdint>

#ifndef MK_PER_PHASE
#define MK_PER_PHASE 0
#endif

constexpr int BATCH = 8, SEQ = 8192, D = 1024, T = BATCH * SEQ, NH = 16, HD = 64, FF = 3584, NE = 8;
constexpr int NWAVES = 8;
constexpr float RMS_EPS = 1e-6f;
constexpr float LOG2E = 1.4426950408889634f;

#define GAS __attribute__((address_space(1)))
#define LAS __attribute__((address_space(3)))
typedef unsigned short bf16;
typedef unsigned v4u __attribute__((ext_vector_type(4)));
typedef unsigned v2u __attribute__((ext_vector_type(2)));
typedef float f32x4 __attribute__((ext_vector_type(4)));
typedef float f32x2 __attribute__((ext_vector_type(2)));
typedef float f32x16 __attribute__((ext_vector_type(16)));
typedef short bf16x8 __attribute__((ext_vector_type(8)));
typedef short s16x4 __attribute__((ext_vector_type(4)));
typedef GAS unsigned gu32;
#define RLX_AGENT __ATOMIC_RELAXED, __HIP_MEMORY_SCOPE_AGENT
#define LDS_WAIT() asm volatile("s_waitcnt lgkmcnt(0)" ::: "memory")
#define VM_WAIT() asm volatile("s_waitcnt vmcnt(0)" ::: "memory")

__device__ __forceinline__ unsigned f2bf(float f) { unsigned u = __builtin_bit_cast(unsigned, f); return (u + 0x7fffu + ((u >> 16) & 1u)) >> 16; }
__device__ __forceinline__ unsigned pk2(float lo, float hi) { unsigned r; asm("v_cvt_pk_bf16_f32 %0, %1, %2" : "=v"(r) : "v"(lo), "v"(hi)); return r; }
__device__ __forceinline__ float bflo(unsigned w) { return __builtin_bit_cast(float, w << 16); }
__device__ __forceinline__ float bfhi(unsigned w) { return __builtin_bit_cast(float, w & 0xffff0000u); }
__device__ __forceinline__ unsigned cvt_pk_bf16(float lo, float hi) { unsigned r; asm volatile("v_cvt_pk_bf16_f32 %0, %1, %2" : "=v"(r) : "v"(lo), "v"(hi)); return r; }
typedef unsigned short xr_t;
__device__ __forceinline__ void xr_unpack8(const v4u& r, f32x4& a, f32x4& b) {
    a[0] = __uint_as_float(r.x << 16); a[1] = __uint_as_float(r.x & 0xffff0000u); a[2] = __uint_as_float(r.y << 16); a[3] = __uint_as_float(r.y & 0xffff0000u);
    b[0] = __uint_as_float(r.z << 16); b[1] = __uint_as_float(r.z & 0xffff0000u); b[2] = __uint_as_float(r.w << 16); b[3] = __uint_as_float(r.w & 0xffff0000u); }
__device__ __forceinline__ v4u xr_pack8(const f32x4& a, const f32x4& b) { v4u w; w.x = cvt_pk_bf16(a[0], a[1]); w.y = cvt_pk_bf16(a[2], a[3]); w.z = cvt_pk_bf16(b[0], b[1]); w.w = cvt_pk_bf16(b[2], b[3]); return w; }
__device__ __forceinline__ float fast_exp2(float x) { return __builtin_amdgcn_exp2f(x); }
__device__ __forceinline__ float fast_rcp(float x) { return __builtin_amdgcn_rcpf(x); }
__device__ __forceinline__ float sigmoidf_(float x) { return fast_rcp(1.0f + fast_exp2(-x * LOG2E)); }
__device__ __forceinline__ float q8(float x, float sc) { const float y = fminf(fmaxf(x * sc, -448.f), 448.f); const int p = __builtin_amdgcn_cvt_pk_fp8_f32(y, y, 0, false); return __builtin_amdgcn_cvt_f32_fp8(p, 0) * (1.0f / sc); }
__device__ __forceinline__ unsigned pack4_fp8(float a, float b, float c, float d, float sc) {
    a = fminf(fmaxf(a * sc, -448.f), 448.f); b = fminf(fmaxf(b * sc, -448.f), 448.f); c = fminf(fmaxf(c * sc, -448.f), 448.f); d = fminf(fmaxf(d * sc, -448.f), 448.f);
    int p = __builtin_amdgcn_cvt_pk_fp8_f32(a, b, 0, false); p = __builtin_amdgcn_cvt_pk_fp8_f32(c, d, p, true); return (unsigned)p;
}
#ifndef EMU_FP8
#define EMU_FP8 0
#endif
#ifndef FP8_LRUIN_J1
#define FP8_LRUIN_J1 1
#endif
#ifndef FP8_FOXIN_J0
#define FP8_FOXIN_J0 1
#endif
#ifndef FP8_FOXIN_J1
#define FP8_FOXIN_J1 1
#endif
#ifndef FP8_L2_FFN
#define FP8_L2_FFN 1
#endif
#ifndef FP8_MOE_J0
#define FP8_MOE_J0 1
#endif
#ifndef MOE_OVERLAP
#define MOE_OVERLAP 1
#endif
#ifndef FP8_LAST_MOE
#define FP8_LAST_MOE 1
#endif
__device__ __forceinline__ float wave_sum(float v) {
#pragma unroll
    for (int o = 1; o < 64; o <<= 1) v += __shfl_xor(v, o);
    return v;
}

namespace pg8 {
#define PG8_LAS __attribute__((address_space(3)))
constexpr int BM = 256, BK = 64, HALF = 128, HTB = HALF * BK * 2, STAGE_BYTES = 8 * HTB, NXCD = 8, WGM = 8;
__host__ __device__ __forceinline__ int lds_byte(int r, int c) { const int st = (r >> 4) * 2 + (c >> 5), rr = r & 15, cc = c & 31, ob = rr * 64 + cc * 2; return st * 1024 + (ob ^ (((ob >> 9) & 1) << 5)); }
__host__ __device__ __forceinline__ void stage_rc(int b, int& R, int& C) { const int st = b / 1024, sb = b % 1024, swz = sb ^ (((sb >> 9) & 1) << 5); R = (st >> 1) * 16 + swz / 64; C = (st & 1) * 32 + (swz % 64) / 2; }
__host__ __device__ __forceinline__ int perm32(int rho) { const int n = rho >> 4, i = rho & 15; return 8 * (i >> 2) + 4 * n + (i & 3); }

typedef int v8i_t __attribute__((ext_vector_type(8)));
typedef int v4i_t __attribute__((ext_vector_type(4)));
__device__ __forceinline__ v8i_t cat8(bf16x8 lo, bf16x8 hi) { const v4i_t a = __builtin_bit_cast(v4i_t, lo), b = __builtin_bit_cast(v4i_t, hi); return __builtin_shufflevector(a, b, 0, 1, 2, 3, 4, 5, 6, 7); }
struct Unit { int pm, pn; };
struct StaticOrder {
    int nM, nN, nwg, G, c, isp, csk;
    __device__ void init(int nM_, int nN_, int G_, int c_) { nM = nM_; nN = nN_; nwg = nM * nN; G = G_; c = c_; isp = 0x7fffffff; csk = 0; }
    __device__ void split(int isp_, int csk_) { isp = isp_; csk = csk_; }
    __device__ bool next(int i, Unit& u) const {
        long L;
        if (i < isp) L = (long)i * G + c; else { if (c < csk) return false; L = (long)isp * G + (long)(i - isp) * (G - csk) + (c - csk); }
        if (L >= nwg) return false;
        int wgid = (int)L; { const int q = nwg / NXCD, r = nwg % NXCD, xcd = wgid % NXCD, off = wgid / NXCD; wgid = (xcd < r ? xcd * (q + 1) : r * (q + 1) + (xcd - r) * q) + off; }
        const int nig = WGM * nN, gid = wgid / nig, fm = gid * WGM, gsz = (nM - fm) < WGM ? (nM - fm) : WGM;
        u.pm = fm + ((wgid % nig) % gsz); u.pn = (wgid % nig) / gsz; return true;
    }
};

template <bool GATHER_, bool EXPERT_, bool FP8_ = false> struct GemmT {
    static constexpr bool GATHER = GATHER_, EXPERT = EXPERT_, FP8 = FP8_;
    const bf16* A; const bf16* Bt; int lda, ldb, nt;
    long a_pn, b_pn;
    const unsigned* list;
    const unsigned* tile_e; long b_e;
    int scA = 0x7f7f7f7f, scB = 0x7f7f7f7f;
    __device__ __forceinline__ const char* a_tile(const Unit& u) const { return (const char*)(A + (GATHER ? 0 : (size_t)u.pm * BM * lda) + (size_t)u.pn * a_pn); }
    __device__ __forceinline__ const char* b_tile(const Unit& u) const {
        size_t off = (size_t)u.pn * b_pn;
        if (EXPERT) { const unsigned e = (unsigned)__builtin_amdgcn_readfirstlane((int)__hip_atomic_load(tile_e + u.pm, RLX_AGENT)); off += (size_t)e * b_e; }
        return (const char*)(Bt + off);
    }
    __device__ __forceinline__ void a_voff(const Unit& u, const int (&sR)[2], const int (&sC)[2], unsigned (&vo)[2][2]) const {
        if (GATHER) {
            unsigned idx[2][2];
#pragma unroll
            for (int h = 0; h < 2; ++h)
#pragma unroll
                for (int i = 0; i < 2; ++i) idx[h][i] = list[u.pm * BM + h * HALF + sR[i]];
            asm volatile("s_waitcnt vmcnt(0)" ::: "memory");
#pragma unroll
            for (int h = 0; h < 2; ++h)
#pragma unroll
                for (int i = 0; i < 2; ++i) vo[h][i] = ((idx[h][i] & 0xffffu) * (unsigned)lda + (unsigned)sC[i]) * 2u;
        } else {
#pragma unroll
            for (int h = 0; h < 2; ++h)
#pragma unroll
                for (int i = 0; i < 2; ++i) vo[h][i] = (unsigned)((h * HALF + sR[i]) * lda + sC[i]) * 2u;
        }
    }
};

template <class Epi, class Sched, class GD, bool ALIGN_EPI>
__device__ __forceinline__ void gemm_phase(PG8_LAS unsigned char* lds, const GD& g, const Sched& S, const Epi& E) {
    int tid = threadIdx.x; asm volatile("" : "+v"(tid));
    const int wid = __builtin_amdgcn_readfirstlane(tid >> 6), lane = tid & 63, wr = wid >> 2, wc = wid & 3, fr = lane & 15, fq = lane >> 4;
    int nt = g.nt; asm volatile("" : "+s"(nt));
    int sR[2], sC[2]; unsigned voffB[2];
#pragma unroll
    for (int i = 0; i < 2; ++i) { int R, C; stage_rc(tid * 16 + i * 8192, R, C); sR[i] = R; sC[i] = C; const int Rb = Epi::PERM ? ((R & ~31) + perm32(R & 31)) : R;
        voffB[i] = (unsigned)(Rb * g.ldb + C) * 2u; }
    const size_t kstep = (size_t)(BK * 2);
    const size_t hstepB = (size_t)HALF * g.ldb * 2;
    const size_t hstepA = (size_t)HALF * g.lda * 2;
    unsigned voffA[2];
#pragma unroll
    for (int i = 0; i < 2; ++i) voffA[i] = (unsigned)(sR[i] * g.lda + sC[i]) * 2u;
    const unsigned ldsw = (unsigned)wid * 1024u;
    const int aoff = lds_byte(wr * 64 + fr, fq * 8), boff = lds_byte(wc * 32 + fr, fq * 8);
#define PG8_SA(b, h) (((b) * 2 + (h)) * HTB)
#define PG8_SB(b, h) ((4 + (b) * 2 + (h)) * HTB)
#define PG8_STAGE(bufoff, gbase, voff) do { _Pragma("unroll") for (int _i = 0; _i < 2; ++_i) \
        __builtin_amdgcn_global_load_lds((const unsigned*)((const char*)(gbase) + (voff)[_i]), (PG8_LAS unsigned*)(lds + (bufoff) + ldsw + _i * 8192), 16, 0, 0); } while (0)
#define PG8_STAGE_A(bufoff, gbase, h, VA) do { if constexpr (GD::GATHER) { PG8_STAGE(bufoff, gbase, VA[h]); } else { PG8_STAGE(bufoff, (gbase) + (h) * hstepA, voffA); } } while (0)
#define PG8_LDA(dst, b, h) do { _Pragma("unroll") for (int m = 0; m < 4; ++m) _Pragma("unroll") for (int k = 0; k < 2; ++k) dst[m][k] = *(const PG8_LAS bf16x8*)(lds + PG8_SA(b, h) + aoff + m * 2048 + k * 1024); } while (0)
#define PG8_LDB(dst, b, h) do { _Pragma("unroll") for (int n = 0; n < 2; ++n) _Pragma("unroll") for (int k = 0; k < 2; ++k) dst[n][k] = *(const PG8_LAS bf16x8*)(lds + PG8_SB(b, h) + boff + n * 2048 + k * 1024); } while (0)
#define PG8_MMA(ai, bj, At, Bt) do { __builtin_amdgcn_s_setprio(1); \
        if constexpr (GD::FP8) { _Pragma("unroll") for (int m = 0; m < 4; ++m) _Pragma("unroll") for (int n = 0; n < 2; ++n) \
            asm volatile("v_mfma_scale_f32_16x16x128_f8f6f4 %0, %1, %2, %0, %3, %4 op_sel_hi:[0,0,0]" : "+v"(acc[ai][bj][m][n]) : "v"(cat8(Bt[n][0], Bt[n][1])), "v"(cat8(At[m][0], At[m][1])), "v"(vscB), "v"(vscA)); } \
        else { _Pragma("unroll") for (int m = 0; m < 4; ++m) _Pragma("unroll") for (int n = 0; n < 2; ++n) _Pragma("unroll") for (int k = 0; k < 2; ++k) \
            acc[ai][bj][m][n] = __builtin_amdgcn_mfma_f32_16x16x32_bf16(Bt[n][k], At[m][k], acc[ai][bj][m][n], 0, 0, 0); } \
        __builtin_amdgcn_s_setprio(0); } while (0)
#define PG8_WAIT_V(n) asm volatile("s_waitcnt vmcnt(" #n ")" ::: "memory")
#define PG8_WAIT_L(n) asm volatile("s_waitcnt lgkmcnt(" #n ")" ::: "memory")
#define PG8_BAR __builtin_amdgcn_s_barrier()
#define PG8_SCHED __builtin_amdgcn_sched_barrier(0)
    Unit cur, nxt; int ui = 0;
    if (!S.next(0, cur)) return;
    int vscA = g.scA, vscB = g.scB; asm volatile("" : "+v"(vscA), "+v"(vscB));
    f32x4 acc[2][2][4][2];
#pragma unroll
    for (int a = 0; a < 2; ++a)
#pragma unroll
        for (int b = 0; b < 2; ++b)
#pragma unroll
            for (int m = 0; m < 4; ++m)
#pragma unroll
                for (int n = 0; n < 2; ++n) acc[a][b][m][n] = (f32x4){0.f, 0.f, 0.f, 0.f};
    bf16x8 At[4][2], B0[2][2], B1[2][2];
    const char* cA = g.a_tile(cur); const char* cB = g.b_tile(cur);
    unsigned vAc[2][2], vAn[2][2];
    if constexpr (GD::GATHER) g.a_voff(cur, sR, sC, vAc);
    else {
#pragma unroll
        for (int h = 0; h < 2; ++h)
#pragma unroll
            for (int i = 0; i < 2; ++i) vAc[h][i] = 0u;
    }
#pragma unroll
    for (int h = 0; h < 2; ++h)
#pragma unroll
        for (int i = 0; i < 2; ++i) vAn[h][i] = vAc[h][i];
    PG8_STAGE(PG8_SB(0, 0), cB, voffB); PG8_STAGE(PG8_SB(0, 1), cB + hstepB, voffB); PG8_STAGE_A(PG8_SA(0, 0), cA, 0, vAc); PG8_STAGE_A(PG8_SA(0, 1), cA, 1, vAc);
    if (wr == 1) PG8_BAR;
    PG8_WAIT_V(2); PG8_BAR;
    PG8_STAGE(PG8_SB(1, 0), cB + kstep, voffB); PG8_STAGE_A(PG8_SA(1, 0), cA + kstep, 0, vAc); PG8_STAGE(PG8_SB(1, 1), cB + hstepB + kstep, voffB);
    PG8_WAIT_V(6); PG8_BAR;
    for (;;) {
        const bool has_next = S.next(ui + 1, nxt);
        const char* nA = has_next ? g.a_tile(nxt) : cA; const char* nB = has_next ? g.b_tile(nxt) : cB;
        for (int t = 0; t < nt; t += 2) {
            const bool last = (t == nt - 2);
            const char* a1 = cA + (size_t)(t + 1) * kstep;
            const char* a2 = last ? nA : cA + (size_t)(t + 2) * kstep; const char* b2 = last ? nB : cB + (size_t)(t + 2) * kstep;
            const char* a3 = a2 + kstep; const char* b3 = b2 + kstep;
            if (GD::GATHER && last && has_next) g.a_voff(nxt, sR, sC, vAn);
            PG8_LDB(B0, 0, 0); PG8_LDB(B1, 0, 1); PG8_SCHED; PG8_LDA(At, 0, 0); PG8_STAGE_A(PG8_SA(1, 1), a1, 1, vAc);
            PG8_WAIT_V(8); PG8_WAIT_L(0); PG8_BAR; PG8_MMA(0, 0, At, B0); PG8_MMA(0, 1, At, B1); PG8_BAR; PG8_SCHED;
            PG8_LDA(At, 0, 1); PG8_STAGE(PG8_SB(0, 0), b2, voffB); PG8_STAGE(PG8_SB(0, 1), b2 + hstepB, voffB); PG8_STAGE_A(PG8_SA(0, 0), a2, 0, vAn);
            PG8_WAIT_V(8); PG8_WAIT_L(0); PG8_BAR; PG8_MMA(1, 0, At, B0); PG8_MMA(1, 1, At, B1); PG8_BAR; PG8_SCHED;
            PG8_LDB(B0, 1, 0); PG8_LDB(B1, 1, 1); PG8_SCHED; PG8_LDA(At, 1, 0); PG8_STAGE_A(PG8_SA(0, 1), a2, 1, vAn);
            PG8_WAIT_V(8); PG8_WAIT_L(0); PG8_BAR; PG8_MMA(0, 0, At, B0); PG8_MMA(0, 1, At, B1); PG8_BAR; PG8_SCHED;
            PG8_LDA(At, 1, 1); PG8_STAGE(PG8_SB(1, 0), b3, voffB); PG8_STAGE(PG8_SB(1, 1), b3 + hstepB, voffB); PG8_STAGE_A(PG8_SA(1, 0), a3, 0, vAn);
            PG8_WAIT_V(8); PG8_WAIT_L(0); PG8_BAR; PG8_MMA(1, 0, At, B0); PG8_MMA(1, 1, At, B1); PG8_BAR; PG8_SCHED;
        }
        if constexpr (ALIGN_EPI) { if (wr == 0) PG8_BAR; }
        if constexpr (GD::FP8) asm volatile("s_nop 15\n\ts_nop 7" ::: "memory");
        E(acc, cur, wr, wc, fr, fq);
        if (!has_next) break;
#pragma unroll
        for (int a = 0; a < 2; ++a)
#pragma unroll
            for (int b = 0; b < 2; ++b)
#pragma unroll
                for (int m = 0; m < 4; ++m)
#pragma unroll
                    for (int n = 0; n < 2; ++n) acc[a][b][m][n] = (f32x4){0.f, 0.f, 0.f, 0.f};
        cur = nxt; cA = nA; cB = nB; ++ui;
#pragma unroll
        for (int h = 0; h < 2; ++h)
#pragma unroll
            for (int i = 0; i < 2; ++i) vAc[h][i] = vAn[h][i];
        if constexpr (ALIGN_EPI) { if (wr == 1) PG8_BAR; }
    }
    PG8_WAIT_V(0);
    if constexpr (!ALIGN_EPI) { if (wr == 0) PG8_BAR; }
    PG8_BAR;
#undef PG8_SA
#undef PG8_SB
#undef PG8_STAGE
#undef PG8_STAGE_A
#undef PG8_LDA
#undef PG8_LDB
#undef PG8_MMA
#undef PG8_WAIT_V
#undef PG8_WAIT_L
#undef PG8_BAR
#undef PG8_SCHED
}

__device__ __forceinline__ float gelu_tanh(float v) { const float z2 = (2.0f * 0.7978845608028654f * LOG2E) * (v + 0.044715f * v * v * v); return v * fast_rcp(1.0f + fast_exp2(-z2)); }

constexpr int XCH_OFF = 131072 + 1024;
__device__ __forceinline__ float row_rs(const float* ssp, int row, int fq) {
    float p = ssp[(size_t)fq * T + row]; p += __shfl_xor(p, 16); p += __shfl_xor(p, 32);
    return __builtin_amdgcn_rsqf(p * (1.0f / D) + RMS_EPS);
}
__device__ __forceinline__ void row_rs8(const float* ssp, int row0, int fq, float (&rs)[2][4]) {
    if (!ssp) {
#pragma unroll
        for (int ai = 0; ai < 2; ++ai)
#pragma unroll
            for (int m = 0; m < 4; ++m) rs[ai][m] = 1.0f;
        return; }
    float p[2][4];
#pragma unroll
    for (int ai = 0; ai < 2; ++ai)
#pragma unroll
        for (int m = 0; m < 4; ++m) p[ai][m] = ssp[(size_t)fq * T + row0 + ai * HALF + m * 16];
#pragma unroll
    for (int ai = 0; ai < 2; ++ai)
#pragma unroll
        for (int m = 0; m < 4; ++m) { float q = p[ai][m]; q += __shfl_xor(q, 16); q += __shfl_xor(q, 32); rs[ai][m] = __builtin_amdgcn_rsqf(q * (1.0f / D) + RMS_EPS); }
}
struct EpiLruIn {
    static constexpr bool PERM = true;
    bf16* Y; bf16* XB; const float* ss;
    __device__ __forceinline__ void operator()(const f32x4 (&acc)[2][2][4][2], const Unit& u, int wr, int wc, int fr, int fq) const {
        int row0 = u.pm * BM + wr * 64 + fr; asm volatile("" : "+v"(row0)); const bool act = (u.pn < 4);
        bf16* base = act ? Y : XB; const int col0 = (u.pn & 3) * BM + wc * 32 + 8 * fq;
        float rs8[2][4]; row_rs8(ss, row0, fq, rs8);
#pragma unroll
        for (int ai = 0; ai < 2; ++ai)
#pragma unroll
            for (int m = 0; m < 4; ++m) { bf16* rowp = base + (size_t)(row0 + ai * HALF + m * 16) * D + col0;
                const float rs = rs8[ai][m];
#pragma unroll
                for (int bj = 0; bj < 2; ++bj) { f32x4 v0 = acc[ai][bj][m][0] * rs, v1 = acc[ai][bj][m][1] * rs;
                    if (act) {
#pragma unroll
                        for (int j = 0; j < 4; ++j) { v0[j] = gelu_tanh(v0[j]); v1[j] = gelu_tanh(v1[j]); } }
                    v4u w; w.x = cvt_pk_bf16(v0[0], v0[1]); w.y = cvt_pk_bf16(v0[2], v0[3]); w.z = cvt_pk_bf16(v1[0], v1[1]); w.w = cvt_pk_bf16(v1[2], v1[3]);
                    *(v4u*)(rowp + bj * HALF) = w; }
                asm volatile("" ::: "memory"); }
    }
};
struct EpiGate {
    static constexpr bool PERM = false;
    const bf16* XC; const float* ba; const float* bx; const float* c8; unsigned* AB;
    __device__ __forceinline__ void operator()(const f32x4 (&acc)[2][2][4][2], const Unit& u, int wr, int wc, int fr, int fq) const {
        int row0 = u.pm * BM + wr * 64 + fr; asm volatile("" : "+v"(row0)); const int ch0 = u.pn * HALF + wc * 32 + 4 * fq;
        v2u xall[2][2][4];
#pragma unroll
        for (int n = 0; n < 2; ++n)
#pragma unroll
            for (int ai = 0; ai < 2; ++ai)
#pragma unroll
                for (int m = 0; m < 4; ++m) xall[n][ai][m] = *(const v2u*)(XC + (size_t)(row0 + ai * HALF + m * 16) * D + ch0 + 16 * n);
#pragma unroll
        for (int n = 0; n < 2; ++n) {
            const f32x4 vba = *(const f32x4*)(ba + ch0 + 16 * n), vbx = *(const f32x4*)(bx + ch0 + 16 * n), vc8 = *(const f32x4*)(c8 + ch0 + 16 * n);
#pragma unroll
            for (int ai = 0; ai < 2; ++ai)
#pragma unroll
                for (int m = 0; m < 4; ++m) { const size_t ro = (size_t)(row0 + ai * HALF + m * 16) * D + ch0 + 16 * n;
                    const v2u xw = xall[n][ai][m];
                    const float xc[4] = {bflo(xw.x), bfhi(xw.x), bflo(xw.y), bfhi(xw.y)}; v4u o;
#pragma unroll
                    for (int j = 0; j < 4; ++j) { const float r = sigmoidf_(acc[ai][0][m][n][j] + vba[j]), gi = sigmoidf_(acc[ai][1][m][n][j] + vbx[j]);
                        const float la2 = -vc8[j] * r, a2 = fast_exp2(2.0f * la2), mult = __builtin_amdgcn_sqrtf(fmaxf(1.0f - a2, 0.f));
                        o[j] = pk2(mult * gi * xc[j], la2); }
                    *(v4u*)(AB + ro) = o;
                    if (m & 1) asm volatile("" ::: "memory"); }
        }
    }
};
struct EpiResid {
    static constexpr bool PERM = true;
    const xr_t* xin; xr_t* out;
    const float* gnext; bf16* hn; float* ssp; PG8_LAS unsigned char* lds;
    float h8s = 0.f;
    __device__ __forceinline__ void operator()(const f32x4 (&acc)[2][2][4][2], const Unit& u, int wr, int wc, int fr, int fq) const {
        int row0 = u.pm * BM + wr * 64 + fr; asm volatile("" : "+v"(row0)); const int col0 = u.pn * BM + wc * 32 + 8 * fq;
        PG8_LAS float* xch = (PG8_LAS float*)(lds + XCH_OFF);
        f32x4 gv[2][2];
        if (hn) {
#pragma unroll
            for (int bj = 0; bj < 2; ++bj)
#pragma unroll
                for (int n = 0; n < 2; ++n) gv[bj][n] = *(const f32x4*)(gnext + col0 + bj * HALF + 4 * n); }
        v4u xn[2];
#pragma unroll
        for (int bj = 0; bj < 2; ++bj) xn[bj] = *(const v4u*)(xin + (size_t)row0 * D + col0 + bj * HALF);
#pragma unroll
        for (int g8 = 0; g8 < 8; ++g8) { const int ai = g8 >> 2, m = g8 & 3; const int row = row0 + ai * HALF + m * 16; const size_t ro = (size_t)row * D + col0; float sq = 0.f;
                f32x4 xc[2][2];
#pragma unroll
                for (int bj = 0; bj < 2; ++bj) xr_unpack8(xn[bj], xc[bj][0], xc[bj][1]);
                if (g8 < 7) { const size_t rn = (size_t)(row0 + ((g8 + 1) >> 2) * HALF + ((g8 + 1) & 3) * 16) * D + col0;
#pragma unroll
                    for (int bj = 0; bj < 2; ++bj) xn[bj] = *(const v4u*)(xin + rn + bj * HALF); }
#pragma unroll
                for (int bj = 0; bj < 2; ++bj) { f32x4 o[2];
#pragma unroll
                    for (int n = 0; n < 2; ++n) o[n] = xc[bj][n] + acc[ai][bj][m][n];
                    *(v4u*)(out + ro + bj * HALF) = xr_pack8(o[0], o[1]);
                    if (hn) { sq += (o[0][0] * o[0][0] + o[0][1] * o[0][1]) + (o[0][2] * o[0][2] + o[0][3] * o[0][3]) + (o[1][0] * o[1][0] + o[1][1] * o[1][1]) + (o[1][2] * o[1][2] + o[1][3] * o[1][3]);
                        const f32x4 h0 = o[0] * gv[bj][0], h1 = o[1] * gv[bj][1];
                        if (h8s != 0.f) { v2u w; w.x = pack4_fp8(h0[0], h0[1], h0[2], h0[3], h8s); w.y = pack4_fp8(h1[0], h1[1], h1[2], h1[3], h8s); *(v2u*)((unsigned char*)hn + ro + bj * HALF) = w; }
                        else { v4u w; w.x = cvt_pk_bf16(h0[0], h0[1]); w.y = cvt_pk_bf16(h0[2], h0[3]); w.z = cvt_pk_bf16(h1[0], h1[1]); w.w = cvt_pk_bf16(h1[2], h1[3]);
                        *(v4u*)(hn + ro + bj * HALF) = w; } } }
                if (hn) { sq += __shfl_xor(sq, 16); sq += __shfl_xor(sq, 32); if (fq == 0) xch[wc * 256 + ai * HALF + wr * 64 + m * 16 + fr] = sq; }
                asm volatile("" ::: "memory"); }
        if (hn) {
            asm volatile("s_waitcnt lgkmcnt(0)" ::: "memory"); __builtin_amdgcn_s_barrier(); asm volatile("" ::: "memory");
            const int t = (wr * 4 + wc) * 64 + fq * 16 + fr;
            if (t < 256) ssp[(size_t)u.pn * T + u.pm * BM + t] = (xch[t] + xch[256 + t]) + (xch[512 + t] + xch[768 + t]);
        }
    }
};
struct EpiFoxIn {
    static constexpr bool PERM = true;
    bf16* base; size_t kstride; const float* qg; const float* kg; float c2;
    const float* ss;
    const float* bfv; float* LOGF;
    __device__ __forceinline__ void operator()(const f32x4 (&acc)[2][2][4][2], const Unit& u, int wr, int wc, int fr, int fq) const {
        const int kind = u.pn >> 2, head = 4 * (u.pn & 3) + wc; int row0 = u.pm * BM + wr * 64 + fr; asm volatile("" : "+v"(row0));
        float rs8[2][4]; row_rs8(ss, row0, fq, rs8);
        if (kind == 4) {
            if (wc == 0) { f32x4 bb[2];
#pragma unroll
                for (int n = 0; n < 2; ++n) bb[n] = *(const f32x4*)(bfv + 8 * (fq & 1) + 4 * n);
#pragma unroll
                for (int ai = 0; ai < 2; ++ai)
#pragma unroll
                    for (int m = 0; m < 4; ++m) { const int row = row0 + ai * HALF + m * 16; const float rs = rs8[ai][m];
                        if (fq < 2) {
#pragma unroll
                            for (int n = 0; n < 2; ++n) { f32x4 o;
#pragma unroll
                                for (int j = 0; j < 4; ++j) { const float z = acc[ai][0][m][n][j] * rs + bb[n][j]; o[j] = fminf(z, 0.f) - log1pf(__expf(-fabsf(z))); }
                                *(f32x4*)(LOGF + (size_t)row * 16 + 8 * fq + 4 * n) = o; } } } }
            return;
        }
        bf16* tb = base + (size_t)kind * kstride + head * HD + 8 * fq;
        f32x4 gn[2][2];
        if (kind < 2) { const float* gp = (kind == 0 ? qg : kg) + 8 * fq;
#pragma unroll
            for (int bj = 0; bj < 2; ++bj)
#pragma unroll
                for (int n = 0; n < 2; ++n) gn[bj][n] = *(const f32x4*)(gp + 32 * bj + 4 * n); }
        const float sc = (kind == 0) ? c2 : 1.0f;
#pragma unroll
        for (int ai = 0; ai < 2; ++ai)
#pragma unroll
            for (int m = 0; m < 4; ++m) { const int row = row0 + ai * HALF + m * 16; bf16* rowp = tb + (size_t)row * D;
                const float rsx = rs8[ai][m];
                f32x4 v[2][2];
#pragma unroll
                for (int bj = 0; bj < 2; ++bj)
#pragma unroll
                    for (int n = 0; n < 2; ++n) v[bj][n] = acc[ai][bj][m][n] * rsx;
                if (kind < 2) { float s2 = 0.f;
#pragma unroll
                    for (int bj = 0; bj < 2; ++bj)
#pragma unroll
                        for (int n = 0; n < 2; ++n) s2 += (v[bj][n][0] * v[bj][n][0] + v[bj][n][1] * v[bj][n][1]) + (v[bj][n][2] * v[bj][n][2] + v[bj][n][3] * v[bj][n][3]);
                    s2 += __shfl_xor(s2, 16); s2 += __shfl_xor(s2, 32);
                    const float rs = __builtin_amdgcn_rsqf(s2 * (1.0f / HD) + RMS_EPS) * sc;
#pragma unroll
                    for (int bj = 0; bj < 2; ++bj)
#pragma unroll
                        for (int n = 0; n < 2; ++n) v[bj][n] = v[bj][n] * rs * gn[bj][n];
                } else if (kind == 3) {
#pragma unroll
                    for (int bj = 0; bj < 2; ++bj)
#pragma unroll
                        for (int n = 0; n < 2; ++n)
#pragma unroll
                            for (int j = 0; j < 4; ++j) v[bj][n][j] = sigmoidf_(v[bj][n][j]);
                }
#pragma unroll
                for (int bj = 0; bj < 2; ++bj) { v4u w; w.x = cvt_pk_bf16(v[bj][0][0], v[bj][0][1]); w.y = cvt_pk_bf16(v[bj][0][2], v[bj][0][3]); w.z = cvt_pk_bf16(v[bj][1][0], v[bj][1][1]); w.w = cvt_pk_bf16(v[bj][1][2], v[bj][1][3]);
                    *(v4u*)(rowp + 32 * bj) = w; }
                asm volatile("" ::: "memory"); }
    }
};
struct EpiSwiglu {
    static constexpr bool PERM = true;
    bf16* Hb; int ldh; const float* ss; float hq;
    __device__ __forceinline__ void operator()(const f32x4 (&acc)[2][2][4][2], const Unit& u, int wr, int wc, int fr, int fq) const {
        int row0 = u.pm * BM + wr * 64 + fr; asm volatile("" : "+v"(row0)); const int col0 = u.pn * HALF + wc * 32 + 8 * fq;
        float rs8[2][4]; row_rs8(ss, row0, fq, rs8);
#pragma unroll
        for (int ai = 0; ai < 2; ++ai)
#pragma unroll
            for (int m = 0; m < 4; ++m) { bf16* rowp = Hb + (size_t)(row0 + ai * HALF + m * 16) * ldh + col0; float h[8];
                const float rs = rs8[ai][m];
#pragma unroll
                for (int n = 0; n < 2; ++n)
#pragma unroll
                    for (int j = 0; j < 4; ++j) { const float gv = acc[ai][0][m][n][j] * rs, uv = acc[ai][1][m][n][j] * rs; h[4 * n + j] = gv * uv * fast_rcp(1.0f + fast_exp2(-gv * LOG2E));
#if EMU_FP8
                        if (hq != 0.f) h[4 * n + j] = q8(h[4 * n + j], hq);
#endif
                    }
                v4u w; w.x = cvt_pk_bf16(h[0], h[1]); w.y = cvt_pk_bf16(h[2], h[3]); w.z = cvt_pk_bf16(h[4], h[5]); w.w = cvt_pk_bf16(h[6], h[7]);
                *(v4u*)rowp = w;
                asm volatile("" ::: "memory"); }
    }
};
struct EpiNull {
    static constexpr bool PERM = true;
    float* sink;
    __device__ __forceinline__ void operator()(const f32x4 (&acc)[2][2][4][2], const Unit& u, int wr, int wc, int fr, int fq) const {
        float s = 0.f;
#pragma unroll
        for (int ai = 0; ai < 2; ++ai)
#pragma unroll
            for (int bj = 0; bj < 2; ++bj)
#pragma unroll
                for (int m = 0; m < 4; ++m)
#pragma unroll
                    for (int n = 0; n < 2; ++n) s += acc[ai][bj][m][n][0] + acc[ai][bj][m][n][1] + acc[ai][bj][m][n][2] + acc[ai][bj][m][n][3];
        if (s == 12345.678f) *sink = s;
    }
};
struct EpiSwiglu8 {
    static constexpr bool PERM = true;
    unsigned char* H8; int ldh; float hs; const float* ss = nullptr;
    __device__ __forceinline__ void operator()(const f32x4 (&acc)[2][2][4][2], const Unit& u, int wr, int wc, int fr, int fq) const {
        int row0 = u.pm * BM + wr * 64 + fr; asm volatile("" : "+v"(row0)); const int col0 = u.pn * HALF + wc * 32 + 8 * fq;
        float rs8[2][4]; row_rs8(ss, row0, fq, rs8);
#pragma unroll
        for (int ai = 0; ai < 2; ++ai)
#pragma unroll
            for (int m = 0; m < 4; ++m) { unsigned char* rowp = H8 + (size_t)(row0 + ai * HALF + m * 16) * ldh + col0; float h[8];
                const float rs = rs8[ai][m];
#pragma unroll
                for (int n = 0; n < 2; ++n)
#pragma unroll
                    for (int j = 0; j < 4; ++j) { const float gv = acc[ai][0][m][n][j] * rs, uv = acc[ai][1][m][n][j] * rs; h[4 * n + j] = gv * uv * fast_rcp(1.0f + fast_exp2(-gv * LOG2E)); }
                v2u w; w.x = pack4_fp8(h[0], h[1], h[2], h[3], hs); w.y = pack4_fp8(h[4], h[5], h[6], h[7], hs);
                *(v2u*)rowp = w;
                asm volatile("" ::: "memory"); }
    }
};
struct EpiScatter {
    static constexpr bool PERM = true; static constexpr int NST = 0;
    const xr_t* xr; xr_t* xw; float* fout; const unsigned* list; const float* listw;
    const float* gnext; bf16* hn; float* ssp; PG8_LAS unsigned char* lds;
    float h8s = 0.f;
    __device__ __forceinline__ void operator()(const f32x4 (&acc)[2][2][4][2], const Unit& u, int wr, int wc, int fr, int fq) const {
        int row0 = u.pm * BM + wr * 64 + fr; asm volatile("" : "+v"(row0)); const int col0 = u.pn * BM + wc * 32 + 8 * fq;
        PG8_LAS float* xch = (PG8_LAS float*)(lds + XCH_OFF);
        unsigned idx8[8]; float w8[8];
#pragma unroll
        for (int g8 = 0; g8 < 8; ++g8) { const int row = row0 + (g8 >> 2) * HALF + (g8 & 3) * 16; idx8[g8] = list[row]; w8[g8] = listw[row]; }
        v4u xn[2];
        { const size_t r0 = (size_t)(idx8[0] & 0xffffu) * D + col0;
#pragma unroll
          for (int bj = 0; bj < 2; ++bj) xn[bj] = *(const v4u*)(xr + r0 + bj * HALF); }
#pragma unroll
        for (int g8 = 0; g8 < 8; ++g8) { const int ai = g8 >> 2, m = g8 & 3; const unsigned idx = idx8[g8]; const float w = w8[g8]; const bool valid = (idx & 0x80000000u) != 0u;
                const int tok = (int)(idx & 0xffffu); const size_t ro = (size_t)tok * D + col0; float sq = 0.f;
                f32x4 xc[2][2];
#pragma unroll
                for (int bj = 0; bj < 2; ++bj) xr_unpack8(xn[bj], xc[bj][0], xc[bj][1]);
                if (g8 < 7) { const size_t rn = (size_t)(idx8[g8 + 1 < 8 ? g8 + 1 : 7] & 0xffffu) * D + col0;
#pragma unroll
                    for (int bj = 0; bj < 2; ++bj) xn[bj] = *(const v4u*)(xr + rn + bj * HALF); }
                if (valid) {
#pragma unroll
                    for (int bj = 0; bj < 2; ++bj) { f32x4 o[2];
#pragma unroll
                        for (int n = 0; n < 2; ++n) o[n] = xc[bj][n] + acc[ai][bj][m][n] * w;
                        if (fout) { *(f32x4*)(fout + ro + bj * HALF) = o[0]; *(f32x4*)(fout + ro + bj * HALF + 4) = o[1]; }
                        else *(v4u*)(xw + ro + bj * HALF) = xr_pack8(o[0], o[1]);
                        if (hn) { sq += (o[0][0] * o[0][0] + o[0][1] * o[0][1]) + (o[0][2] * o[0][2] + o[0][3] * o[0][3]) + (o[1][0] * o[1][0] + o[1][1] * o[1][1]) + (o[1][2] * o[1][2] + o[1][3] * o[1][3]);
                            const f32x4 g0 = *(const f32x4*)(gnext + col0 + bj * HALF), g1 = *(const f32x4*)(gnext + col0 + bj * HALF + 4);
                            const f32x4 h0 = o[0] * g0, h1 = o[1] * g1;
                            if (h8s != 0.f) { v2u w2; w2.x = pack4_fp8(h0[0], h0[1], h0[2], h0[3], h8s); w2.y = pack4_fp8(h1[0], h1[1], h1[2], h1[3], h8s); *(v2u*)((unsigned char*)hn + ro + bj * HALF) = w2; }
                            else { v4u w4; w4.x = cvt_pk_bf16(h0[0], h0[1]); w4.y = cvt_pk_bf16(h0[2], h0[3]); w4.z = cvt_pk_bf16(h1[0], h1[1]); w4.w = cvt_pk_bf16(h1[2], h1[3]);
                            *(v4u*)(hn + ro + bj * HALF) = w4; } }
                        asm volatile("" ::: "memory"); } }
                if (hn) { sq += __shfl_xor(sq, 16); sq += __shfl_xor(sq, 32); if (fq == 0) xch[wc * 256 + ai * HALF + wr * 64 + m * 16 + fr] = sq; }
                asm volatile("" ::: "memory"); }
        if (hn) {
            asm volatile("s_waitcnt lgkmcnt(0)" ::: "memory"); __builtin_amdgcn_s_barrier(); asm volatile("" ::: "memory");
            const int t = (wr * 4 + wc) * 64 + fq * 16 + fr;
            if (t < 256) { const unsigned idx = list[u.pm * BM + t];
                if (idx & 0x80000000u) ssp[(size_t)u.pn * T + (idx & 0xffffu)] = (xch[t] + xch[256 + t]) + (xch[512 + t] + xch[768 + t]); }
        }
    }
};
}

#define XB_TMO      128
#define XB_XCNT(j)  (256  + 64 * (j))
#define XB_XSUB(j)  (1280 + 64 * (j))
#define XB_XGEN(j)  (2304 + 64 * (j))
#define XB_TOP      3328
#define XB_TOPGEN   3392
#define XCD_BAR_WORDS 3456
#define XB_SPIN_CAP (1u << 21)
__device__ __forceinline__ unsigned xb_ld(unsigned* p)              { return __hip_atomic_load(p, __ATOMIC_RELAXED, __HIP_MEMORY_SCOPE_AGENT); }
__device__ __forceinline__ unsigned xb_add(unsigned* p, unsigned v) { return __hip_atomic_fetch_add(p, v, __ATOMIC_RELAXED, __HIP_MEMORY_SCOPE_AGENT); }
__device__ __forceinline__ unsigned xb_xcc_id() { return (unsigned)__builtin_amdgcn_s_getreg((3 << 11) | 20) & 0xFu; }
#define XB_SPIN(cond, bar) do { unsigned _sp = 0; while (cond) { __builtin_amdgcn_s_sleep(1); \
    if ((++_sp & 255u) == 0u) { if (xb_ld(&(bar)[XB_TMO])) break; if (_sp > XB_SPIN_CAP) { atomicAdd(&(bar)[XB_TMO], 1u); break; } } } } while (0)
struct XcdBarrier { unsigned* bar; unsigned x; volatile LAS unsigned* st; };
__device__ __forceinline__ XcdBarrier xcd_barrier_post(unsigned* bar, volatile LAS unsigned* st) {
    XcdBarrier b; b.bar = bar; b.x = xb_xcc_id(); b.st = st;
    if (threadIdx.x == 0) (void)xb_add(&bar[XB_XCNT(b.x)], 1u);
    return b;
}
__device__ __forceinline__ void xcd_barrier_complete(unsigned* bar, unsigned x, unsigned& nloc, unsigned& nx) {
    const unsigned G = gridDim.x * gridDim.y * gridDim.z;
    unsigned sum, cnt, mine, sp = 0u;
    for (;;) {
        sum = 0u; cnt = 0u; mine = 0u;
#pragma unroll
        for (unsigned j = 0; j < 16; ++j) { const unsigned c = xb_ld(&bar[XB_XCNT(j)]); sum += c; cnt += (c > 0u) ? 1u : 0u; mine = (j == x) ? c : mine; }
        if (sum == G) break;
        __builtin_amdgcn_s_sleep(1);
        if ((++sp & 255u) == 0u) { if (xb_ld(&bar[XB_TMO])) break; if (sp > XB_SPIN_CAP) { atomicAdd(&bar[XB_TMO], 1u); break; } }
    }
    nloc = mine > 0u ? mine : 1u; nx = cnt > 0u ? cnt : 1u;
}
__device__ __forceinline__ void xcd_barrier(const XcdBarrier& b) {
    asm volatile("s_waitcnt vmcnt(0)" ::: "memory");
    __syncthreads();
    if (threadIdx.x == 0) {
        unsigned* bar = b.bar; asm volatile("" : "+s"(bar));
        __builtin_amdgcn_s_waitcnt(0);
        unsigned nloc = b.st[0], nx = b.st[1];
        if (nloc == 0u) { xcd_barrier_complete(bar, b.x, nloc, nx); b.st[0] = nloc; b.st[1] = nx; }
        const unsigned old = xb_add(&bar[XB_XSUB(b.x)], 1u);
        const unsigned gen = old / nloc;
        if (old + 1u == (gen + 1u) * nloc) {
            __builtin_amdgcn_fence(__ATOMIC_RELEASE, "agent");
            asm volatile("s_waitcnt vmcnt(0)" ::: "memory");
            const unsigned og = xb_add(&bar[XB_TOP], 1u);
            const unsigned tg = og / nx;
            if (og + 1u == (tg + 1u) * nx) xb_add(&bar[XB_TOPGEN], 1u);
            else XB_SPIN(xb_ld(&bar[XB_TOPGEN]) == tg, bar);
            __builtin_amdgcn_fence(__ATOMIC_ACQUIRE, "agent");
            xb_add(&bar[XB_XGEN(b.x)], 1u);
            asm volatile("s_waitcnt vmcnt(0)" ::: "memory");
        } else {
            XB_SPIN(xb_ld(&bar[XB_XGEN(b.x)]) == gen, bar);
            __builtin_amdgcn_fence(__ATOMIC_ACQUIRE, "agent");
            asm volatile("s_waitcnt vmcnt(0)" ::: "memory");
        }
    }
    __syncthreads();
}

constexpr size_t MiB = 1u << 20;
constexpr size_t WS_CTL = 0, CTL_ZERO_BYTES = 1 * MiB;
constexpr size_t WS_F2 = 1 * MiB;
constexpr size_t WS_LOGF = 5 * MiB;
constexpr size_t WS_AGG = 9 * MiB;
constexpr size_t WS_TOPE = 13 * MiB;
constexpr size_t WS_TOPW = 13 * MiB + 256 * 1024;
constexpr size_t WS_SMALL = 13 * MiB + 768 * 1024;
constexpr size_t SM_CNT = 0, SM_TILE = 16384, SM_NT = 16384 + 8192, SM_C8 = 16384 + 8192 + 256, SM_T0 = SM_C8 + 4096;
constexpr int CW_QCTR = 2048;
constexpr float SKIP_THR = 64.0f;
constexpr int LISTCAP = 264 * 256;
constexpr size_t WS_LIST = 14 * MiB;
constexpr size_t WS_LISTW = 15 * MiB;
constexpr size_t WS_WL = 16 * MiB;
constexpr size_t WL_IN = 0, WL_G = 4 * MiB, WL_OUT = 5 * MiB, WL_W1 = 8 * MiB, WL_W2 = 22 * MiB;
constexpr size_t WS_WF = 48 * MiB;
constexpr size_t WF_IN = 0, WF_OUT = 9 * MiB, WF_W1 = 11 * MiB, WF_W2 = 123 * MiB;
constexpr size_t WS_SS = 228 * MiB;
constexpr size_t WS_HN = 232 * MiB;
constexpr size_t WS_ACT = 360 * MiB;
constexpr size_t ACT_SLOT = 128 * MiB;
constexpr size_t WS_END = 1000 * MiB;
static_assert(WS_WL + WL_W2 + (size_t)D * FF * 2 <= WS_WF && WS_WF + WF_W2 + (size_t)NE * D * FF * 2 <= WS_SS && WS_SS + 12 * (size_t)T * 4 <= WS_HN && WS_HN + (size_t)T * D * 2 <= WS_ACT && WS_ACT + 5 * ACT_SLOT <= WS_END, "d_ws map");
constexpr int CW_BAR = 4096;

constexpr int RING_BYTES = 131072, MISC_OFF = RING_BYTES + 320, LDS_BYTES = 147456;

struct Args {
    const float* in[24]; float* out; unsigned char* ws; int ph_lo, ph_hi;
};

__device__ __forceinline__ const float* inp(int k) {
    int kk = k; asm volatile("" : "+s"(kk));
    const __attribute__((address_space(4))) unsigned long long* tab = (const __attribute__((address_space(4))) unsigned long long*)__builtin_amdgcn_kernarg_segment_ptr();
    return (const float*)(uintptr_t)tab[kk];
}
struct Frame {
    LAS unsigned char* lds; unsigned char* ldsg;
    int tid, lane, wave, G, vcu, bx;
};

struct CvtJob { const float* src; bf16* dst; int pitch, dpitch; float qs; float f8;    };
__device__ __forceinline__ void cvt_load(const CvtJob& jb, float (&r)[32], int lane) {
    const float* p = jb.src + (size_t)(lane >> 5) * jb.pitch + (lane & 31);
#pragma unroll
    for (int i = 0; i < 32; ++i) r[i] = p[(size_t)(2 * i) * jb.pitch];
#if EMU_FP8
    if (jb.qs != 0.f) {
#pragma unroll
        for (int i = 0; i < 32; ++i) r[i] = q8(r[i], jb.qs); }
#endif
}
__device__ __forceinline__ void cvt_store(const CvtJob& jb, const float (&r)[32], LAS float* scr, int lane) {
#pragma unroll
    for (int i = 0; i < 32; ++i) scr[(2 * i + (lane >> 5)) * 33 + (lane & 31)] = r[i];
    LDS_WAIT(); asm volatile("" ::: "memory");
    const int c = lane & 7;
    if (jb.f8 != 0.f) {
#pragma unroll
        for (int j = 0; j < 4; ++j) { const int n = (lane >> 3) + 8 * j; const LAS float* s = scr + (8 * c) * 33 + n;
            v2u o; o.x = pack4_fp8(s[0 * 33], s[1 * 33], s[2 * 33], s[3 * 33], jb.f8); o.y = pack4_fp8(s[4 * 33], s[5 * 33], s[6 * 33], s[7 * 33], jb.f8);
            *(GAS v2u*)((unsigned char*)jb.dst + (size_t)n * jb.dpitch + 8 * c) = o; }
    } else {
#pragma unroll
    for (int j = 0; j < 4; ++j) { const int n = (lane >> 3) + 8 * j; const LAS float* s = scr + (8 * c) * 33 + n;
        v4u o; o.x = pk2(s[0 * 33], s[1 * 33]); o.y = pk2(s[2 * 33], s[3 * 33]); o.z = pk2(s[4 * 33], s[5 * 33]); o.w = pk2(s[6 * 33], s[7 * 33]);
        *(GAS v4u*)(jb.dst + (size_t)n * jb.dpitch + 8 * c) = o; }
    }
    LDS_WAIT(); asm volatile("" ::: "memory");
}
enum { MAP_NAT = 0, MAP_FOXIN = 1, MAP_GU = 2 };
__device__ __forceinline__ int map_row(int kind, int n0, int half) {
    if (kind == MAP_NAT) return n0;
    if (kind == MAP_FOXIN) { const int tile = n0 >> 8, c = n0 & 255, wc = c >> 6, bj = (c >> 5) & 1; return tile * 256 + bj * 128 + wc * 32; }
    return (n0 >> 7) * 256 + half * 128 + (n0 & 127);
}
__device__ __forceinline__ CvtJob cvt_mk(const float* W, int N, int pitch, bf16* WT, int dpitch, int kind, int half, int drow_base, int idx) {
    const int nblk = N / 32, kb = idx / nblk, nb = idx % nblk;
    CvtJob jb; jb.src = W + (size_t)(64 * kb) * pitch + 32 * nb; jb.dst = WT + (size_t)(drow_base + map_row(kind, 32 * nb, half)) * dpitch + 64 * kb; jb.pitch = pitch; jb.dpitch = dpitch; jb.qs = 0.f; jb.f8 = 0.f; return jb;
}
__device__ __forceinline__ CvtJob cvt_mk8(const float* W, int N, int pitch, unsigned char* WT8, int K, int kind, int half, int drow_base, int idx, float sc) {
    const int nblk = N / 32, kb = idx / nblk, nb = idx % nblk;
    CvtJob jb; jb.src = W + (size_t)(64 * kb) * pitch + 32 * nb; jb.dst = (bf16*)(WT8 + (size_t)(drow_base + map_row(kind, 32 * nb, half)) * K + 64 * kb); jb.pitch = pitch; jb.dpitch = K; jb.qs = 0.f; jb.f8 = sc; return jb;
}
constexpr int CVT_L_TOTAL = 1024 + 128 + 512 + 3 * 1792, CVT_F_TOTAL = 2048 + 512 + NE * 3 * 1792;
__device__ __forceinline__ CvtJob cvt_decode_lru(int it, int j, unsigned char* wreg) {
    bf16* Win_t = (bf16*)(wreg + WL_IN); bf16* Wg_t = (bf16*)(wreg + WL_G); bf16* Wout_t = (bf16*)(wreg + WL_OUT); bf16* W1_t = (bf16*)(wreg + WL_W1); bf16* W2_t = (bf16*)(wreg + WL_W2);
    if (it < 1024) { if (FP8_LRUIN_J1 && j == 1) return cvt_mk8(inp(3) + (size_t)j * D * 2 * D, 2 * D, 2 * D, (unsigned char*)Win_t, D, MAP_NAT, 0, 0, it, 64.f);
        return cvt_mk(inp(3) + (size_t)j * D * 2 * D, 2 * D, 2 * D, Win_t, D, MAP_NAT, 0, 0, it); }
    it -= 1024;
    if (it < 128) { const int m = it >> 3, hb = m >> 1, gx = m & 1; return cvt_mk(inp(gx ? 8 : 6) + ((size_t)j * 8 + hb) * 128 * 128, 128, 128, Wg_t, 128, MAP_NAT, 0, 256 * hb + 128 * gx, it & 7); }
    it -= 128;
    if (it < 512) return cvt_mk(inp(11) + (size_t)j * D * D, D, D, Wout_t, D, MAP_NAT, 0, 0, it);
    it -= 512;
    if (FP8_L2_FFN && j == 1) {
        if (it < 1792) return cvt_mk8(inp(17) + (size_t)j * D * FF, FF, FF, (unsigned char*)W1_t, D, MAP_GU, 0, 0, it, 64.f);
        it -= 1792;
        if (it < 1792) return cvt_mk8(inp(18) + (size_t)j * D * FF, FF, FF, (unsigned char*)W1_t, D, MAP_GU, 1, 0, it, 64.f);
        it -= 1792;
        return cvt_mk8(inp(19) + (size_t)j * FF * D, D, D, (unsigned char*)W2_t, FF, MAP_NAT, 0, 0, it, 128.f);
    }
    const bool q = (EMU_FP8 >= 2 && j == 1) || EMU_FP8 >= 3;
    if (it < 1792) { CvtJob jb = cvt_mk(inp(17) + (size_t)j * D * FF, FF, FF, W1_t, D, MAP_GU, 0, 0, it); if (q) jb.qs = 64.f; return jb; }
    it -= 1792;
    if (it < 1792) { CvtJob jb = cvt_mk(inp(18) + (size_t)j * D * FF, FF, FF, W1_t, D, MAP_GU, 1, 0, it); if (q) jb.qs = 64.f; return jb; }
    it -= 1792;
    { CvtJob jb = cvt_mk(inp(19) + (size_t)j * FF * D, D, D, W2_t, FF, MAP_NAT, 0, 0, it); if (q) jb.qs = 128.f; return jb; }
}
__device__ __forceinline__ CvtJob cvt_decode_fox(int it, int j, unsigned char* wreg) {
    bf16* Win_t = (bf16*)(wreg + WF_IN); bf16* Wout_t = (bf16*)(wreg + WF_OUT); bf16* W1_t = (bf16*)(wreg + WF_W1); bf16* W2_t = (bf16*)(wreg + WF_W2);
    if (it < 2048) { if (FP8_FOXIN_J1 && (j == 1 || FP8_FOXIN_J0)) return cvt_mk8(inp(12) + (size_t)j * D * (4 * D + NH), 4 * D, 4 * D + NH, (unsigned char*)Win_t, D, MAP_FOXIN, 0, 0, it, 64.f);
        return cvt_mk(inp(12) + (size_t)j * D * (4 * D + NH), 4 * D, 4 * D + NH, Win_t, D, MAP_FOXIN, 0, 0, it); }
    it -= 2048;
    if (it < 512) return cvt_mk(inp(16) + (size_t)j * D * D, D, D, Wout_t, D, MAP_NAT, 0, 0, it);
    it -= 512;
    const int e = it / (3 * 1792), q = it % (3 * 1792), m = q / 1792, idx = q % 1792;
    CvtJob jb;
    if (FP8_LAST_MOE && (j == 1 || FP8_MOE_J0)) {
        if (m == 0) return cvt_mk8(inp(21) + ((size_t)j * NE + e) * D * FF, FF, FF, (unsigned char*)W1_t, D, MAP_GU, 0, e * 2 * FF, idx, 64.f);
        if (m == 1) return cvt_mk8(inp(22) + ((size_t)j * NE + e) * D * FF, FF, FF, (unsigned char*)W1_t, D, MAP_GU, 1, e * 2 * FF, idx, 64.f);
        return cvt_mk8(inp(23) + ((size_t)j * NE + e) * FF * D, D, D, (unsigned char*)W2_t, FF, MAP_NAT, 0, e * D, idx, 128.f);
    }
    if (m == 0) jb = cvt_mk(inp(21) + ((size_t)j * NE + e) * D * FF, FF, FF, W1_t, D, MAP_GU, 0, e * 2 * FF, idx);
    else if (m == 1) jb = cvt_mk(inp(22) + ((size_t)j * NE + e) * D * FF, FF, FF, W1_t, D, MAP_GU, 1, e * 2 * FF, idx);
    else jb = cvt_mk(inp(23) + ((size_t)j * NE + e) * FF * D, D, D, W2_t, FF, MAP_NAT, 0, e * D, idx);
    if ((EMU_FP8 && j == 1) || EMU_FP8 >= 3) jb.qs = (m == 2) ? 128.f : 64.f;
    return jb;
}
template <bool FOX>
__device__ __forceinline__ void cvt_phase(Frame& F, int j, unsigned char* wreg) {
    const int gw = F.vcu * NWAVES + F.wave, NGW = F.G * NWAVES, total = FOX ? CVT_F_TOTAL : CVT_L_TOTAL;
    LAS float* scr = (LAS float*)(F.lds + F.wave * 16384);
    if (gw >= total) return;
    float ra[32], rb[32];
    CvtJob ja = FOX ? cvt_decode_fox(gw, j, wreg) : cvt_decode_lru(gw, j, wreg), jb2 = ja;
    cvt_load(ja, ra, F.lane);
    for (int it = gw; it < total; it += NGW) {
        const int nx = it + NGW; const bool more = nx < total;
        if (more) { jb2 = FOX ? cvt_decode_fox(nx, j, wreg) : cvt_decode_lru(nx, j, wreg); cvt_load(jb2, rb, F.lane); }
        cvt_store(ja, ra, scr, F.lane);
        ja = jb2;
#pragma unroll
        for (int i = 0; i < 32; ++i) ra[i] = rb[i];
    }
}

template <int NP, bool XB16 = false>
__device__ __forceinline__ void norm_phase(Frame& F, const float* xin, const float* gain, bf16* HN, const float* Wp, int wp_pitch,
                                           const float* bfv, float* LOGF, unsigned* TOPE, float* TOPW, unsigned* CNT, float hq = 0.f, xr_t* xcopy = nullptr) {
    LAS float* Wl = (LAS float*)(F.lds);
    LAS int* cnts = (LAS int*)(F.lds + 65536);
    if (NP > 0) {
        for (int idx = F.tid; idx < NP * 1024; idx += NWAVES * 64) { const int c = idx / NP, j = idx % NP; Wl[j * 1024 + c] = Wp[(size_t)c * wp_pitch + j]; }
        if (NP == 8 && F.tid < 16) cnts[F.tid] = 0;
        __syncthreads();
    }
    f32x4 gv[4];
#pragma unroll
    for (int j = 0; j < 4; ++j) gv[j] = *(const f32x4*)(gain + 4 * F.lane + 256 * j);
    const int rbase = F.bx * 256 + F.wave * 32;
    f32x4 vn[4]; v2u vb[4];
    if (XB16) { const GAS v2u* xr = (const GAS v2u*)((const xr_t*)xin + (size_t)rbase * D) + F.lane;
#pragma unroll
      for (int j = 0; j < 4; ++j) vb[j] = xr[64 * j]; }
    else { const GAS f32x4* xr = (const GAS f32x4*)(xin + (size_t)rbase * D) + F.lane;
#pragma unroll
      for (int j = 0; j < 4; ++j) vn[j] = xr[64 * j]; }
    for (int i = 0; i < 32; ++i) {
        const int m = rbase + i;
        f32x4 v[4];
        if (XB16) {
#pragma unroll
            for (int j = 0; j < 4; ++j) { v[j].x = __uint_as_float(vb[j].x << 16); v[j].y = __uint_as_float(vb[j].x & 0xffff0000u); v[j].z = __uint_as_float(vb[j].y << 16); v[j].w = __uint_as_float(vb[j].y & 0xffff0000u); }
            if (i + 1 < 32) { const GAS v2u* xr = (const GAS v2u*)((const xr_t*)xin + (size_t)(m + 1) * D) + F.lane;
#pragma unroll
                for (int j = 0; j < 4; ++j) vb[j] = xr[64 * j]; }
        } else {
#pragma unroll
            for (int j = 0; j < 4; ++j) v[j] = vn[j];
            if (i + 1 < 32) { const GAS f32x4* xr = (const GAS f32x4*)(xin + (size_t)(m + 1) * D) + F.lane;
#pragma unroll
                for (int j = 0; j < 4; ++j) vn[j] = xr[64 * j]; }
            if (xcopy) { GAS v2u* xc = (GAS v2u*)(xcopy + (size_t)m * D) + F.lane;
#pragma unroll
                for (int j = 0; j < 4; ++j) { v2u w; w.x = cvt_pk_bf16(v[j].x, v[j].y); w.y = cvt_pk_bf16(v[j].z, v[j].w); xc[64 * j] = w; } }
        }
        float s = 0.f;
#pragma unroll
        for (int j = 0; j < 4; ++j) s += (v[j].x * v[j].x + v[j].y * v[j].y) + (v[j].z * v[j].z + v[j].w * v[j].w);
        const float rs = 1.0f / __builtin_sqrtf(wave_sum(s) * (1.0f / D) + RMS_EPS);
#pragma unroll
        for (int j = 0; j < 4; ++j) v[j] = v[j] * rs * gv[j];
        GAS unsigned long long* o8 = (GAS unsigned long long*)(HN + (size_t)m * D) + F.lane;
#if EMU_FP8
        if (hq != 0.f) {
#pragma unroll
            for (int j = 0; j < 4; ++j) o8[64 * j] = (unsigned long long)pk2(q8(v[j].x, hq), q8(v[j].y, hq)) | ((unsigned long long)pk2(q8(v[j].z, hq), q8(v[j].w, hq)) << 32);
        } else
#endif
        if (hq < 0.f) {
            GAS unsigned* o4 = (GAS unsigned*)((unsigned char*)HN + (size_t)m * D) + F.lane;
#pragma unroll
            for (int j = 0; j < 4; ++j) o4[64 * j] = pack4_fp8(v[j].x, v[j].y, v[j].z, v[j].w, -hq);
        } else
#pragma unroll
        for (int j = 0; j < 4; ++j) o8[64 * j] = (unsigned long long)pk2(v[j].x, v[j].y) | ((unsigned long long)pk2(v[j].z, v[j].w) << 32);
        if (NP > 0) {
            float mine = 0.f;
#pragma unroll 2
            for (int p = 0; p < NP; ++p) { float a = 0.f;
#pragma unroll
                for (int j = 0; j < 4; ++j) { const f32x4 w = *(const LAS f32x4*)(Wl + p * 1024 + 4 * F.lane + 256 * j); a += (v[j].x * w.x + v[j].y * w.y) + (v[j].z * w.z + v[j].w * w.w); }
                a = wave_sum(a); if (F.lane == p) mine = a; }
            if (NP == 16) {
                if (F.lane < 16) { const float z = mine + bfv[F.lane]; const float ls = fminf(z, 0.f) - log1pf(__expf(-fabsf(z))); LOGF[(size_t)m * 16 + F.lane] = ls; }
            } else {
                float lg[8];
#pragma unroll
                for (int p = 0; p < 8; ++p) lg[p] = __shfl(mine, p);
                int i1 = 0; float l1 = lg[0];
#pragma unroll
                for (int p = 1; p < 8; ++p) if (lg[p] > l1) { l1 = lg[p]; i1 = p; }
                int i2 = (i1 == 0) ? 1 : 0; float l2 = (i1 == 0) ? lg[1] : lg[0];
#pragma unroll
                for (int p = 1; p < 8; ++p) if (p != i1 && lg[p] > l2) { l2 = lg[p]; i2 = p; }
                const float w1 = 1.0f / (1.0f + __expf(l2 - l1)), w2 = 1.0f - w1;
                if (F.lane == 0) { TOPE[m] = (unsigned)i1 | ((unsigned)i2 << 8); TOPW[2 * (size_t)m] = w1; TOPW[2 * (size_t)m + 1] = w2;
                    atomicAdd((int*)&cnts[i1], 1); atomicAdd((int*)&cnts[8 + i2], 1); }
            }
        }
    }
    if (NP == 8) { __syncthreads(); if (F.tid < 16) CNT[F.bx * 16 + F.tid] = (unsigned)cnts[F.tid]; }
    __syncthreads();
}

__device__ __forceinline__ void norm0_phase(Frame& F, const float* xin, const float* gain, bf16* HN, xr_t* XR) {
    f32x4 gv[4];
#pragma unroll
    for (int j = 0; j < 4; ++j) gv[j] = *(const f32x4*)(gain + 4 * F.lane + 256 * j);
    const int rbase = F.bx * 256 + F.wave * 32;
    f32x4 nb[4][4];
#pragma unroll
    for (int r = 0; r < 4; ++r) { const GAS f32x4* xr = (const GAS f32x4*)(xin + (size_t)(rbase + r) * D) + F.lane;
#pragma unroll
        for (int j = 0; j < 4; ++j) nb[r][j] = xr[64 * j]; }
    for (int g = 0; g < 8; ++g) {
        f32x4 v[4][4];
#pragma unroll
        for (int r = 0; r < 4; ++r)
#pragma unroll
            for (int j = 0; j < 4; ++j) v[r][j] = nb[r][j];
        if (g + 1 < 8) {
#pragma unroll
            for (int r = 0; r < 4; ++r) { const GAS f32x4* xr = (const GAS f32x4*)(xin + (size_t)(rbase + 4 * (g + 1) + r) * D) + F.lane;
#pragma unroll
                for (int j = 0; j < 4; ++j) nb[r][j] = xr[64 * j]; } }
        float ss[4];
#pragma unroll
        for (int r = 0; r < 4; ++r) { float s = 0.f;
#pragma unroll
            for (int j = 0; j < 4; ++j) s += (v[r][j].x * v[r][j].x + v[r][j].y * v[r][j].y) + (v[r][j].z * v[r][j].z + v[r][j].w * v[r][j].w);
            ss[r] = s; }
#pragma unroll
        for (int o = 1; o < 64; o <<= 1) {
#pragma unroll
            for (int r = 0; r < 4; ++r) ss[r] += __shfl_xor(ss[r], o); }
#pragma unroll
        for (int r = 0; r < 4; ++r) { const int m = rbase + 4 * g + r;
            const float rs = 1.0f / __builtin_sqrtf(ss[r] * (1.0f / D) + RMS_EPS);
            GAS v2u* xc = (GAS v2u*)(XR + (size_t)m * D) + F.lane; GAS v2u* o8 = (GAS v2u*)(HN + (size_t)m * D) + F.lane;
#pragma unroll
            for (int j = 0; j < 4; ++j) { v2u w; w.x = cvt_pk_bf16(v[r][j].x, v[r][j].y); w.y = cvt_pk_bf16(v[r][j].z, v[r][j].w); xc[64 * j] = w;
                const f32x4 h = v[r][j] * rs * gv[j]; v2u w2; w2.x = pk2(h.x, h.y); w2.y = pk2(h.z, h.w); o8[64 * j] = w2; } }
    }
}

__device__ __forceinline__ void router_phase(Frame& F, const xr_t* xin, const float* gain, unsigned char* HN8, const float* Wp, unsigned* TOPE, float* TOPW, unsigned* CNT, float hs) {
    LAS float* Wl = (LAS float*)(F.lds);
    LAS int* cnts = (LAS int*)(F.lds + 65536);
    for (int idx = F.tid; idx < NE * 1024; idx += NWAVES * 64) { const int c = idx / NE, p = idx % NE; Wl[p * 1024 + c] = Wp[(size_t)c * NE + p] * gain[c]; }
    if (F.tid < 16) cnts[F.tid] = 0;
    __syncthreads();
    f32x4 gv[4];
#pragma unroll
    for (int j = 0; j < 4; ++j) gv[j] = *(const f32x4*)(gain + 4 * F.lane + 256 * j);
    const int rbase = F.bx * 256 + F.wave * 32;
    const bool up1 = (F.lane & 1) != 0, up2 = (F.lane & 2) != 0, up4 = (F.lane & 4) != 0;
    v2u nb[4][4];
#pragma unroll
    for (int r = 0; r < 4; ++r) { const GAS v2u* xr = (const GAS v2u*)(xin + (size_t)(rbase + r) * D) + F.lane;
#pragma unroll
        for (int j = 0; j < 4; ++j) nb[r][j] = xr[64 * j]; }
    for (int g = 0; g < 8; ++g) {
        f32x4 v[4][4];
#pragma unroll
        for (int r = 0; r < 4; ++r)
#pragma unroll
            for (int j = 0; j < 4; ++j) { v[r][j].x = __uint_as_float(nb[r][j].x << 16); v[r][j].y = __uint_as_float(nb[r][j].x & 0xffff0000u); v[r][j].z = __uint_as_float(nb[r][j].y << 16); v[r][j].w = __uint_as_float(nb[r][j].y & 0xffff0000u); }
        if (g + 1 < 8) {
#pragma unroll
            for (int r = 0; r < 4; ++r) { const GAS v2u* xr = (const GAS v2u*)(xin + (size_t)(rbase + 4 * (g + 1) + r) * D) + F.lane;
#pragma unroll
                for (int j = 0; j < 4; ++j) nb[r][j] = xr[64 * j]; } }
        float a[4][8];
#pragma unroll
        for (int p = 0; p < 8; ++p) { f32x4 w[4];
#pragma unroll
            for (int j = 0; j < 4; ++j) w[j] = *(const LAS f32x4*)(Wl + p * 1024 + 4 * F.lane + 256 * j);
#pragma unroll
            for (int r = 0; r < 4; ++r) { float t = 0.f;
#pragma unroll
                for (int j = 0; j < 4; ++j) t += (v[r][j].x * w[j].x + v[r][j].y * w[j].y) + (v[r][j].z * w[j].z + v[r][j].w * w[j].w);
                a[r][p] = t; } }
        float d[4], ss[4];
#pragma unroll
        for (int r = 0; r < 4; ++r) { float s = 0.f;
#pragma unroll
            for (int j = 0; j < 4; ++j) s += (v[r][j].x * v[r][j].x + v[r][j].y * v[r][j].y) + (v[r][j].z * v[r][j].z + v[r][j].w * v[r][j].w);
            ss[r] = s; }
#pragma unroll
        for (int r = 0; r < 4; ++r) { float b4[4], c2[2];
#pragma unroll
            for (int k = 0; k < 4; ++k) { const float snd = up1 ? a[r][k] : a[r][k + 4], kept = up1 ? a[r][k + 4] : a[r][k]; b4[k] = kept + __shfl_xor(snd, 1); }
#pragma unroll
            for (int k = 0; k < 2; ++k) { const float snd = up2 ? b4[k] : b4[k + 2], kept = up2 ? b4[k + 2] : b4[k]; c2[k] = kept + __shfl_xor(snd, 2); }
            { const float snd = up4 ? c2[0] : c2[1], kept = up4 ? c2[1] : c2[0]; d[r] = kept + __shfl_xor(snd, 4); } }
#pragma unroll
        for (int o = 8; o < 64; o <<= 1) {
#pragma unroll
            for (int r = 0; r < 4; ++r) d[r] += __shfl_xor(d[r], o); }
#pragma unroll
        for (int o = 1; o < 64; o <<= 1) {
#pragma unroll
            for (int r = 0; r < 4; ++r) ss[r] += __shfl_xor(ss[r], o); }
#pragma unroll
        for (int r = 0; r < 4; ++r) {
            const int m = rbase + 4 * g + r;
            const float rs = 1.0f / __builtin_sqrtf(ss[r] * (1.0f / D) + RMS_EPS);
            GAS unsigned* o4 = (GAS unsigned*)(HN8 + (size_t)m * D) + F.lane;
#pragma unroll
            for (int j = 0; j < 4; ++j) { const f32x4 h = v[r][j] * rs * gv[j]; o4[64 * j] = pack4_fp8(h.x, h.y, h.z, h.w, hs); }
            float lg[8];
#pragma unroll
            for (int p = 0; p < 8; ++p) lg[p] = __shfl(d[r], (p >> 2) | (((p >> 1) & 1) << 1) | ((p & 1) << 2)) * rs;
            int i1 = 0; float l1 = lg[0];
#pragma unroll
            for (int p = 1; p < 8; ++p) if (lg[p] > l1) { l1 = lg[p]; i1 = p; }
            int i2 = (i1 == 0) ? 1 : 0; float l2 = (i1 == 0) ? lg[1] : lg[0];
#pragma unroll
            for (int p = 1; p < 8; ++p) if (p != i1 && lg[p] > l2) { l2 = lg[p]; i2 = p; }
            const float w1 = 1.0f / (1.0f + __expf(l2 - l1)), w2 = 1.0f - w1;
            if (F.lane == 0) { TOPE[m] = (unsigned)i1 | ((unsigned)i2 << 8); TOPW[2 * (size_t)m] = w1; TOPW[2 * (size_t)m + 1] = w2;
                atomicAdd((int*)&cnts[i1], 1); atomicAdd((int*)&cnts[8 + i2], 1); }
        }
    }
    __syncthreads(); if (F.tid < 16) CNT[F.bx * 16 + F.tid] = (unsigned)cnts[F.tid];
    __syncthreads();
}

__device__ __forceinline__ void split3(float v, unsigned& w01, unsigned& w2) {
    const unsigned t0 = f2bf(v); const float r1 = v - __builtin_bit_cast(float, t0 << 16);
    const unsigned t1 = f2bf(r1); const float r2 = r1 - __builtin_bit_cast(float, t1 << 16);
    w01 = t0 | (t1 << 16); w2 = f2bf(r2);
}
__device__ __forceinline__ void cumsum_phase(Frame& F, const float* LOGF, float* F2, int* T0, bf16* QX, bf16* KX, const float* qg, const float* kg) {
    if (F.bx >= BATCH * NH) return;
    const int b = F.bx >> 4, h = F.bx & 15;
    LAS float* sh = (LAS float*)(F.lds);
    LAS float* Fls = (LAS float*)(F.lds + 1024);
    float mq = fabsf(qg[F.lane]), mk = fabsf(kg[F.lane]);
#pragma unroll
    for (int o = 1; o < 64; o <<= 1) { mq = fmaxf(mq, __shfl_xor(mq, o)); mk = fmaxf(mk, __shfl_xor(mk, o)); }
    const float mfix = 8.0f * mq * mk * LOG2E * 1.02f;
    float v[16]; float run = 0.f;
#pragma unroll
    for (int k = 0; k < 16; ++k) { run += LOGF[((size_t)b * SEQ + 16 * F.tid + k) * 16 + h]; v[k] = run; }
    float inc = run;
#pragma unroll
    for (int o = 1; o < 64; o <<= 1) { const float t = __shfl_up(inc, o); if (F.lane >= o) inc += t; }
    if (F.lane == 63) sh[F.wave] = inc;
    __syncthreads();
    float pre = inc - run;
    for (int w = 0; w < F.wave; ++w) pre += sh[w];
    float* o = F2 + (size_t)F.bx * SEQ + 16 * F.tid;
    v4u* qx = (v4u*)(QX + ((size_t)F.bx * SEQ + 16 * F.tid) * 8); v4u* kx = (v4u*)(KX + ((size_t)F.bx * SEQ + 16 * F.tid) * 16);
#pragma unroll
    for (int k = 0; k < 16; k += 4) { const f32x4 q = (f32x4){(pre + v[k]) * LOG2E, (pre + v[k + 1]) * LOG2E, (pre + v[k + 2]) * LOG2E, (pre + v[k + 3]) * LOG2E};
        *(f32x4*)(o + k) = q; *(LAS f32x4*)(Fls + 16 * F.tid + k) = q;
#pragma unroll
        for (int e = 0; e < 4; ++e) { unsigned a01, a2, b01, b2; split3(q[e] - mfix, a01, a2); split3(-q[e], b01, b2);
            qx[k + e] = (v4u){a01, a2 | 0x3f800000u, 0x3f803f80u, 0u};
            kx[2 * (k + e)] = (v4u){0x3f803f80u, 0x3f80u | (b01 << 16), (b01 >> 16) | (b2 << 16), 0u};
            kx[2 * (k + e) + 1] = (v4u){0u, 0u, 0u, 0u}; } }
    __syncthreads();
    if (F.tid < 32) { const int qb = F.tid; const float target = Fls[256 * qb] + SKIP_THR; int lo_ = 0, hi_ = 4 * qb;
        while (lo_ < hi_) { const int mid = (lo_ + hi_) >> 1; if (Fls[64 * mid + 63] <= target) hi_ = mid; else lo_ = mid + 1; }
        T0[F.bx * 32 + qb] = lo_; }
    __syncthreads();
}

__device__ __forceinline__ void conv_phase(Frame& F, const bf16* XB, const float* cw, const float* cb, bf16* XC) {
    const int gt = F.bx * (NWAVES * 64) + F.tid, cg = gt & 127, c0 = cg * 8;
    float w[4][8], bias[8];
#pragma unroll
    for (int j = 0; j < 4; ++j)
#pragma unroll
        for (int c = 0; c < 8; ++c) w[j][c] = cw[j * D + c0 + c];
#pragma unroll
    for (int c = 0; c < 8; ++c) bias[c] = cb[c0 + c];
    const int nchunk_threads = (F.G * NWAVES * 64) >> 7;
    for (int chunk = gt >> 7; chunk < T / 16; chunk += nchunk_threads) {
        const int t0 = chunk * 16, s0 = t0 & (SEQ - 1);
        float xw[3][8];
#pragma unroll
        for (int r = 0; r < 3; ++r) {
            if (s0 == 0) {
#pragma unroll
                for (int c = 0; c < 8; ++c) xw[r][c] = 0.f;
            } else { const v4u q = *(const v4u*)(XB + (size_t)(t0 - 3 + r) * D + c0);
                xw[r][0] = bflo(q.x); xw[r][1] = bfhi(q.x); xw[r][2] = bflo(q.y); xw[r][3] = bfhi(q.y); xw[r][4] = bflo(q.z); xw[r][5] = bfhi(q.z); xw[r][6] = bflo(q.w); xw[r][7] = bfhi(q.w); }
        }
        v4u qr[16];
#pragma unroll
        for (int i = 0; i < 16; ++i) qr[i] = *(const v4u*)(XB + (size_t)(t0 + i) * D + c0);
#pragma unroll
        for (int i = 0; i < 16; ++i) {
            const v4u q = qr[i];
            float x3[8] = {bflo(q.x), bfhi(q.x), bflo(q.y), bfhi(q.y), bflo(q.z), bfhi(q.z), bflo(q.w), bfhi(q.w)};
            float o[8];
#pragma unroll
            for (int c = 0; c < 8; ++c) o[c] = bias[c] + w[0][c] * xw[0][c] + w[1][c] * xw[1][c] + w[2][c] * xw[2][c] + w[3][c] * x3[c];
            v4u ov; ov.x = pk2(o[0], o[1]); ov.y = pk2(o[2], o[3]); ov.z = pk2(o[4], o[5]); ov.w = pk2(o[6], o[7]);
            *(v4u*)(XC + (size_t)(t0 + i) * D + c0) = ov;
#pragma unroll
            for (int c = 0; c < 8; ++c) { xw[0][c] = xw[1][c]; xw[1][c] = xw[2][c]; xw[2][c] = x3[c]; }
        }
    }
}

constexpr int SCH = 128, NCH = SEQ / SCH;
__device__ __forceinline__ void scan_agg_phase(Frame& F, const unsigned* AB, float* AGG) {
    for (int item = F.bx; item < BATCH * NCH; item += F.G) {
        const size_t t0 = (size_t)item * SCH; const int ch = 2 * F.tid;
        float h0 = 0.f, h1 = 0.f, A0 = 1.f, A1 = 1.f;
        const unsigned* p = AB + t0 * D + ch;
        v2u qa[8], qb[8];
#pragma unroll
        for (int k = 0; k < 8; ++k) qa[k] = *(const v2u*)(p + (size_t)k * D);
        for (int t = 0; t < SCH; t += 16) {
#pragma unroll
            for (int k = 0; k < 8; ++k) qb[k] = *(const v2u*)(p + (size_t)(t + 8 + k) * D);
#pragma unroll
            for (int k = 0; k < 8; ++k) { const float a0 = fast_exp2(bfhi(qa[k].x)), a1 = fast_exp2(bfhi(qa[k].y));
                h0 = a0 * h0 + bflo(qa[k].x); h1 = a1 * h1 + bflo(qa[k].y); A0 *= a0; A1 *= a1; }
            if (t + 16 < SCH) {
#pragma unroll
                for (int k = 0; k < 8; ++k) qa[k] = *(const v2u*)(p + (size_t)(t + 16 + k) * D); }
#pragma unroll
            for (int k = 0; k < 8; ++k) { const float a0 = fast_exp2(bfhi(qb[k].x)), a1 = fast_exp2(bfhi(qb[k].y));
                h0 = a0 * h0 + bflo(qb[k].x); h1 = a1 * h1 + bflo(qb[k].y); A0 *= a0; A1 *= a1; }
        }
        *(f32x4*)(AGG + ((size_t)item * D + ch) * 2) = (f32x4){A0, h0, A1, h1};
    }
}
__device__ __forceinline__ void scan_out_phase(Frame& F, const unsigned* AB, const float* AGG, const bf16* Y, bf16* HY) {
    for (int item = F.bx; item < BATCH * NCH; item += F.G) {
        const int c = item & (NCH - 1); const size_t t0 = (size_t)item * SCH; const int ch = 2 * F.tid;
        float h0 = 0.f, h1 = 0.f;
        const float* ag = AGG + ((size_t)(item - c) * D + ch) * 2;
        const unsigned* p = AB + t0 * D + ch; const bf16* yp = Y + t0 * D + ch; bf16* op = HY + t0 * D + ch;
        v2u qa[8], qb[8]; unsigned ya[8], yb[8];
#pragma unroll
        for (int k = 0; k < 8; ++k) { qa[k] = *(const v2u*)(p + (size_t)k * D); ya[k] = *(const unsigned*)(yp + (size_t)k * D); }
        { int cc = 0;
          for (; cc + 8 <= c; cc += 8) { f32x4 g[8];
#pragma unroll
              for (int k = 0; k < 8; ++k) g[k] = *(const f32x4*)(ag + (size_t)(cc + k) * D * 2);
#pragma unroll
              for (int k = 0; k < 8; ++k) { h0 = g[k].x * h0 + g[k].y; h1 = g[k].z * h1 + g[k].w; } }
          for (; cc < c; ++cc) { const f32x4 g = *(const f32x4*)(ag + (size_t)cc * D * 2); h0 = g.x * h0 + g.y; h1 = g.z * h1 + g.w; } }
        for (int t = 0; t < SCH; t += 16) {
#pragma unroll
            for (int k = 0; k < 8; ++k) { qb[k] = *(const v2u*)(p + (size_t)(t + 8 + k) * D); yb[k] = *(const unsigned*)(yp + (size_t)(t + 8 + k) * D); }
            unsigned oa[8];
#pragma unroll
            for (int k = 0; k < 8; ++k) { const float a0 = fast_exp2(bfhi(qa[k].x)), a1 = fast_exp2(bfhi(qa[k].y));
                h0 = a0 * h0 + bflo(qa[k].x); h1 = a1 * h1 + bflo(qa[k].y); oa[k] = pk2(h0 * bflo(ya[k]), h1 * bfhi(ya[k])); }
            if (t + 16 < SCH) {
#pragma unroll
                for (int k = 0; k < 8; ++k) { qa[k] = *(const v2u*)(p + (size_t)(t + 16 + k) * D); ya[k] = *(const unsigned*)(yp + (size_t)(t + 16 + k) * D); } }
#pragma unroll
            for (int k = 0; k < 8; ++k) *(unsigned*)(op + (size_t)(t + k) * D) = oa[k];
#pragma unroll
            for (int k = 0; k < 8; ++k) { const float a0 = fast_exp2(bfhi(qb[k].x)), a1 = fast_exp2(bfhi(qb[k].y));
                h0 = a0 * h0 + bflo(qb[k].x); h1 = a1 * h1 + bflo(qb[k].y); oa[k] = pk2(h0 * bflo(yb[k]), h1 * bfhi(yb[k])); }
#pragma unroll
            for (int k = 0; k < 8; ++k) *(unsigned*)(op + (size_t)(t + 8 + k) * D) = oa[k];
        }
    }
}

__device__ __forceinline__ void moe_build_phase(Frame& F, const unsigned* TOPE, const float* TOPW, unsigned* CNT, unsigned* LIST, float* LISTW, unsigned* TILE, unsigned* NTL) {
    LAS int* sh = (LAS int*)(F.lds);
    const int bx = F.bx;
    { const int slot = F.tid & 15, grp = F.tid >> 4; int tot = 0, off = 0;
      for (int c = grp; c < F.G; c += 32) { const int v = (int)__hip_atomic_load(CNT + c * 16 + slot, RLX_AGENT); if (c < bx) off += v; tot += v; }
      sh[128 + grp * 16 + slot] = tot; sh[128 + 512 + grp * 16 + slot] = off; }
    __syncthreads();
    if (F.tid < 16) { int tot = 0, off = 0; for (int g2 = 0; g2 < 32; ++g2) { tot += sh[128 + g2 * 16 + F.tid]; off += sh[128 + 512 + g2 * 16 + F.tid]; } sh[F.tid] = tot; sh[16 + F.tid] = off; }
    __syncthreads();
    if (F.tid < 2) { const int p = F.tid; int a = 0; for (int e = 0; e < 8; ++e) { sh[32 + p * 8 + e] = a; a += (sh[p * 8 + e] + 255) & ~255; } sh[48 + p] = a >> 8; }
    __syncthreads();
    const int p = F.tid >> 8, i = F.tid & 255, t = bx * 256 + i;
    const unsigned te = TOPE[t]; const int e = (int)((te >> (8 * p)) & 0xffu); const float w = TOPW[2 * (size_t)t + p];
    int rank = 0;
    const unsigned long long lt = (F.lane == 0) ? 0ull : (~0ull >> (64 - F.lane));
#pragma unroll
    for (int ee = 0; ee < 8; ++ee) { const unsigned long long mk = __ballot(e == ee); if (e == ee) rank = __popcll(mk & lt); if (F.lane == 0) sh[64 + F.wave * 8 + ee] = __popcll(mk); }
    __syncthreads();
    int wpre = 0; for (int w2 = (F.wave & 4); w2 < F.wave; ++w2) wpre += sh[64 + w2 * 8 + e];
    const int pos = sh[32 + p * 8 + e] + sh[16 + p * 8 + e] + wpre + rank;
    LIST[(size_t)p * LISTCAP + pos] = (unsigned)t | 0x80000000u; LISTW[(size_t)p * LISTCAP + pos] = w;
    if (bx < 16) { const int pp = bx >> 3, ee = bx & 7; const int st = sh[32 + pp * 8 + ee], n = sh[pp * 8 + ee], cap = (n + 255) & ~255;
        for (int k = n + F.tid; k < cap; k += NWAVES * 64) { LIST[(size_t)pp * LISTCAP + st + k] = 0u; LISTW[(size_t)pp * LISTCAP + st + k] = 0.f; }
        for (int k = F.tid; k < (cap >> 8); k += NWAVES * 64) TILE[pp * 272 + (st >> 8) + k] = (unsigned)ee;
        if (ee == 0 && F.tid == 0) NTL[pp] = (unsigned)sh[48 + pp]; }
    __syncthreads();
}

namespace fa {
constexpr int KSLOT = 10240, VSLOT = 8192, NKS = 4, NVS = 3;
constexpr int L_K = 0, L_V = NKS * KSLOT, L_WS = L_V + NVS * VSLOT, L_OST = L_WS + NWAVES * 256, L_END = L_OST + NWAVES * 4096;
__device__ __forceinline__ int crow(int r, int hi) { return (r & 3) + 8 * (r >> 2) + 4 * hi; }
__device__ __forceinline__ void glds16(const void* gsrc, unsigned lds_dst) { unsigned keep;
    asm volatile("s_mov_b32 %0, m0\n\ts_mov_b32 m0, %2\n\ts_nop 0\n\tglobal_load_lds_dwordx4 %1, off\n\ts_mov_b32 m0, %0" : "=&s"(keep) : "v"(gsrc), "s"(lds_dst) : "memory"); }
__device__ __forceinline__ void glds16s(const void* sbase, unsigned voff, unsigned lds_dst) { unsigned keep;
    asm volatile("s_mov_b32 %0, m0\n\ts_mov_b32 m0, %3\n\ts_nop 0\n\tglobal_load_lds_dwordx4 %1, %2\n\ts_mov_b32 m0, %0" : "=&s"(keep) : "v"(voff), "s"(sbase), "s"(lds_dst) : "memory"); }
__device__ __forceinline__ void glds4(const void* gsrc, unsigned lds_dst) { unsigned keep;
    asm volatile("s_mov_b32 %0, m0\n\ts_mov_b32 m0, %2\n\ts_nop 0\n\tglobal_load_lds_dword %1, off\n\ts_mov_b32 m0, %0" : "=&s"(keep) : "v"(gsrc), "s"(lds_dst) : "memory"); }
#define FA_WAIT_BAR() asm volatile("s_waitcnt vmcnt(0) lgkmcnt(0)\n\ts_barrier" ::: "memory")

__device__ __forceinline__ void qkt(f32x16& p0, f32x16& p1, const LAS unsigned char* kb, const bf16x8 (&qr)[5]) {
    p0 = f32x16{}; p1 = f32x16{};
#pragma unroll
    for (int d0 = 0; d0 < 5; ++d0) {
        const bf16x8 b0 = *(const LAS bf16x8*)(kb + d0 * 2048);
        const bf16x8 b1 = *(const LAS bf16x8*)(kb + d0 * 2048 + 512);
        p0 = __builtin_amdgcn_mfma_f32_32x32x16_bf16(b0, qr[d0], p0, 0, 0, 0); p1 = __builtin_amdgcn_mfma_f32_32x32x16_bf16(b1, qr[d0], p1, 0, 0, 0); }
}

__device__ __forceinline__ void attn_unit(int b, int h, int qb, const bf16* Q, const bf16* K, const bf16* V, const bf16* Gt, bf16* O, const bf16* QX, const bf16* KX, LAS unsigned char* lds, unsigned lds0, int tid, int t0, gu32* qhead, LAS unsigned* uq) {
    const int lane = tid & 63, r32 = lane & 31, hi = lane >> 5; const int wid = __builtin_amdgcn_readfirstlane(tid >> 6);
    const size_t rowbase = (size_t)b * SEQ; const int q0 = qb * 256; const int bh = b * NH + h;
    const bf16* Qw = Q + (rowbase + q0 + wid * 32) * D + h * HD;
    const bf16* Kh = K + rowbase * D + h * HD; const bf16* Vh = V + rowbase * D + h * HD;
    const int NT = (q0 + 256) / 64;
    t0 -= (NT - t0) & 1;
    const bf16* ksrc = Kh + (size_t)lane * D + wid * 8;
    const bf16* vsrc = Vh + (size_t)(16 * (wid & 3) + (lane >> 2)) * D + (wid >> 2) * 32 + (lane & 3) * 8;
    const bf16* xsrc = KX + ((size_t)bh * SEQ + lane) * 16 + (wid & 1) * 8;
    const unsigned kdst = lds0 + L_K + wid * 1024, vdst = lds0 + L_V + wid * 1024, xdst = lds0 + L_K + 8192 + (wid & 1) * 1024;
#define FA_DMAK(t_) do { const int sk_ = ((t_) % NKS); \
        glds16(ksrc + (size_t)(t_) * 64 * D, (unsigned)__builtin_amdgcn_readfirstlane((int)(kdst + sk_ * KSLOT))); \
        if (wid < 2) glds16(xsrc + (size_t)(t_) * 64 * 16, (unsigned)__builtin_amdgcn_readfirstlane((int)(xdst + sk_ * KSLOT))); } while (0)
#define FA_DMAV(t_) do { const int sv_ = ((t_) % NVS); \
        glds16(vsrc + (size_t)(t_) * 64 * D, (unsigned)__builtin_amdgcn_readfirstlane((int)(vdst + sv_ * VSLOT))); } while (0)
    FA_DMAK(t0); FA_DMAV(t0);
    if (t0 + 1 < NT) FA_DMAK(t0 + 1);
    if (t0 + 2 < NT) FA_DMAK(t0 + 2);
    bf16x8 qr[5];
#pragma unroll
    for (int d0 = 0; d0 < 4; ++d0) qr[d0] = *(const bf16x8*)(Qw + (size_t)r32 * D + d0 * 16 + hi * 8);
    { const bf16x8 qx = *(const bf16x8*)(QX + ((size_t)bh * SEQ + q0 + wid * 32 + r32) * 8); qr[4] = hi ? (bf16x8){0, 0, 0, 0, 0, 0, 0, 0} : qx; }
    f32x16 o[2]; o[0] = f32x16{}; o[1] = f32x16{};
    float lsum = 0.f;
    const int qrel = wid * 32 + r32;
    const LAS unsigned char* kbase = lds + L_K + hi * 1024 + r32 * 16;
    const LAS unsigned char* vbp = lds + L_V + ((lane >> 4) & 1) * 32 + (lane & 3) * 8 + (4 * hi + ((lane & 15) >> 2)) * 64;
    FA_WAIT_BAR();
#define FA_SB() __builtin_amdgcn_sched_barrier(0)
#define FA_EX4(P, B) do { P[B] = fast_exp2(P[B]); P[B + 1] = fast_exp2(P[B + 1]); P[B + 2] = fast_exp2(P[B + 2]); P[B + 3] = fast_exp2(P[B + 3]); asm volatile("" : "+v"(P)); } while (0)
#define FA_KLD(j, T_) do { const LAS unsigned char* kb_ = kbase + ((T_) % NKS) * KSLOT; kf[2 * (j)] = *(const LAS bf16x8*)(kb_ + (j) * 2048); kf[2 * (j) + 1] = *(const LAS bf16x8*)(kb_ + (j) * 2048 + 512); } while (0)
#define FA_MASK(C0, C1, T_) do { if ((T_) >= NT - 4) { const int kb2_ = 64 * (T_) - q0 + 4 * hi; \
        _Pragma("unroll") for (int r = 0; r < 16; ++r) { const int kv = kb2_ + (r & 3) + 8 * (r >> 2); if (kv > qrel) C0[r] = -INFINITY; if (kv + 32 > qrel) C1[r] = -INFINITY; } } } while (0)
#define FA_VRD(i, VB) do { lo[i] = __builtin_bit_cast(s16x4, __builtin_amdgcn_ds_read_tr16_b64_v4i16((LAS s16x4*)((VB) + ((i) >> 2) * 4096 + ((i) & 3) * 1024))); \
        hh[i] = __builtin_bit_cast(s16x4, __builtin_amdgcn_ds_read_tr16_b64_v4i16((LAS s16x4*)((VB) + ((i) >> 2) * 4096 + ((i) & 3) * 1024 + 512))); } while (0)
#define FA_PK(k) (bf16x8){lo[k][0], lo[k][1], lo[k][2], lo[k][3], hh[k][0], hh[k][1], hh[k][2], hh[k][3]}
#define FA_AD4(P, B) do { sacc += (P[B] + P[B + 1]) + (P[B + 2] + P[B + 3]); asm volatile("" : "+v"(sacc)); } while (0)
#define FA_ENDWAIT(T_) do { const int nfl_ = (((T_) + 3 < NT) ? ((wid < 2) ? 2 : 1) : 0) + (((T_) + 1 < NT) ? 1 : 0); \
        if (nfl_ == 3) asm volatile("s_waitcnt vmcnt(3) lgkmcnt(0)\n\ts_barrier" ::: "memory"); \
        else if (nfl_ == 2) asm volatile("s_waitcnt vmcnt(2) lgkmcnt(0)\n\ts_barrier" ::: "memory"); \
        else if (nfl_ == 1) asm volatile("s_waitcnt vmcnt(1) lgkmcnt(0)\n\ts_barrier" ::: "memory"); \
        else FA_WAIT_BAR(); } while (0)
    bf16x8 kf[10];
    f32x16 c0, c1;
    s16x4 lo[8], hh[8]; v4u pw0, pw1, pw2, pw3;
    {
#pragma unroll
        for (int j = 0; j < 5; ++j) FA_KLD(j, t0);
        c0 = f32x16{}; c1 = f32x16{};
#pragma unroll
        for (int d0 = 0; d0 < 5; ++d0) { c0 = __builtin_amdgcn_mfma_f32_32x32x16_bf16(kf[2 * d0], qr[d0], c0, 0, 0, 0); c1 = __builtin_amdgcn_mfma_f32_32x32x16_bf16(kf[2 * d0 + 1], qr[d0], c1, 0, 0, 0); }
        FA_SB();
        if (t0 + 3 < NT) FA_DMAK(t0 + 3);
        if (t0 + 1 < NT) FA_DMAV(t0 + 1);
        FA_MASK(c0, c1, t0);
        FA_EX4(c0, 0); FA_EX4(c0, 4); FA_EX4(c0, 8); FA_EX4(c0, 12); FA_EX4(c1, 0); FA_EX4(c1, 4); FA_EX4(c1, 8); FA_EX4(c1, 12);
        if (t0 + 1 < NT) {
#pragma unroll
            for (int j = 0; j < 3; ++j) FA_KLD(j, t0 + 1);
        }
        FA_SB(); FA_ENDWAIT(t0); FA_SB();
    }
#define FA_STEP(T_, C0, C1, P0, P1) do { \
        const LAS unsigned char* vb = vbp + (((T_) - 1) % NVS) * VSLOT; \
        float sacc = 0.f; \
        FA_VRD(0, vb); FA_SB(); C0 = __builtin_amdgcn_mfma_f32_32x32x16_bf16(kf[0], qr[0], f32x16{}, 0, 0, 0); FA_AD4(P0, 0); pw0.x = cvt_pk_bf16(P0[0], P0[1]); pw0.y = cvt_pk_bf16(P0[2], P0[3]); FA_SB(); \
        FA_VRD(4, vb); FA_SB(); C1 = __builtin_amdgcn_mfma_f32_32x32x16_bf16(kf[1], qr[0], f32x16{}, 0, 0, 0); FA_AD4(P0, 4); pw0.z = cvt_pk_bf16(P0[4], P0[5]); pw0.w = cvt_pk_bf16(P0[6], P0[7]); FA_SB(); \
        FA_KLD(3, (T_)); FA_SB(); \
        FA_VRD(1, vb); FA_SB(); C0 = __builtin_amdgcn_mfma_f32_32x32x16_bf16(kf[2], qr[1], C0, 0, 0, 0); FA_AD4(P0, 8); pw1.x = cvt_pk_bf16(P0[8], P0[9]); pw1.y = cvt_pk_bf16(P0[10], P0[11]); FA_SB(); \
        FA_VRD(5, vb); FA_SB(); C1 = __builtin_amdgcn_mfma_f32_32x32x16_bf16(kf[3], qr[1], C1, 0, 0, 0); FA_AD4(P0, 12); pw1.z = cvt_pk_bf16(P0[12], P0[13]); pw1.w = cvt_pk_bf16(P0[14], P0[15]); FA_SB(); \
        FA_KLD(4, (T_)); FA_SB(); \
        FA_VRD(2, vb); FA_SB(); C0 = __builtin_amdgcn_mfma_f32_32x32x16_bf16(kf[4], qr[2], C0, 0, 0, 0); FA_AD4(P1, 0); pw2.x = cvt_pk_bf16(P1[0], P1[1]); pw2.y = cvt_pk_bf16(P1[2], P1[3]); FA_SB(); \
        FA_VRD(6, vb); FA_SB(); C1 = __builtin_amdgcn_mfma_f32_32x32x16_bf16(kf[5], qr[2], C1, 0, 0, 0); FA_AD4(P1, 4); pw2.z = cvt_pk_bf16(P1[4], P1[5]); pw2.w = cvt_pk_bf16(P1[6], P1[7]); FA_SB(); \
        FA_VRD(3, vb); FA_SB(); C0 = __builtin_amdgcn_mfma_f32_32x32x16_bf16(kf[6], qr[3], C0, 0, 0, 0); FA_AD4(P1, 8); pw3.x = cvt_pk_bf16(P1[8], P1[9]); pw3.y = cvt_pk_bf16(P1[10], P1[11]); FA_SB(); \
        FA_VRD(7, vb); FA_SB(); C1 = __builtin_amdgcn_mfma_f32_32x32x16_bf16(kf[7], qr[3], C1, 0, 0, 0); FA_AD4(P1, 12); pw3.z = cvt_pk_bf16(P1[12], P1[13]); pw3.w = cvt_pk_bf16(P1[14], P1[15]); FA_SB(); \
        C0 = __builtin_amdgcn_mfma_f32_32x32x16_bf16(kf[8], qr[4], C0, 0, 0, 0); \
        C1 = __builtin_amdgcn_mfma_f32_32x32x16_bf16(kf[9], qr[4], C1, 0, 0, 0); FA_SB(); \
        lsum += sacc; \
        if ((T_) + 3 < NT) FA_DMAK((T_) + 3); \
        if ((T_) + 1 < NT) FA_DMAV((T_) + 1); \
        FA_MASK(C0, C1, (T_)); \
        FA_SB(); \
        const bool more = ((T_) + 1 < NT); \
        o[0] = __builtin_amdgcn_mfma_f32_32x32x16_bf16(__builtin_bit_cast(bf16x8, pw0), FA_PK(0), o[0], 0, 0, 0); FA_EX4(C0, 0); FA_SB(); \
        o[1] = __builtin_amdgcn_mfma_f32_32x32x16_bf16(__builtin_bit_cast(bf16x8, pw0), FA_PK(4), o[1], 0, 0, 0); FA_EX4(C0, 4); FA_SB(); \
        if (more) FA_KLD(0, (T_) + 1); FA_SB(); \
        o[0] = __builtin_amdgcn_mfma_f32_32x32x16_bf16(__builtin_bit_cast(bf16x8, pw1), FA_PK(1), o[0], 0, 0, 0); FA_EX4(C0, 8); FA_SB(); \
        if (more) FA_KLD(1, (T_) + 1); FA_SB(); \
        o[1] = __builtin_amdgcn_mfma_f32_32x32x16_bf16(__builtin_bit_cast(bf16x8, pw1), FA_PK(5), o[1], 0, 0, 0); FA_EX4(C0, 12); FA_SB(); \
        if (more) FA_KLD(2, (T_) + 1); FA_SB(); \
        o[0] = __builtin_amdgcn_mfma_f32_32x32x16_bf16(__builtin_bit_cast(bf16x8, pw2), FA_PK(2), o[0], 0, 0, 0); FA_EX4(C1, 0); FA_SB(); \
        o[1] = __builtin_amdgcn_mfma_f32_32x32x16_bf16(__builtin_bit_cast(bf16x8, pw2), FA_PK(6), o[1], 0, 0, 0); FA_EX4(C1, 4); FA_SB(); \
        o[0] = __builtin_amdgcn_mfma_f32_32x32x16_bf16(__builtin_bit_cast(bf16x8, pw3), FA_PK(3), o[0], 0, 0, 0); FA_EX4(C1, 8); FA_SB(); \
        o[1] = __builtin_amdgcn_mfma_f32_32x32x16_bf16(__builtin_bit_cast(bf16x8, pw3), FA_PK(7), o[1], 0, 0, 0); FA_EX4(C1, 12); FA_SB(); \
        FA_ENDWAIT((T_)); FA_SB(); \
    } while (0)
    f32x16 d0, d1;
    int t = t0 + 1;
    FA_STEP(t, d0, d1, c0, c1); ++t;
    for (; t + 1 < NT; t += 2) { FA_STEP(t, c0, c1, d0, d1); FA_STEP(t + 1, d0, d1, c0, c1); }
#undef FA_STEP
    {
        const LAS unsigned char* vb = vbp + ((NT - 1) % NVS) * VSLOT;
#pragma unroll
        for (int i = 0; i < 8; ++i) FA_VRD(i, vb);
        float sacc = 0.f;
        FA_AD4(d0, 0); FA_AD4(d0, 4); FA_AD4(d0, 8); FA_AD4(d0, 12); FA_AD4(d1, 0); FA_AD4(d1, 4); FA_AD4(d1, 8); FA_AD4(d1, 12);
        lsum += sacc;
        pw0 = (v4u){cvt_pk_bf16(d0[0], d0[1]), cvt_pk_bf16(d0[2], d0[3]), cvt_pk_bf16(d0[4], d0[5]), cvt_pk_bf16(d0[6], d0[7])};
        pw1 = (v4u){cvt_pk_bf16(d0[8], d0[9]), cvt_pk_bf16(d0[10], d0[11]), cvt_pk_bf16(d0[12], d0[13]), cvt_pk_bf16(d0[14], d0[15])};
        pw2 = (v4u){cvt_pk_bf16(d1[0], d1[1]), cvt_pk_bf16(d1[2], d1[3]), cvt_pk_bf16(d1[4], d1[5]), cvt_pk_bf16(d1[6], d1[7])};
        pw3 = (v4u){cvt_pk_bf16(d1[8], d1[9]), cvt_pk_bf16(d1[10], d1[11]), cvt_pk_bf16(d1[12], d1[13]), cvt_pk_bf16(d1[14], d1[15])};
        FA_SB();
        o[0] = __builtin_amdgcn_mfma_f32_32x32x16_bf16(__builtin_bit_cast(bf16x8, pw0), FA_PK(0), o[0], 0, 0, 0);
        o[1] = __builtin_amdgcn_mfma_f32_32x32x16_bf16(__builtin_bit_cast(bf16x8, pw0), FA_PK(4), o[1], 0, 0, 0);
        o[0] = __builtin_amdgcn_mfma_f32_32x32x16_bf16(__builtin_bit_cast(bf16x8, pw1), FA_PK(1), o[0], 0, 0, 0);
        o[1] = __builtin_amdgcn_mfma_f32_32x32x16_bf16(__builtin_bit_cast(bf16x8, pw1), FA_PK(5), o[1], 0, 0, 0);
        o[0] = __builtin_amdgcn_mfma_f32_32x32x16_bf16(__builtin_bit_cast(bf16x8, pw2), FA_PK(2), o[0], 0, 0, 0);
        o[1] = __builtin_amdgcn_mfma_f32_32x32x16_bf16(__builtin_bit_cast(bf16x8, pw2), FA_PK(6), o[1], 0, 0, 0);
        o[0] = __builtin_amdgcn_mfma_f32_32x32x16_bf16(__builtin_bit_cast(bf16x8, pw3), FA_PK(3), o[0], 0, 0, 0);
        o[1] = __builtin_amdgcn_mfma_f32_32x32x16_bf16(__builtin_bit_cast(bf16x8, pw3), FA_PK(7), o[1], 0, 0, 0);
        FA_SB();
    }
#undef FA_SB
#undef FA_EX4
#undef FA_KLD
#undef FA_MASK
#undef FA_VRD
#undef FA_PK
#undef FA_AD4
#undef FA_ENDWAIT
#undef FA_DMAK
#undef FA_DMAV
    unsigned nxt_ticket = 0u; if (tid == 0) nxt_ticket = __hip_atomic_fetch_add(qhead, 1u, RLX_AGENT);
    bf16* Ow = O + (rowbase + q0 + wid * 32) * D + h * HD; const bf16* Gw = Gt + (rowbase + q0 + wid * 32) * D + h * HD;
    v4u gq4[4];
#pragma unroll
    for (int i = 0; i < 4; ++i) gq4[i] = *(const v4u*)(Gw + (size_t)(i * 8 + (lane >> 3)) * D + (lane & 7) * 8);
    { auto rr = __builtin_amdgcn_permlane32_swap(__float_as_uint(lsum), __float_as_uint(lsum), false, false); lsum = __uint_as_float(rr[0]) + __uint_as_float(rr[1]); }
    LAS float* wsf = (LAS float*)(lds + L_WS) + wid * 64;
    if (hi == 0) wsf[r32] = lsum;
    asm volatile("s_waitcnt lgkmcnt(0)" ::: "memory");
    float rli[16];
#pragma unroll
    for (int r = 0; r < 16; ++r) rli[r] = fast_rcp(wsf[crow(r, hi)]);
    LAS bf16* stg = (LAS bf16*)(lds + L_OST) + wid * 2048;
#pragma unroll
    for (int r = 0; r < 16; ++r) { const int orow = crow(r, hi);
#pragma unroll
        for (int d0 = 0; d0 < 2; ++d0) stg[orow * 64 + d0 * 32 + r32] = (bf16)f2bf(o[d0][r] * rli[r]); }
    asm volatile("s_waitcnt lgkmcnt(0)" ::: "memory");
#pragma unroll
    for (int i = 0; i < 4; ++i) { const int row = i * 8 + (lane >> 3), chn = lane & 7; const v4u v = *(const LAS v4u*)(stg + row * 64 + chn * 8); const v4u gq = gq4[i];
        v4u w; w.x = pk2(bflo(v.x) * bflo(gq.x), bfhi(v.x) * bfhi(gq.x)); w.y = pk2(bflo(v.y) * bflo(gq.y), bfhi(v.y) * bfhi(gq.y)); w.z = pk2(bflo(v.z) * bflo(gq.z), bfhi(v.z) * bfhi(gq.z)); w.w = pk2(bflo(v.w) * bflo(gq.w), bfhi(v.w) * bfhi(gq.w));
        *(v4u*)(Ow + (size_t)row * D + chn * 8) = w; }
    if (tid == 0) *uq = nxt_ticket;
    FA_WAIT_BAR();
}
}

__device__ __forceinline__ void attn_phase(Frame& F, const bf16* Q, const bf16* K, const bf16* V, const bf16* Gt, bf16* O, const bf16* QX, const bf16* KX, const int* T0, const float* bfv, gu32* qctr) {
    const unsigned lds0 = (unsigned)(uintptr_t)F.ldsg;
    int myrank = 99;
    if (F.lane < NH) { const float mine = bfv[F.lane]; myrank = 0; for (int h2 = 0; h2 < NH; ++h2) { const float o = bfv[h2]; myrank += (o > mine || (o == mine && h2 < F.lane)) ? 1 : 0; } }
    LAS unsigned* uq = (LAS unsigned*)(F.lds + fa::L_END);
    const int x0 = (int)(xb_xcc_id() & 7u);
    LAS int* t0tab = (LAS int*)(F.lds + fa::L_END + 64);
    for (int qi = 0; qi < BATCH; ++qi) {
        const int b = (x0 + qi) & (BATCH - 1);
        __syncthreads();
        t0tab[F.tid] = __hip_atomic_load(T0 + b * NH * 32 + F.tid, RLX_AGENT);
        if (F.tid == 0) *uq = __hip_atomic_fetch_add(qctr + b, 1u, RLX_AGENT);
        __syncthreads();
        for (;;) {
            const int u = __builtin_amdgcn_readfirstlane((int)*uq);
            if (u >= NH * 32) break;
            const int r = u >> 5, qb = 31 - (u & 31);
            const unsigned long long mk_ = __ballot(myrank == r);
            const int h = __builtin_amdgcn_readfirstlane((int)__builtin_ctzll(mk_));
            const int t0 = __builtin_amdgcn_readfirstlane(t0tab[h * 32 + qb]);
            fa::attn_unit(b, h, qb, Q, K, V, Gt, O, QX, KX, F.lds, lds0, F.tid, t0, qctr + b, uq);
        }
    }
}

constexpr int NPH_PAIR = 19, NPH = 2 * NPH_PAIR;
#define OPAQUE_S(x) asm volatile("" : "+s"(x))
__global__ void __launch_bounds__(NWAVES * 64, 2) trunk_fwd(Args args) {
    extern __shared__ __attribute__((aligned(16))) unsigned char lds_raw[];
    const int tid0 = threadIdx.x;
    volatile LAS unsigned* MISC = (volatile LAS unsigned*)((LAS unsigned char*)lds_raw + MISC_OFF);
    for (int u = tid0; u < (LDS_BYTES - RING_BYTES) / 4; u += NWAVES * 64) ((LAS unsigned*)((LAS unsigned char*)lds_raw + RING_BYTES))[u] = 0u;
    __syncthreads();
    const int lo = args.ph_lo, hi = args.ph_hi;
    const bool use_bar = (hi - lo) > 1;
    XcdBarrier bar; bar.bar = (unsigned*)(args.ws + WS_CTL) + CW_BAR; bar.x = 0; bar.st = nullptr;
    if (use_bar) bar = xcd_barrier_post((unsigned*)(args.ws + WS_CTL) + CW_BAR, MISC + 8);

#ifndef PROBE_NULL_EPI
#define PROBE_NULL_EPI 0
#endif
#ifndef PROBE_DUP_MASK
#define PROBE_DUP_MASK 0u
#endif
#define PHASE(k) (lo <= base + (k) && base + (k) < hi)
#define DUP(k) (((PROBE_DUP_MASK) >> (k)) & 1u)
#define PHASE_FOR(k) for (int rep_ = 0; rep_ < (PHASE(k) ? 1 + (int)DUP(k) : 0); ++rep_)
#define SEAM(k) do { if (PHASE(k) && base + (k) + 1 < hi) xcd_barrier(bar); } while (0)
#define PH_BEGIN if (rep_) xcd_barrier(bar); unsigned char* ws = args.ws; OPAQUE_S(ws); int bx = blockIdx.x; OPAQUE_S(bx); float* xo = args.out; OPAQUE_S(xo); \
        Frame F; { int t_ = threadIdx.x; asm volatile("" : "+v"(t_)); F.lds = (LAS unsigned char*)lds_raw; F.ldsg = lds_raw; F.tid = t_; F.lane = t_ & 63; F.wave = __builtin_amdgcn_readfirstlane(t_ >> 6); \
          F.G = gridDim.x; F.bx = bx; F.vcu = (F.G % 8 == 0) ? (bx % 8) * (F.G / 8) + bx / 8 : bx; } \
        unsigned char* act = ws + WS_ACT; unsigned char* wl = ws + WS_WL; unsigned char* wf = ws + WS_WF; unsigned char* small = ws + WS_SMALL; bf16* HN = (bf16*)(ws + WS_HN); (void)act; (void)wl; (void)wf; (void)small; (void)HN; (void)bx; (void)xo;

    for (int j = 0; j < 2; ++j) {
        const int base = j * NPH_PAIR;
        PHASE_FOR(0) { PH_BEGIN
            cvt_phase<false>(F, j, wl);
            cvt_phase<true>(F, j, wf);
            if (bx == 0) { float* C8 = (float*)(small + SM_C8); const float* ll = inp(10) + (size_t)j * D; for (int c = F.tid; c < D; c += NWAVES * 64) { const float L = ll[c]; C8[c] = 8.0f * LOG2E * log1pf(__expf(-L)); } }
            if (bx == 1) { bf16* Wf = (bf16*)(wf + WF_IN) + (size_t)4 * D * D; unsigned char* Wf8 = (unsigned char*)(wf + WF_IN) + (size_t)4 * D * D; const float* src = inp(12) + (size_t)j * D * (4 * D + NH) + 4 * D;
                const bool f8 = FP8_FOXIN_J1 && (j == 1 || FP8_FOXIN_J0);
                for (int k = F.tid; k < D; k += NWAVES * 64) { const f32x4* p = (const f32x4*)(src + (size_t)k * (4 * D + NH));
#pragma unroll
                    for (int q4 = 0; q4 < 4; ++q4) { const f32x4 v = p[q4];
#pragma unroll
                        for (int e = 0; e < 4; ++e) { if (f8) Wf8[(size_t)(4 * q4 + e) * D + k] = (unsigned char)(pack4_fp8(v[e], 0.f, 0.f, 0.f, 64.f) & 0xffu); else Wf[(size_t)(4 * q4 + e) * D + k] = (bf16)f2bf(v[e]); } } } }
            __syncthreads();
            if (j == 0) norm0_phase(F, inp(0), inp(1), HN, (xr_t*)xo);
        }
        SEAM(0);
        PHASE_FOR(1) { PH_BEGIN
            pg8::StaticOrder S; S.init(T / 256, 2 * D / 256, F.G, bx);
            pg8::EpiLruIn E{(bf16*)(act), (bf16*)(act + ACT_SLOT), (j == 0) ? (const float*)nullptr : (const float*)(ws + WS_SS) + 8 * (size_t)T};
            if (FP8_LRUIN_J1 && j == 1) {
                pg8::GemmT<false, false, true> g8{HN, (bf16*)(wl + WL_IN), D / 2, D / 2, D / 128, 0, (long)256 * (D / 2), nullptr, nullptr, 0, 0x7d7d7d7d, 0x79797979};
                pg8::gemm_phase<pg8::EpiLruIn, pg8::StaticOrder, pg8::GemmT<false, false, true>, true>(F.lds, g8, S, E);
            } else {
                pg8::GemmT<false, false> g{HN, (bf16*)(wl + WL_IN), D, D, D / 64, 0, (long)256 * D, nullptr, nullptr, 0};
                pg8::gemm_phase<pg8::EpiLruIn, pg8::StaticOrder, pg8::GemmT<false, false>, true>(F.lds, g, S, E);
            }
        }
        SEAM(1);
        PHASE_FOR(2) { PH_BEGIN
            conv_phase(F, (const bf16*)(act + ACT_SLOT), inp(4) + (size_t)j * 4 * D, inp(5) + (size_t)j * D, (bf16*)(act + 2 * ACT_SLOT)); }
        SEAM(2);
        PHASE_FOR(3) { PH_BEGIN
            bf16* XC = (bf16*)(act + 2 * ACT_SLOT);
            pg8::GemmT<false, false> g{XC, (bf16*)(wl + WL_G), D, 128, 2, 128, (long)256 * 128, nullptr, nullptr, 0};
            pg8::StaticOrder S; S.init(T / 256, 8, F.G, bx);
            pg8::EpiGate E{XC, inp(7) + (size_t)j * D, inp(9) + (size_t)j * D, (const float*)(small + SM_C8), (unsigned*)(act + 3 * ACT_SLOT)};
            pg8::gemm_phase<pg8::EpiGate, pg8::StaticOrder, pg8::GemmT<false, false>, true>(F.lds, g, S, E);
        }
        SEAM(3);
        PHASE_FOR(4) { PH_BEGIN scan_agg_phase(F, (const unsigned*)(act + 3 * ACT_SLOT), (float*)(ws + WS_AGG)); }
        SEAM(4);
        PHASE_FOR(5) { PH_BEGIN scan_out_phase(F, (const unsigned*)(act + 3 * ACT_SLOT), (const float*)(ws + WS_AGG), (const bf16*)(act), (bf16*)(act + ACT_SLOT)); }
        SEAM(5);
        PHASE_FOR(6) { PH_BEGIN
            pg8::GemmT<false, false> g{(bf16*)(act + ACT_SLOT), (bf16*)(wl + WL_OUT), D, D, D / 64, 0, (long)256 * D, nullptr, nullptr, 0};
            pg8::StaticOrder S; S.init(T / 256, D / 256, F.G, bx);
            pg8::EpiResid E{(const xr_t*)xo, (xr_t*)xo, inp(2) + (size_t)(2 * j) * D, HN, (float*)(ws + WS_SS), F.lds, (FP8_L2_FFN && j == 1) ? 4.f : 0.f};
            pg8::gemm_phase<pg8::EpiResid, pg8::StaticOrder, pg8::GemmT<false, false>, true>(F.lds, g, S, E);
        }
        SEAM(6);
        PHASE_FOR(7) { PH_BEGIN
            pg8::StaticOrder S; S.init(T / 256, 2 * FF / 256, F.G, bx);
            if (FP8_L2_FFN && j == 1) {
                pg8::GemmT<false, false, true> g8{HN, (bf16*)(wl + WL_W1), D / 2, D / 2, D / 128, 0, (long)256 * (D / 2), nullptr, nullptr, 0, 0x7d7d7d7d, 0x79797979};
                pg8::EpiSwiglu8 E8{(unsigned char*)(act), FF, 8.f, (const float*)(ws + WS_SS)};
                pg8::gemm_phase<pg8::EpiSwiglu8, pg8::StaticOrder, pg8::GemmT<false, false, true>, true>(F.lds, g8, S, E8);
            } else {
                pg8::GemmT<false, false> g{HN, (bf16*)(wl + WL_W1), D, D, D / 64, 0, (long)256 * D, nullptr, nullptr, 0};
                pg8::EpiSwiglu E{(bf16*)(act), FF, (const float*)(ws + WS_SS), ((EMU_FP8 >= 2 && j == 1) || EMU_FP8 >= 3) ? 8.f : 0.f};
                pg8::gemm_phase<pg8::EpiSwiglu, pg8::StaticOrder, pg8::GemmT<false, false>, true>(F.lds, g, S, E);
            }
        }
        SEAM(7);
        PHASE_FOR(8) { PH_BEGIN
            pg8::StaticOrder S; S.init(T / 256, D / 256, F.G, bx);
            pg8::EpiResid E{(const xr_t*)xo, (xr_t*)xo, inp(1) + (size_t)(2 * j + 1) * D, HN, (float*)(ws + WS_SS) + 4 * (size_t)T, F.lds, (FP8_FOXIN_J1 && (j == 1 || FP8_FOXIN_J0)) ? 4.f : 0.f};
            if (FP8_L2_FFN && j == 1) {
                pg8::GemmT<false, false, true> g8{(bf16*)(act), (bf16*)(wl + WL_W2), FF / 2, FF / 2, FF / 128, 0, (long)256 * (FF / 2), nullptr, nullptr, 0, 0x7c7c7c7c, 0x78787878};
                pg8::gemm_phase<pg8::EpiResid, pg8::StaticOrder, pg8::GemmT<false, false, true>, true>(F.lds, g8, S, E);
            } else {
                pg8::GemmT<false, false> g{(bf16*)(act), (bf16*)(wl + WL_W2), FF, FF, FF / 64, 0, (long)256 * FF, nullptr, nullptr, 0};
                pg8::gemm_phase<pg8::EpiResid, pg8::StaticOrder, pg8::GemmT<false, false>, true>(F.lds, g, S, E);
            }
        }
        SEAM(8);
        PHASE_FOR(9) { PH_BEGIN
            pg8::GemmT<false, false> g{HN, (bf16*)(wf + WF_IN), D, D, D / 64, 0, (long)256 * D, nullptr, nullptr, 0};
            pg8::StaticOrder S; S.init(T / 256, 4 * D / 256 + 1, F.G, bx);
            pg8::EpiFoxIn E{(bf16*)(act), (size_t)T * D, inp(14) + (size_t)j * HD, inp(15) + (size_t)j * HD, 0.125f * LOG2E, (const float*)(ws + WS_SS) + 4 * (size_t)T, inp(13) + (size_t)j * NH, (float*)(ws + WS_LOGF)};
#if PROBE_NULL_EPI
            if (rep_) { pg8::EpiNull E0{(float*)(ws + WS_AGG)}; pg8::gemm_phase<pg8::EpiNull, pg8::StaticOrder, pg8::GemmT<false, false>, true>(F.lds, g, S, E0); } else
#endif
            if (FP8_FOXIN_J1 && (j == 1 || FP8_FOXIN_J0)) {
                pg8::GemmT<false, false, true> g8{HN, (bf16*)(wf + WF_IN), D / 2, D / 2, D / 128, 0, (long)256 * (D / 2), nullptr, nullptr, 0, 0x7d7d7d7d, 0x79797979};
                pg8::gemm_phase<pg8::EpiFoxIn, pg8::StaticOrder, pg8::GemmT<false, false, true>, true>(F.lds, g8, S, E);
            } else
            pg8::gemm_phase<pg8::EpiFoxIn, pg8::StaticOrder, pg8::GemmT<false, false>, true>(F.lds, g, S, E);
        }
        SEAM(9);
        PHASE_FOR(10) { PH_BEGIN cumsum_phase(F, (const float*)(ws + WS_LOGF), (float*)(ws + WS_F2), (int*)(small + SM_T0), (bf16*)(act + 4 * ACT_SLOT + 32 * MiB), (bf16*)(act + 4 * ACT_SLOT), inp(14) + (size_t)j * HD, inp(15) + (size_t)j * HD); }
        SEAM(10);
        PHASE_FOR(11) { PH_BEGIN attn_phase(F, (const bf16*)(act), (const bf16*)(act + ACT_SLOT), (const bf16*)(act + 2 * ACT_SLOT), (const bf16*)(act + 3 * ACT_SLOT), HN, (const bf16*)(act + 4 * ACT_SLOT + 32 * MiB), (const bf16*)(act + 4 * ACT_SLOT), (const int*)(small + SM_T0), inp(13) + (size_t)j * NH, (gu32*)(ws + WS_CTL) + CW_QCTR + 64 * j + 16 * rep_); }
        SEAM(11);
        PHASE_FOR(12) { PH_BEGIN
            pg8::GemmT<false, false> g{HN, (bf16*)(wf + WF_OUT), D, D, D / 64, 0, (long)256 * D, nullptr, nullptr, 0};
            pg8::StaticOrder S; S.init(T / 256, D / 256, F.G, bx);
            pg8::EpiResid E{(const xr_t*)xo, (xr_t*)xo, nullptr, nullptr, nullptr, F.lds};
            pg8::gemm_phase<pg8::EpiResid, pg8::StaticOrder, pg8::GemmT<false, false>, true>(F.lds, g, S, E);
        }
        SEAM(12);
        PHASE_FOR(13) { PH_BEGIN
            if (FP8_LAST_MOE && (j == 1 || FP8_MOE_J0)) router_phase(F, (const xr_t*)xo, inp(2) + (size_t)(2 * j + 1) * D, (unsigned char*)HN, inp(20) + (size_t)j * D * NE, (unsigned*)(ws + WS_TOPE), (float*)(ws + WS_TOPW), (unsigned*)(small + SM_CNT), 4.f);
            else norm_phase<8, true>(F, xo, inp(2) + (size_t)(2 * j + 1) * D, HN, inp(20) + (size_t)j * D * NE, NE, nullptr, nullptr, (unsigned*)(ws + WS_TOPE), (float*)(ws + WS_TOPW), (unsigned*)(small + SM_CNT), (FP8_LAST_MOE && (j == 1 || FP8_MOE_J0)) ? -4.f : (((EMU_FP8 && j == 1) || EMU_FP8 >= 3) ? 4.f : 0.f)); }
        SEAM(13);
        PHASE_FOR(14) { PH_BEGIN moe_build_phase(F, (const unsigned*)(ws + WS_TOPE), (const float*)(ws + WS_TOPW), (unsigned*)(small + SM_CNT), (unsigned*)(ws + WS_LIST), (float*)(ws + WS_LISTW), (unsigned*)(small + SM_TILE) + j * 2 * 272, (unsigned*)(small + SM_NT) + j * 2); }
        SEAM(14);
#pragma unroll
        for (int p = 0; p < 2; ++p) {
            PHASE_FOR(15 + 2 * p) { PH_BEGIN
                unsigned* TILE = (unsigned*)(small + SM_TILE) + j * 2 * 272 + p * 272; unsigned* NTL = (unsigned*)(small + SM_NT) + j * 2 + p;
                const int ntl = __builtin_amdgcn_readfirstlane((int)__hip_atomic_load(NTL, RLX_AGENT));
                pg8::StaticOrder S; S.init(ntl, 2 * FF / 256, F.G, bx);
                if (FP8_LAST_MOE && (j == 1 || FP8_MOE_J0)) {
                    if (MOE_OVERLAP && p == 1) {
                        const int ntl0 = __builtin_amdgcn_readfirstlane((int)__hip_atomic_load((unsigned*)(small + SM_NT) + j * 2, RLX_AGENT));
                        const int ntail = ntl0 * (D / 256) - 4 * F.G, rnd = (ntl * (2 * FF / 256)) / F.G;
                        if (ntail > 0 && ntail <= F.G / 2 && rnd > 3) S.split(rnd - 3, ntail);
                    }
                    pg8::GemmT<true, true, true> g{HN, (bf16*)(wf + WF_W1), D / 2, D / 2, D / 128, 0, (long)256 * (D / 2), (const unsigned*)(ws + WS_LIST) + (size_t)p * LISTCAP, TILE, (long)2 * FF * (D / 2), 0x7d7d7d7d, 0x79797979};
                    pg8::EpiSwiglu8 E{(unsigned char*)(act) + (MOE_OVERLAP ? (size_t)p * LISTCAP * FF : (size_t)0), FF, 8.f};
                    pg8::gemm_phase<pg8::EpiSwiglu8, pg8::StaticOrder, pg8::GemmT<true, true, true>, true>(F.lds, g, S, E);
                } else {
                    pg8::GemmT<true, true> g{HN, (bf16*)(wf + WF_W1), D, D, D / 64, 0, (long)256 * D, (const unsigned*)(ws + WS_LIST) + (size_t)p * LISTCAP, TILE, (long)2 * FF * D};
                    pg8::EpiSwiglu E{(bf16*)(act), FF, nullptr, ((EMU_FP8 && j == 1) || EMU_FP8 >= 3) ? 8.f : 0.f};
                    pg8::gemm_phase<pg8::EpiSwiglu, pg8::StaticOrder, pg8::GemmT<true, true>, true>(F.lds, g, S, E);
                }
            }
            SEAM(15 + 2 * p);
            PHASE_FOR(16 + 2 * p) { PH_BEGIN
                unsigned* TILE = (unsigned*)(small + SM_TILE) + j * 2 * 272 + p * 272; unsigned* NTL = (unsigned*)(small + SM_NT) + j * 2 + p;
                const int ntl = __builtin_amdgcn_readfirstlane((int)__hip_atomic_load(NTL, RLX_AGENT));
                pg8::StaticOrder S; S.init(ntl, D / 256, F.G, bx);
                const bool fuse = (p == 1) && (j == 0);
                xr_t* XR2 = (xr_t*)(act + 480 * MiB);
                pg8::EpiScatter E{(j == 1 && p == 1) ? (const xr_t*)XR2 : (const xr_t*)xo, (j == 1 && p == 0) ? XR2 : (xr_t*)xo, (j == 1 && p == 1) ? xo : (float*)nullptr, (const unsigned*)(ws + WS_LIST) + (size_t)p * LISTCAP, (const float*)(ws + WS_LISTW) + (size_t)p * LISTCAP,
                                  fuse ? inp(1) + (size_t)(2 * j + 2) * D : (const float*)nullptr, fuse ? HN : (bf16*)nullptr, fuse ? (float*)(ws + WS_SS) + 8 * (size_t)T : (float*)nullptr, F.lds, FP8_LRUIN_J1 ? 4.f : 0.f};
                if (FP8_LAST_MOE && (j == 1 || FP8_MOE_J0)) {
                    pg8::GemmT<false, true, true> g{(bf16*)(act + (MOE_OVERLAP ? (size_t)p * LISTCAP * FF : (size_t)0)), (bf16*)(wf + WF_W2), FF / 2, FF / 2, FF / 128, 0, (long)256 * (FF / 2), nullptr, TILE, (long)D * (FF / 2), 0x7c7c7c7c, 0x78787878};
                    pg8::gemm_phase<pg8::EpiScatter, pg8::StaticOrder, pg8::GemmT<false, true, true>, true>(F.lds, g, S, E);
                } else {
                    pg8::GemmT<false, true> g{(bf16*)(act), (bf16*)(wf + WF_W2), FF, FF, FF / 64, 0, (long)256 * FF, nullptr, TILE, (long)D * FF};
                    pg8::gemm_phase<pg8::EpiScatter, pg8::StaticOrder, pg8::GemmT<false, true>, true>(F.lds, g, S, E);
                }
            }
            if (MOE_OVERLAP && p == 0 && FP8_LAST_MOE && (j == 1 || FP8_MOE_J0)) { if (PHASE(16) && PHASE(17)) __syncthreads(); else SEAM(16); }
            else SEAM(16 + 2 * p);
        }
    }
#undef PHASE
#undef SEAM
#undef PH_BEGIN
}

extern "C" void kernel_launch(void* const* d_in, const int* in_sizes, int n_in, void* d_out, int out_size, void* d_ws, size_t ws_size, hipStream_t stream) {
    static int grid = 0;
    if (grid == 0) {
        if (n_in != 24 || in_sizes[0] != T * D || out_size != T * D || ws_size < WS_END) { fprintf(stderr, "kernel_launch: unexpected problem (n_in %d in0 %d out %d ws %zu)\n", n_in, n_in > 0 ? in_sizes[0] : -1, out_size, ws_size); grid = -1; return; }
        int dev = 0, cus = 0, per_cu = 0;
        if (hipGetDevice(&dev) != hipSuccess || hipDeviceGetAttribute(&cus, hipDeviceAttributeMultiprocessorCount, dev) != hipSuccess) { grid = -1; return; }
        if (hipFuncSetAttribute((const void*)trunk_fwd, hipFuncAttributeMaxDynamicSharedMemorySize, LDS_BYTES) != hipSuccess) { fprintf(stderr, "kernel_launch: hipFuncSetAttribute failed\n"); grid = -1; return; }
        if (hipOccupancyMaxActiveBlocksPerMultiprocessor(&per_cu, (const void*)trunk_fwd, NWAVES * 64, LDS_BYTES) != hipSuccess || per_cu < 1)
            fprintf(stderr, "kernel_launch: occupancy query reports %d workgroups per CU\n", per_cu);
        (void)hipGetLastError();
        grid = cus;
        if (grid != 256) { fprintf(stderr, "kernel_launch: %d CUs; this kernel is built for 256\n", grid); grid = -1; return; }
    }
    if (grid < 0) return;
    if (hipMemsetAsync((char*)d_ws + WS_CTL, 0, CTL_ZERO_BYTES, stream) != hipSuccess) return;
    Args a{};
    for (int i = 0; i < 24; ++i) a.in[i] = (const float*)d_in[i];
    a.out = (float*)d_out; a.ws = (unsigned char*)d_ws;
#if MK_PER_PHASE
    for (int ph = 0; ph < NPH; ++ph) { a.ph_lo = ph; a.ph_hi = ph + 1; hipLaunchKernelGGL(trunk_fwd, dim3(grid), dim3(NWAVES * 64), LDS_BYTES, stream, a); }
#else
    a.ph_lo = 0; a.ph_hi = NPH;
    hipLaunchKernelGGL(trunk_fwd, dim3(grid), dim3(NWAVES * 64), LDS_BYTES, stream, a);
#endif
    const hipError_t le = hipPeekAtLastError();
    if (le != hipSuccess) fprintf(stderr, "kernel_launch: launch failed: %s\n", hipGetErrorName(le));
}
```

```cpp
#include <hip/hip_runtime.h>
#include <cstdio>
#include <cstdint>

#ifndef MK_PER_PHASE
#define MK_PER_PHASE 0
#endif

constexpr int BATCH = 8, SEQ = 8192, D = 1024, T = BATCH * SEQ, NH = 16, HD = 64, FF = 3584, NE = 8;
constexpr int NWAVES = 8;
constexpr float RMS_EPS = 1e-6f;
constexpr float LOG2E = 1.4426950408889634f;

#define GAS __attribute__((address_space(1)))
#define LAS __attribute__((address_space(3)))
typedef unsigned short bf16;
typedef unsigned v4u __attribute__((ext_vector_type(4)));
typedef unsigned v2u __attribute__((ext_vector_type(2)));
typedef float f32x4 __attribute__((ext_vector_type(4)));
typedef float f32x2 __attribute__((ext_vector_type(2)));
typedef float f32x16 __attribute__((ext_vector_type(16)));
typedef short bf16x8 __attribute__((ext_vector_type(8)));
typedef short s16x4 __attribute__((ext_vector_type(4)));
typedef GAS unsigned gu32;
#define RLX_AGENT __ATOMIC_RELAXED, __HIP_MEMORY_SCOPE_AGENT
#define LDS_WAIT() asm volatile("s_waitcnt lgkmcnt(0)" ::: "memory")
#define VM_WAIT() asm volatile("s_waitcnt vmcnt(0)" ::: "memory")

__device__ __forceinline__ unsigned f2bf(float f) { unsigned u = __builtin_bit_cast(unsigned, f); return (u + 0x7fffu + ((u >> 16) & 1u)) >> 16; }
__device__ __forceinline__ unsigned pk2(float lo, float hi) { unsigned r; asm("v_cvt_pk_bf16_f32 %0, %1, %2" : "=v"(r) : "v"(lo), "v"(hi)); return r; }
__device__ __forceinline__ float bflo(unsigned w) { return __builtin_bit_cast(float, w << 16); }
__device__ __forceinline__ float bfhi(unsigned w) { return __builtin_bit_cast(float, w & 0xffff0000u); }
__device__ __forceinline__ unsigned cvt_pk_bf16(float lo, float hi) { unsigned r; asm volatile("v_cvt_pk_bf16_f32 %0, %1, %2" : "=v"(r) : "v"(lo), "v"(hi)); return r; }
typedef unsigned short xr_t;
__device__ __forceinline__ void xr_unpack8(const v4u& r, f32x4& a, f32x4& b) {
    a[0] = __uint_as_float(r.x << 16); a[1] = __uint_as_float(r.x & 0xffff0000u); a[2] = __uint_as_float(r.y << 16); a[3] = __uint_as_float(r.y & 0xffff0000u);
    b[0] = __uint_as_float(r.z << 16); b[1] = __uint_as_float(r.z & 0xffff0000u); b[2] = __uint_as_float(r.w << 16); b[3] = __uint_as_float(r.w & 0xffff0000u); }
__device__ __forceinline__ v4u xr_pack8(const f32x4& a, const f32x4& b) { v4u w; w.x = cvt_pk_bf16(a[0], a[1]); w.y = cvt_pk_bf16(a[2], a[3]); w.z = cvt_pk_bf16(b[0], b[1]); w.w = cvt_pk_bf16(b[2], b[3]); return w; }
__device__ __forceinline__ float fast_exp2(float x) { return __builtin_amdgcn_exp2f(x); }
__device__ __forceinline__ float fast_rcp(float x) { return __builtin_amdgcn_rcpf(x); }
__device__ __forceinline__ float sigmoidf_(float x) { return fast_rcp(1.0f + fast_exp2(-x * LOG2E)); }
__device__ __forceinline__ float q8(float x, float sc) { const float y = fminf(fmaxf(x * sc, -448.f), 448.f); const int p = __builtin_amdgcn_cvt_pk_fp8_f32(y, y, 0, false); return __builtin_amdgcn_cvt_f32_fp8(p, 0) * (1.0f / sc); }
__device__ __forceinline__ unsigned pack4_fp8(float a, float b, float c, float d, float sc) {
    a = fminf(fmaxf(a * sc, -448.f), 448.f); b = fminf(fmaxf(b * sc, -448.f), 448.f); c = fminf(fmaxf(c * sc, -448.f), 448.f); d = fminf(fmaxf(d * sc, -448.f), 448.f);
    int p = __builtin_amdgcn_cvt_pk_fp8_f32(a, b, 0, false); p = __builtin_amdgcn_cvt_pk_fp8_f32(c, d, p, true); return (unsigned)p;
}
#ifndef EMU_FP8
#define EMU_FP8 0
#endif
#ifndef FP8_LRUIN_J1
#define FP8_LRUIN_J1 1
#endif
#ifndef FP8_FOXIN_J0
#define FP8_FOXIN_J0 1
#endif
#ifndef FP8_FOXIN_J1
#define FP8_FOXIN_J1 1
#endif
#ifndef FP8_L2_FFN
#define FP8_L2_FFN 1
#endif
#ifndef FP8_MOE_J0
#define FP8_MOE_J0 1
#endif
#ifndef CVT_OVERLAP
#define CVT_OVERLAP 1
#endif
#ifndef MOE_OVERLAP
#define MOE_OVERLAP 1
#endif
#ifndef FP8_LAST_MOE
#define FP8_LAST_MOE 1
#endif
__device__ __forceinline__ float wave_sum(float v) {
#pragma unroll
    for (int o = 1; o < 64; o <<= 1) v += __shfl_xor(v, o);
    return v;
}

namespace pg8 {
#define PG8_LAS __attribute__((address_space(3)))
constexpr int BM = 256, BK = 64, HALF = 128, HTB = HALF * BK * 2, STAGE_BYTES = 8 * HTB, NXCD = 8, WGM = 8;
__host__ __device__ __forceinline__ int lds_byte(int r, int c) { const int st = (r >> 4) * 2 + (c >> 5), rr = r & 15, cc = c & 31, ob = rr * 64 + cc * 2; return st * 1024 + (ob ^ (((ob >> 9) & 1) << 5)); }
__host__ __device__ __forceinline__ void stage_rc(int b, int& R, int& C) { const int st = b / 1024, sb = b % 1024, swz = sb ^ (((sb >> 9) & 1) << 5); R = (st >> 1) * 16 + swz / 64; C = (st & 1) * 32 + (swz % 64) / 2; }
__host__ __device__ __forceinline__ int perm32(int rho) { const int n = rho >> 4, i = rho & 15; return 8 * (i >> 2) + 4 * n + (i & 3); }

typedef int v8i_t __attribute__((ext_vector_type(8)));
typedef int v4i_t __attribute__((ext_vector_type(4)));
__device__ __forceinline__ v8i_t cat8(bf16x8 lo, bf16x8 hi) { const v4i_t a = __builtin_bit_cast(v4i_t, lo), b = __builtin_bit_cast(v4i_t, hi); return __builtin_shufflevector(a, b, 0, 1, 2, 3, 4, 5, 6, 7); }
struct Unit { int pm, pn; };
struct StaticOrder {
    int nM, nN, nwg, G, c, isp, csk;
    __device__ void init(int nM_, int nN_, int G_, int c_) { nM = nM_; nN = nN_; nwg = nM * nN; G = G_; c = c_; isp = 0x7fffffff; csk = 0; }
    __device__ void split(int isp_, int csk_) { isp = isp_; csk = csk_; }
    __device__ bool next(int i, Unit& u) const {
        long L;
        if (i < isp) L = (long)i * G + c; else { if (c < csk) return false; L = (long)isp * G + (long)(i - isp) * (G - csk) + (c - csk); }
        if (L >= nwg) return false;
        int wgid = (int)L; { const int q = nwg / NXCD, r = nwg % NXCD, xcd = wgid % NXCD, off = wgid / NXCD; wgid = (xcd < r ? xcd * (q + 1) : r * (q + 1) + (xcd - r) * q) + off; }
        const int nig = WGM * nN, gid = wgid / nig, fm = gid * WGM, gsz = (nM - fm) < WGM ? (nM - fm) : WGM;
        u.pm = fm + ((wgid % nig) % gsz); u.pn = (wgid % nig) / gsz; return true;
    }
};

template <bool GATHER_, bool EXPERT_, bool FP8_ = false> struct GemmT {
    static constexpr bool GATHER = GATHER_, EXPERT = EXPERT_, FP8 = FP8_;
    const bf16* A; const bf16* Bt; int lda, ldb, nt;
    long a_pn, b_pn;
    const unsigned* list;
    const unsigned* tile_e; long b_e;
    int scA = 0x7f7f7f7f, scB = 0x7f7f7f7f;
    __device__ __forceinline__ const char* a_tile(const Unit& u) const { return (const char*)(A + (GATHER ? 0 : (size_t)u.pm * BM * lda) + (size_t)u.pn * a_pn); }
    __device__ __forceinline__ const char* b_tile(const Unit& u) const {
        size_t off = (size_t)u.pn * b_pn;
        if (EXPERT) { const unsigned e = (unsigned)__builtin_amdgcn_readfirstlane((int)__hip_atomic_load(tile_e + u.pm, RLX_AGENT)); off += (size_t)e * b_e; }
        return (const char*)(Bt + off);
    }
    __device__ __forceinline__ void a_voff(const Unit& u, const int (&sR)[2], const int (&sC)[2], unsigned (&vo)[2][2]) const {
        if (GATHER) {
            unsigned idx[2][2];
#pragma unroll
            for (int h = 0; h < 2; ++h)
#pragma unroll
                for (int i = 0; i < 2; ++i) idx[h][i] = list[u.pm * BM + h * HALF + sR[i]];
            asm volatile("s_waitcnt vmcnt(0)" ::: "memory");
#pragma unroll
            for (int h = 0; h < 2; ++h)
#pragma unroll
                for (int i = 0; i < 2; ++i) vo[h][i] = ((idx[h][i] & 0xffffu) * (unsigned)lda + (unsigned)sC[i]) * 2u;
        } else {
#pragma unroll
            for (int h = 0; h < 2; ++h)
#pragma unroll
                for (int i = 0; i < 2; ++i) vo[h][i] = (unsigned)((h * HALF + sR[i]) * lda + sC[i]) * 2u;
        }
    }
};

template <class Epi, class Sched, class GD, bool ALIGN_EPI>
__device__ __forceinline__ void gemm_phase(PG8_LAS unsigned char* lds, const GD& g, const Sched& S, const Epi& E) {
    int tid = threadIdx.x; asm volatile("" : "+v"(tid));
    const int wid = __builtin_amdgcn_readfirstlane(tid >> 6), lane = tid & 63, wr = wid >> 2, wc = wid & 3, fr = lane & 15, fq = lane >> 4;
    int nt = g.nt; asm volatile("" : "+s"(nt));
    int sR[2], sC[2]; unsigned voffB[2];
#pragma unroll
    for (int i = 0; i < 2; ++i) { int R, C; stage_rc(tid * 16 + i * 8192, R, C); sR[i] = R; sC[i] = C; const int Rb = Epi::PERM ? ((R & ~31) + perm32(R & 31)) : R;
        voffB[i] = (unsigned)(Rb * g.ldb + C) * 2u; }
    const size_t kstep = (size_t)(BK * 2);
    const size_t hstepB = (size_t)HALF * g.ldb * 2;
    const size_t hstepA = (size_t)HALF * g.lda * 2;
    unsigned voffA[2];
#pragma unroll
    for (int i = 0; i < 2; ++i) voffA[i] = (unsigned)(sR[i] * g.lda + sC[i]) * 2u;
    const unsigned ldsw = (unsigned)wid * 1024u;
    const int aoff = lds_byte(wr * 64 + fr, fq * 8), boff = lds_byte(wc * 32 + fr, fq * 8);
#define PG8_SA(b, h) (((b) * 2 + (h)) * HTB)
#define PG8_SB(b, h) ((4 + (b) * 2 + (h)) * HTB)
#define PG8_STAGE(bufoff, gbase, voff) do { _Pragma("unroll") for (int _i = 0; _i < 2; ++_i) \
        __builtin_amdgcn_global_load_lds((const unsigned*)((const char*)(gbase) + (voff)[_i]), (PG8_LAS unsigned*)(lds + (bufoff) + ldsw + _i * 8192), 16, 0, 0); } while (0)
#define PG8_STAGE_A(bufoff, gbase, h, VA) do { if constexpr (GD::GATHER) { PG8_STAGE(bufoff, gbase, VA[h]); } else { PG8_STAGE(bufoff, (gbase) + (h) * hstepA, voffA); } } while (0)
#define PG8_LDA(dst, b, h) do { _Pragma("unroll") for (int m = 0; m < 4; ++m) _Pragma("unroll") for (int k = 0; k < 2; ++k) dst[m][k] = *(const PG8_LAS bf16x8*)(lds + PG8_SA(b, h) + aoff + m * 2048 + k * 1024); } while (0)
#define PG8_LDB(dst, b, h) do { _Pragma("unroll") for (int n = 0; n < 2; ++n) _Pragma("unroll") for (int k = 0; k < 2; ++k) dst[n][k] = *(const PG8_LAS bf16x8*)(lds + PG8_SB(b, h) + boff + n * 2048 + k * 1024); } while (0)
#define PG8_MMA(ai, bj, At, Bt) do { __builtin_amdgcn_s_setprio(1); \
        if constexpr (GD::FP8) { _Pragma("unroll") for (int m = 0; m < 4; ++m) _Pragma("unroll") for (int n = 0; n < 2; ++n) \
            asm volatile("v_mfma_scale_f32_16x16x128_f8f6f4 %0, %1, %2, %0, %3, %4 op_sel_hi:[0,0,0]" : "+v"(acc[ai][bj][m][n]) : "v"(cat8(Bt[n][0], Bt[n][1])), "v"(cat8(At[m][0], At[m][1])), "v"(vscB), "v"(vscA)); } \
        else { _Pragma("unroll") for (int m = 0; m < 4; ++m) _Pragma("unroll") for (int n = 0; n < 2; ++n) _Pragma("unroll") for (int k = 0; k < 2; ++k) \
            acc[ai][bj][m][n] = __builtin_amdgcn_mfma_f32_16x16x32_bf16(Bt[n][k], At[m][k], acc[ai][bj][m][n], 0, 0, 0); } \
        __builtin_amdgcn_s_setprio(0); } while (0)
#define PG8_WAIT_V(n) asm volatile("s_waitcnt vmcnt(" #n ")" ::: "memory")
#define PG8_WAIT_L(n) asm volatile("s_waitcnt lgkmcnt(" #n ")" ::: "memory")
#define PG8_BAR __builtin_amdgcn_s_barrier()
#define PG8_SCHED __builtin_amdgcn_sched_barrier(0)
    Unit cur, nxt; int ui = 0;
    if (!S.next(0, cur)) return;
    int vscA = g.scA, vscB = g.scB; asm volatile("" : "+v"(vscA), "+v"(vscB));
    f32x4 acc[2][2][4][2];
#pragma unroll
    for (int a = 0; a < 2; ++a)
#pragma unroll
        for (int b = 0; b < 2; ++b)
#pragma unroll
            for (int m = 0; m < 4; ++m)
#pragma unroll
                for (int n = 0; n < 2; ++n) acc[a][b][m][n] = (f32x4){0.f, 0.f, 0.f, 0.f};
    bf16x8 At[4][2], B0[2][2], B1[2][2];
    const char* cA = g.a_tile(cur); const char* cB = g.b_tile(cur);
    unsigned vAc[2][2], vAn[2][2];
    if constexpr (GD::GATHER) g.a_voff(cur, sR, sC, vAc);
    else {
#pragma unroll
        for (int h = 0; h < 2; ++h)
#pragma unroll
            for (int i = 0; i < 2; ++i) vAc[h][i] = 0u;
    }
#pragma unroll
    for (int h = 0; h < 2; ++h)
#pragma unroll
        for (int i = 0; i < 2; ++i) vAn[h][i] = vAc[h][i];
    PG8_STAGE(PG8_SB(0, 0), cB, voffB); PG8_STAGE(PG8_SB(0, 1), cB + hstepB, voffB); PG8_STAGE_A(PG8_SA(0, 0), cA, 0, vAc); PG8_STAGE_A(PG8_SA(0, 1), cA, 1, vAc);
    if (wr == 1) PG8_BAR;
    PG8_WAIT_V(2); PG8_BAR;
    PG8_STAGE(PG8_SB(1, 0), cB + kstep, voffB); PG8_STAGE_A(PG8_SA(1, 0), cA + kstep, 0, vAc); PG8_STAGE(PG8_SB(1, 1), cB + hstepB + kstep, voffB);
    PG8_WAIT_V(6); PG8_BAR;
    for (;;) {
        const bool has_next = S.next(ui + 1, nxt);
        const char* nA = has_next ? g.a_tile(nxt) : cA; const char* nB = has_next ? g.b_tile(nxt) : cB;
        for (int t = 0; t < nt; t += 2) {
            const bool last = (t == nt - 2);
            const char* a1 = cA + (size_t)(t + 1) * kstep;
            const char* a2 = last ? nA : cA + (size_t)(t + 2) * kstep; const char* b2 = last ? nB : cB + (size_t)(t + 2) * kstep;
            const char* a3 = a2 + kstep; const char* b3 = b2 + kstep;
            if (GD::GATHER && last && has_next) g.a_voff(nxt, sR, sC, vAn);
            PG8_LDB(B0, 0, 0); PG8_LDB(B1, 0, 1); PG8_SCHED; PG8_LDA(At, 0, 0); PG8_STAGE_A(PG8_SA(1, 1), a1, 1, vAc);
            PG8_WAIT_V(8); PG8_WAIT_L(0); PG8_BAR; PG8_MMA(0, 0, At, B0); PG8_MMA(0, 1, At, B1); PG8_BAR; PG8_SCHED;
            PG8_LDA(At, 0, 1); PG8_STAGE(PG8_SB(0, 0), b2, voffB); PG8_STAGE(PG8_SB(0, 1), b2 + hstepB, voffB); PG8_STAGE_A(PG8_SA(0, 0), a2, 0, vAn);
            PG8_WAIT_V(8); PG8_WAIT_L(0); PG8_BAR; PG8_MMA(1, 0, At, B0); PG8_MMA(1, 1, At, B1); PG8_BAR; PG8_SCHED;
            PG8_LDB(B0, 1, 0); PG8_LDB(B1, 1, 1); PG8_SCHED; PG8_LDA(At, 1, 0); PG8_STAGE_A(PG8_SA(0, 1), a2, 1, vAn);
            PG8_WAIT_V(8); PG8_WAIT_L(0); PG8_BAR; PG8_MMA(0, 0, At, B0); PG8_MMA(0, 1, At, B1); PG8_BAR; PG8_SCHED;
            PG8_LDA(At, 1, 1); PG8_STAGE(PG8_SB(1, 0), b3, voffB); PG8_STAGE(PG8_SB(1, 1), b3 + hstepB, voffB); PG8_STAGE_A(PG8_SA(1, 0), a3, 0, vAn);
            PG8_WAIT_V(8); PG8_WAIT_L(0); PG8_BAR; PG8_MMA(1, 0, At, B0); PG8_MMA(1, 1, At, B1); PG8_BAR; PG8_SCHED;
        }
        if constexpr (ALIGN_EPI) { if (wr == 0) PG8_BAR; }
        if constexpr (GD::FP8) asm volatile("s_nop 15\n\ts_nop 7" ::: "memory");
        E(acc, cur, wr, wc, fr, fq);
        if (!has_next) break;
#pragma unroll
        for (int a = 0; a < 2; ++a)
#pragma unroll
            for (int b = 0; b < 2; ++b)
#pragma unroll
                for (int m = 0; m < 4; ++m)
#pragma unroll
                    for (int n = 0; n < 2; ++n) acc[a][b][m][n] = (f32x4){0.f, 0.f, 0.f, 0.f};
        cur = nxt; cA = nA; cB = nB; ++ui;
#pragma unroll
        for (int h = 0; h < 2; ++h)
#pragma unroll
            for (int i = 0; i < 2; ++i) vAc[h][i] = vAn[h][i];
        if constexpr (ALIGN_EPI) { if (wr == 1) PG8_BAR; }
    }
    PG8_WAIT_V(0);
    if constexpr (!ALIGN_EPI) { if (wr == 0) PG8_BAR; }
    PG8_BAR;
#undef PG8_SA
#undef PG8_SB
#undef PG8_STAGE
#undef PG8_STAGE_A
#undef PG8_LDA
#undef PG8_LDB
#undef PG8_MMA
#undef PG8_WAIT_V
#undef PG8_WAIT_L
#undef PG8_BAR
#undef PG8_SCHED
}

__device__ __forceinline__ float gelu_tanh(float v) { const float z2 = (2.0f * 0.7978845608028654f * LOG2E) * (v + 0.044715f * v * v * v); return v * fast_rcp(1.0f + fast_exp2(-z2)); }

constexpr int XCH_OFF = 131072 + 1024;
__device__ __forceinline__ float row_rs(const float* ssp, int row, int fq) {
    float p = ssp[(size_t)fq * T + row]; p += __shfl_xor(p, 16); p += __shfl_xor(p, 32);
    return __builtin_amdgcn_rsqf(p * (1.0f / D) + RMS_EPS);
}
__device__ __forceinline__ void row_rs8(const float* ssp, int row0, int fq, float (&rs)[2][4]) {
    if (!ssp) {
#pragma unroll
        for (int ai = 0; ai < 2; ++ai)
#pragma unroll
            for (int m = 0; m < 4; ++m) rs[ai][m] = 1.0f;
        return; }
    float p[2][4];
#pragma unroll
    for (int ai = 0; ai < 2; ++ai)
#pragma unroll
        for (int m = 0; m < 4; ++m) p[ai][m] = ssp[(size_t)fq * T + row0 + ai * HALF + m * 16];
#pragma unroll
    for (int ai = 0; ai < 2; ++ai)
#pragma unroll
        for (int m = 0; m < 4; ++m) { float q = p[ai][m]; q += __shfl_xor(q, 16); q += __shfl_xor(q, 32); rs[ai][m] = __builtin_amdgcn_rsqf(q * (1.0f / D) + RMS_EPS); }
}
struct EpiLruIn {
    static constexpr bool PERM = true;
    bf16* Y; bf16* XB; const float* ss;
    __device__ __forceinline__ void operator()(const f32x4 (&acc)[2][2][4][2], const Unit& u, int wr, int wc, int fr, int fq) const {
        int row0 = u.pm * BM + wr * 64 + fr; asm volatile("" : "+v"(row0)); const bool act = (u.pn < 4);
        bf16* base = act ? Y : XB; const int col0 = (u.pn & 3) * BM + wc * 32 + 8 * fq;
        float rs8[2][4]; row_rs8(ss, row0, fq, rs8);
#pragma unroll
        for (int ai = 0; ai < 2; ++ai)
#pragma unroll
            for (int m = 0; m < 4; ++m) { bf16* rowp = base + (size_t)(row0 + ai * HALF + m * 16) * D + col0;
                const float rs = rs8[ai][m];
#pragma unroll
                for (int bj = 0; bj < 2; ++bj) { f32x4 v0 = acc[ai][bj][m][0] * rs, v1 = acc[ai][bj][m][1] * rs;
                    if (act) {
#pragma unroll
                        for (int j = 0; j < 4; ++j) { v0[j] = gelu_tanh(v0[j]); v1[j] = gelu_tanh(v1[j]); } }
                    v4u w; w.x = cvt_pk_bf16(v0[0], v0[1]); w.y = cvt_pk_bf16(v0[2], v0[3]); w.z = cvt_pk_bf16(v1[0], v1[1]); w.w = cvt_pk_bf16(v1[2], v1[3]);
                    *(v4u*)(rowp + bj * HALF) = w; }
                asm volatile("" ::: "memory"); }
    }
};
struct EpiGate {
    static constexpr bool PERM = false;
    const bf16* XC; const float* ba; const float* bx; const float* c8; unsigned* AB;
    __device__ __forceinline__ void operator()(const f32x4 (&acc)[2][2][4][2], const Unit& u, int wr, int wc, int fr, int fq) const {
        int row0 = u.pm * BM + wr * 64 + fr; asm volatile("" : "+v"(row0)); const int ch0 = u.pn * HALF + wc * 32 + 4 * fq;
        v2u xall[2][2][4];
#pragma unroll
        for (int n = 0; n < 2; ++n)
#pragma unroll
            for (int ai = 0; ai < 2; ++ai)
#pragma unroll
                for (int m = 0; m < 4; ++m) xall[n][ai][m] = *(const v2u*)(XC + (size_t)(row0 + ai * HALF + m * 16) * D + ch0 + 16 * n);
#pragma unroll
        for (int n = 0; n < 2; ++n) {
            const f32x4 vba = *(const f32x4*)(ba + ch0 + 16 * n), vbx = *(const f32x4*)(bx + ch0 + 16 * n), vc8 = *(const f32x4*)(c8 + ch0 + 16 * n);
#pragma unroll
            for (int ai = 0; ai < 2; ++ai)
#pragma unroll
                for (int m = 0; m < 4; ++m) { const size_t ro = (size_t)(row0 + ai * HALF + m * 16) * D + ch0 + 16 * n;
                    const v2u xw = xall[n][ai][m];
                    const float xc[4] = {bflo(xw.x), bfhi(xw.x), bflo(xw.y), bfhi(xw.y)}; v4u o;
#pragma unroll
                    for (int j = 0; j < 4; ++j) { const float r = sigmoidf_(acc[ai][0][m][n][j] + vba[j]), gi = sigmoidf_(acc[ai][1][m][n][j] + vbx[j]);
                        const float la2 = -vc8[j] * r, a2 = fast_exp2(2.0f * la2), mult = __builtin_amdgcn_sqrtf(fmaxf(1.0f - a2, 0.f));
                        o[j] = pk2(mult * gi * xc[j], la2); }
                    *(v4u*)(AB + ro) = o;
                    if (m & 1) asm volatile("" ::: "memory"); }
        }
    }
};
struct EpiResid {
    static constexpr bool PERM = true;
    const xr_t* xin; xr_t* out;
    const float* gnext; bf16* hn; float* ssp; PG8_LAS unsigned char* lds;
    float h8s = 0.f;
    __device__ __forceinline__ void operator()(const f32x4 (&acc)[2][2][4][2], const Unit& u, int wr, int wc, int fr, int fq) const {
        int row0 = u.pm * BM + wr * 64 + fr; asm volatile("" : "+v"(row0)); const int col0 = u.pn * BM + wc * 32 + 8 * fq;
        PG8_LAS float* xch = (PG8_LAS float*)(lds + XCH_OFF);
        f32x4 gv[2][2];
        if (hn) {
#pragma unroll
            for (int bj = 0; bj < 2; ++bj)
#pragma unroll
                for (int n = 0; n < 2; ++n) gv[bj][n] = *(const f32x4*)(gnext + col0 + bj * HALF + 4 * n); }
        v4u xn[2];
#pragma unroll
        for (int bj = 0; bj < 2; ++bj) xn[bj] = *(const v4u*)(xin + (size_t)row0 * D + col0 + bj * HALF);
#pragma unroll
        for (int g8 = 0; g8 < 8; ++g8) { const int ai = g8 >> 2, m = g8 & 3; const int row = row0 + ai * HALF + m * 16; const size_t ro = (size_t)row * D + col0; float sq = 0.f;
                f32x4 xc[2][2];
#pragma unroll
                for (int bj = 0; bj < 2; ++bj) xr_unpack8(xn[bj], xc[bj][0], xc[bj][1]);
                if (g8 < 7) { const size_t rn = (size_t)(row0 + ((g8 + 1) >> 2) * HALF + ((g8 + 1) & 3) * 16) * D + col0;
#pragma unroll
                    for (int bj = 0; bj < 2; ++bj) xn[bj] = *(const v4u*)(xin + rn + bj * HALF); }
#pragma unroll
                for (int bj = 0; bj < 2; ++bj) { f32x4 o[2];
#pragma unroll
                    for (int n = 0; n < 2; ++n) o[n] = xc[bj][n] + acc[ai][bj][m][n];
                    *(v4u*)(out + ro + bj * HALF) = xr_pack8(o[0], o[1]);
                    if (hn) { sq += (o[0][0] * o[0][0] + o[0][1] * o[0][1]) + (o[0][2] * o[0][2] + o[0][3] * o[0][3]) + (o[1][0] * o[1][0] + o[1][1] * o[1][1]) + (o[1][2] * o[1][2] + o[1][3] * o[1][3]);
                        const f32x4 h0 = o[0] * gv[bj][0], h1 = o[1] * gv[bj][1];
                        if (h8s != 0.f) { v2u w; w.x = pack4_fp8(h0[0], h0[1], h0[2], h0[3], h8s); w.y = pack4_fp8(h1[0], h1[1], h1[2], h1[3], h8s); *(v2u*)((unsigned char*)hn + ro + bj * HALF) = w; }
                        else { v4u w; w.x = cvt_pk_bf16(h0[0], h0[1]); w.y = cvt_pk_bf16(h0[2], h0[3]); w.z = cvt_pk_bf16(h1[0], h1[1]); w.w = cvt_pk_bf16(h1[2], h1[3]);
                        *(v4u*)(hn + ro + bj * HALF) = w; } } }
                if (hn) { sq += __shfl_xor(sq, 16); sq += __shfl_xor(sq, 32); if (fq == 0) xch[wc * 256 + ai * HALF + wr * 64 + m * 16 + fr] = sq; }
                asm volatile("" ::: "memory"); }
        if (hn) {
            asm volatile("s_waitcnt lgkmcnt(0)" ::: "memory"); __builtin_amdgcn_s_barrier(); asm volatile("" ::: "memory");
            const int t = (wr * 4 + wc) * 64 + fq * 16 + fr;
            if (t < 256) ssp[(size_t)u.pn * T + u.pm * BM + t] = (xch[t] + xch[256 + t]) + (xch[512 + t] + xch[768 + t]);
        }
    }
};
struct EpiFoxIn {
    static constexpr bool PERM = true;
    bf16* base; size_t kstride; const float* qg; const float* kg; float c2;
    const float* ss;
    const float* bfv; float* LOGF;
    __device__ __forceinline__ void operator()(const f32x4 (&acc)[2][2][4][2], const Unit& u, int wr, int wc, int fr, int fq) const {
        const int kind = u.pn >> 2, head = 4 * (u.pn & 3) + wc; int row0 = u.pm * BM + wr * 64 + fr; asm volatile("" : "+v"(row0));
        float rs8[2][4]; row_rs8(ss, row0, fq, rs8);
        if (kind == 4) {
            if (wc == 0) { f32x4 bb[2];
#pragma unroll
                for (int n = 0; n < 2; ++n) bb[n] = *(const f32x4*)(bfv + 8 * (fq & 1) + 4 * n);
#pragma unroll
                for (int ai = 0; ai < 2; ++ai)
#pragma unroll
                    for (int m = 0; m < 4; ++m) { const int row = row0 + ai * HALF + m * 16; const float rs = rs8[ai][m];
                        if (fq < 2) {
#pragma unroll
                            for (int n = 0; n < 2; ++n) { f32x4 o;
#pragma unroll
                                for (int j = 0; j < 4; ++j) { const float z = acc[ai][0][m][n][j] * rs + bb[n][j]; o[j] = fminf(z, 0.f) - log1pf(__expf(-fabsf(z))); }
                                *(f32x4*)(LOGF + (size_t)row * 16 + 8 * fq + 4 * n) = o; } } } }
            return;
        }
        bf16* tb = base + (size_t)kind * kstride + head * HD + 8 * fq;
        f32x4 gn[2][2];
        if (kind < 2) { const float* gp = (kind == 0 ? qg : kg) + 8 * fq;
#pragma unroll
            for (int bj = 0; bj < 2; ++bj)
#pragma unroll
                for (int n = 0; n < 2; ++n) gn[bj][n] = *(const f32x4*)(gp + 32 * bj + 4 * n); }
        const float sc = (kind == 0) ? c2 : 1.0f;
#pragma unroll
        for (int ai = 0; ai < 2; ++ai)
#pragma unroll
            for (int m = 0; m < 4; ++m) { const int row = row0 + ai * HALF + m * 16; bf16* rowp = tb + (size_t)row * D;
                const float rsx = rs8[ai][m];
                f32x4 v[2][2];
#pragma unroll
                for (int bj = 0; bj < 2; ++bj)
#pragma unroll
                    for (int n = 0; n < 2; ++n) v[bj][n] = acc[ai][bj][m][n] * rsx;
                if (kind < 2) { float s2 = 0.f;
#pragma unroll
                    for (int bj = 0; bj < 2; ++bj)
#pragma unroll
                        for (int n = 0; n < 2; ++n) s2 += (v[bj][n][0] * v[bj][n][0] + v[bj][n][1] * v[bj][n][1]) + (v[bj][n][2] * v[bj][n][2] + v[bj][n][3] * v[bj][n][3]);
                    s2 += __shfl_xor(s2, 16); s2 += __shfl_xor(s2, 32);
                    const float rs = __builtin_amdgcn_rsqf(s2 * (1.0f / HD) + RMS_EPS) * sc;
#pragma unroll
                    for (int bj = 0; bj < 2; ++bj)
#pragma unroll
                        for (int n = 0; n < 2; ++n) v[bj][n] = v[bj][n] * rs * gn[bj][n];
                } else if (kind == 3) {
#pragma unroll
                    for (int bj = 0; bj < 2; ++bj)
#pragma unroll
                        for (int n = 0; n < 2; ++n)
#pragma unroll
                            for (int j = 0; j < 4; ++j) v[bj][n][j] = sigmoidf_(v[bj][n][j]);
                }
#pragma unroll
                for (int bj = 0; bj < 2; ++bj) { v4u w; w.x = cvt_pk_bf16(v[bj][0][0], v[bj][0][1]); w.y = cvt_pk_bf16(v[bj][0][2], v[bj][0][3]); w.z = cvt_pk_bf16(v[bj][1][0], v[bj][1][1]); w.w = cvt_pk_bf16(v[bj][1][2], v[bj][1][3]);
                    *(v4u*)(rowp + 32 * bj) = w; }
                asm volatile("" ::: "memory"); }
    }
};
struct EpiSwiglu {
    static constexpr bool PERM = true;
    bf16* Hb; int ldh; const float* ss; float hq;
    __device__ __forceinline__ void operator()(const f32x4 (&acc)[2][2][4][2], const Unit& u, int wr, int wc, int fr, int fq) const {
        int row0 = u.pm * BM + wr * 64 + fr; asm volatile("" : "+v"(row0)); const int col0 = u.pn * HALF + wc * 32 + 8 * fq;
        float rs8[2][4]; row_rs8(ss, row0, fq, rs8);
#pragma unroll
        for (int ai = 0; ai < 2; ++ai)
#pragma unroll
            for (int m = 0; m < 4; ++m) { bf16* rowp = Hb + (size_t)(row0 + ai * HALF + m * 16) * ldh + col0; float h[8];
                const float rs = rs8[ai][m];
#pragma unroll
                for (int n = 0; n < 2; ++n)
#pragma unroll
                    for (int j = 0; j < 4; ++j) { const float gv = acc[ai][0][m][n][j] * rs, uv = acc[ai][1][m][n][j] * rs; h[4 * n + j] = gv * uv * fast_rcp(1.0f + fast_exp2(-gv * LOG2E));
#if EMU_FP8
                        if (hq != 0.f) h[4 * n + j] = q8(h[4 * n + j], hq);
#endif
                    }
                v4u w; w.x = cvt_pk_bf16(h[0], h[1]); w.y = cvt_pk_bf16(h[2], h[3]); w.z = cvt_pk_bf16(h[4], h[5]); w.w = cvt_pk_bf16(h[6], h[7]);
                *(v4u*)rowp = w;
                asm volatile("" ::: "memory"); }
    }
};
struct EpiNull {
    static constexpr bool PERM = true;
    float* sink;
    __device__ __forceinline__ void operator()(const f32x4 (&acc)[2][2][4][2], const Unit& u, int wr, int wc, int fr, int fq) const {
        float s = 0.f;
#pragma unroll
        for (int ai = 0; ai < 2; ++ai)
#pragma unroll
            for (int bj = 0; bj < 2; ++bj)
#pragma unroll
                for (int m = 0; m < 4; ++m)
#pragma unroll
                    for (int n = 0; n < 2; ++n) s += acc[ai][bj][m][n][0] + acc[ai][bj][m][n][1] + acc[ai][bj][m][n][2] + acc[ai][bj][m][n][3];
        if (s == 12345.678f) *sink = s;
    }
};
struct EpiSwiglu8 {
    static constexpr bool PERM = true;
    unsigned char* H8; int ldh; float hs; const float* ss = nullptr;
    __device__ __forceinline__ void operator()(const f32x4 (&acc)[2][2][4][2], const Unit& u, int wr, int wc, int fr, int fq) const {
        int row0 = u.pm * BM + wr * 64 + fr; asm volatile("" : "+v"(row0)); const int col0 = u.pn * HALF + wc * 32 + 8 * fq;
        float rs8[2][4]; row_rs8(ss, row0, fq, rs8);
#pragma unroll
        for (int ai = 0; ai < 2; ++ai)
#pragma unroll
            for (int m = 0; m < 4; ++m) { unsigned char* rowp = H8 + (size_t)(row0 + ai * HALF + m * 16) * ldh + col0; float h[8];
                const float rs = rs8[ai][m];
#pragma unroll
                for (int n = 0; n < 2; ++n)
#pragma unroll
                    for (int j = 0; j < 4; ++j) { const float gv = acc[ai][0][m][n][j] * rs, uv = acc[ai][1][m][n][j] * rs; h[4 * n + j] = gv * uv * fast_rcp(1.0f + fast_exp2(-gv * LOG2E)); }
                v2u w; w.x = pack4_fp8(h[0], h[1], h[2], h[3], hs); w.y = pack4_fp8(h[4], h[5], h[6], h[7], hs);
                *(v2u*)rowp = w;
                asm volatile("" ::: "memory"); }
    }
};
struct EpiScatter {
    static constexpr bool PERM = true; static constexpr int NST = 0;
    const xr_t* xr; xr_t* xw; float* fout; const unsigned* list; const float* listw;
    const float* gnext; bf16* hn; float* ssp; PG8_LAS unsigned char* lds;
    float h8s = 0.f;
    __device__ __forceinline__ void operator()(const f32x4 (&acc)[2][2][4][2], const Unit& u, int wr, int wc, int fr, int fq) const {
        int row0 = u.pm * BM + wr * 64 + fr; asm volatile("" : "+v"(row0)); const int col0 = u.pn * BM + wc * 32 + 8 * fq;
        PG8_LAS float* xch = (PG8_LAS float*)(lds + XCH_OFF);
        unsigned idx8[8]; float w8[8];
#pragma unroll
        for (int g8 = 0; g8 < 8; ++g8) { const int row = row0 + (g8 >> 2) * HALF + (g8 & 3) * 16; idx8[g8] = list[row]; w8[g8] = listw[row]; }
        v4u xn[2];
        { const size_t r0 = (size_t)(idx8[0] & 0xffffu) * D + col0;
#pragma unroll
          for (int bj = 0; bj < 2; ++bj) xn[bj] = *(const v4u*)(xr + r0 + bj * HALF); }
#pragma unroll
        for (int g8 = 0; g8 < 8; ++g8) { const int ai = g8 >> 2, m = g8 & 3; const unsigned idx = idx8[g8]; const float w = w8[g8]; const bool valid = (idx & 0x80000000u) != 0u;
                const int tok = (int)(idx & 0xffffu); const size_t ro = (size_t)tok * D + col0; float sq = 0.f;
                f32x4 xc[2][2];
#pragma unroll
                for (int bj = 0; bj < 2; ++bj) xr_unpack8(xn[bj], xc[bj][0], xc[bj][1]);
                if (g8 < 7) { const size_t rn = (size_t)(idx8[g8 + 1 < 8 ? g8 + 1 : 7] & 0xffffu) * D + col0;
#pragma unroll
                    for (int bj = 0; bj < 2; ++bj) xn[bj] = *(const v4u*)(xr + rn + bj * HALF); }
                if (valid) {
#pragma unroll
                    for (int bj = 0; bj < 2; ++bj) { f32x4 o[2];
#pragma unroll
                        for (int n = 0; n < 2; ++n) o[n] = xc[bj][n] + acc[ai][bj][m][n] * w;
                        if (fout) { *(f32x4*)(fout + ro + bj * HALF) = o[0]; *(f32x4*)(fout + ro + bj * HALF + 4) = o[1]; }
                        else *(v4u*)(xw + ro + bj * HALF) = xr_pack8(o[0], o[1]);
                        if (hn) { sq += (o[0][0] * o[0][0] + o[0][1] * o[0][1]) + (o[0][2] * o[0][2] + o[0][3] * o[0][3]) + (o[1][0] * o[1][0] + o[1][1] * o[1][1]) + (o[1][2] * o[1][2] + o[1][3] * o[1][3]);
                            const f32x4 g0 = *(const f32x4*)(gnext + col0 + bj * HALF), g1 = *(const f32x4*)(gnext + col0 + bj * HALF + 4);
                            const f32x4 h0 = o[0] * g0, h1 = o[1] * g1;
                            if (h8s != 0.f) { v2u w2; w2.x = pack4_fp8(h0[0], h0[1], h0[2], h0[3], h8s); w2.y = pack4_fp8(h1[0], h1[1], h1[2], h1[3], h8s); *(v2u*)((unsigned char*)hn + ro + bj * HALF) = w2; }
                            else { v4u w4; w4.x = cvt_pk_bf16(h0[0], h0[1]); w4.y = cvt_pk_bf16(h0[2], h0[3]); w4.z = cvt_pk_bf16(h1[0], h1[1]); w4.w = cvt_pk_bf16(h1[2], h1[3]);
                            *(v4u*)(hn + ro + bj * HALF) = w4; } }
                        asm volatile("" ::: "memory"); } }
                if (hn) { sq += __shfl_xor(sq, 16); sq += __shfl_xor(sq, 32); if (fq == 0) xch[wc * 256 + ai * HALF + wr * 64 + m * 16 + fr] = sq; }
                asm volatile("" ::: "memory"); }
        if (hn) {
            asm volatile("s_waitcnt lgkmcnt(0)" ::: "memory"); __builtin_amdgcn_s_barrier(); asm volatile("" ::: "memory");
            const int t = (wr * 4 + wc) * 64 + fq * 16 + fr;
            if (t < 256) { const unsigned idx = list[u.pm * BM + t];
                if (idx & 0x80000000u) ssp[(size_t)u.pn * T + (idx & 0xffffu)] = (xch[t] + xch[256 + t]) + (xch[512 + t] + xch[768 + t]); }
        }
    }
};
}

#define XB_TMO      128
#define XB_XCNT(j)  (256  + 64 * (j))
#define XB_XSUB(j)  (1280 + 64 * (j))
#define XB_XGEN(j)  (2304 + 64 * (j))
#define XB_TOP      3328
#define XB_TOPGEN   3392
#define XCD_BAR_WORDS 3456
#define XB_SPIN_CAP (1u << 21)
__device__ __forceinline__ unsigned xb_ld(unsigned* p)              { return __hip_atomic_load(p, __ATOMIC_RELAXED, __HIP_MEMORY_SCOPE_AGENT); }
__device__ __forceinline__ unsigned xb_add(unsigned* p, unsigned v) { return __hip_atomic_fetch_add(p, v, __ATOMIC_RELAXED, __HIP_MEMORY_SCOPE_AGENT); }
__device__ __forceinline__ unsigned xb_xcc_id() { return (unsigned)__builtin_amdgcn_s_getreg((3 << 11) | 20) & 0xFu; }
#define XB_SPIN(cond, bar) do { unsigned _sp = 0; while (cond) { __builtin_amdgcn_s_sleep(1); \
    if ((++_sp & 255u) == 0u) { if (xb_ld(&(bar)[XB_TMO])) break; if (_sp > XB_SPIN_CAP) { atomicAdd(&(bar)[XB_TMO], 1u); break; } } } } while (0)
struct XcdBarrier { unsigned* bar; unsigned x; volatile LAS unsigned* st; };
__device__ __forceinline__ XcdBarrier xcd_barrier_post(unsigned* bar, volatile LAS unsigned* st) {
    XcdBarrier b; b.bar = bar; b.x = xb_xcc_id(); b.st = st;
    if (threadIdx.x == 0) (void)xb_add(&bar[XB_XCNT(b.x)], 1u);
    return b;
}
__device__ __forceinline__ void xcd_barrier_complete(unsigned* bar, unsigned x, unsigned& nloc, unsigned& nx) {
    const unsigned G = gridDim.x * gridDim.y * gridDim.z;
    unsigned sum, cnt, mine, sp = 0u;
    for (;;) {
        sum = 0u; cnt = 0u; mine = 0u;
#pragma unroll
        for (unsigned j = 0; j < 16; ++j) { const unsigned c = xb_ld(&bar[XB_XCNT(j)]); sum += c; cnt += (c > 0u) ? 1u : 0u; mine = (j == x) ? c : mine; }
        if (sum == G) break;
        __builtin_amdgcn_s_sleep(1);
        if ((++sp & 255u) == 0u) { if (xb_ld(&bar[XB_TMO])) break; if (sp > XB_SPIN_CAP) { atomicAdd(&bar[XB_TMO], 1u); break; } }
    }
    nloc = mine > 0u ? mine : 1u; nx = cnt > 0u ? cnt : 1u;
}
__device__ __forceinline__ void xcd_barrier(const XcdBarrier& b) {
    asm volatile("s_waitcnt vmcnt(0)" ::: "memory");
    __syncthreads();
    if (threadIdx.x == 0) {
        unsigned* bar = b.bar; asm volatile("" : "+s"(bar));
        __builtin_amdgcn_s_waitcnt(0);
        unsigned nloc = b.st[0], nx = b.st[1];
        if (nloc == 0u) { xcd_barrier_complete(bar, b.x, nloc, nx); b.st[0] = nloc; b.st[1] = nx; }
        const unsigned old = xb_add(&bar[XB_XSUB(b.x)], 1u);
        const unsigned gen = old / nloc;
        if (old + 1u == (gen + 1u) * nloc) {
            __builtin_amdgcn_fence(__ATOMIC_RELEASE, "agent");
            asm volatile("s_waitcnt vmcnt(0)" ::: "memory");
            const unsigned og = xb_add(&bar[XB_TOP], 1u);
            const unsigned tg = og / nx;
            if (og + 1u == (tg + 1u) * nx) xb_add(&bar[XB_TOPGEN], 1u);
            else XB_SPIN(xb_ld(&bar[XB_TOPGEN]) == tg, bar);
            __builtin_amdgcn_fence(__ATOMIC_ACQUIRE, "agent");
            xb_add(&bar[XB_XGEN(b.x)], 1u);
            asm volatile("s_waitcnt vmcnt(0)" ::: "memory");
        } else {
            XB_SPIN(xb_ld(&bar[XB_XGEN(b.x)]) == gen, bar);
            __builtin_amdgcn_fence(__ATOMIC_ACQUIRE, "agent");
            asm volatile("s_waitcnt vmcnt(0)" ::: "memory");
        }
    }
    __syncthreads();
}

constexpr size_t MiB = 1u << 20;
constexpr size_t WS_CTL = 0, CTL_ZERO_BYTES = 1 * MiB;
constexpr size_t WS_F2 = 1 * MiB;
constexpr size_t WS_LOGF = 5 * MiB;
constexpr size_t WS_AGG = 9 * MiB;
constexpr size_t WS_TOPE = 13 * MiB;
constexpr size_t WS_TOPW = 13 * MiB + 256 * 1024;
constexpr size_t WS_SMALL = 13 * MiB + 768 * 1024;
constexpr size_t SM_CNT = 0, SM_TILE = 16384, SM_NT = 16384 + 8192, SM_C8 = 16384 + 8192 + 256, SM_T0 = SM_C8 + 4096;
constexpr int CW_QCTR = 2048;
constexpr float SKIP_THR = 64.0f;
constexpr int LISTCAP = 264 * 256;
constexpr size_t WS_LIST = 14 * MiB;
constexpr size_t WS_LISTW = 15 * MiB;
constexpr size_t WS_WL = 16 * MiB;
constexpr size_t WL_IN = 0, WL_G = 4 * MiB, WL_OUT = 5 * MiB, WL_W1 = 8 * MiB, WL_W2 = 22 * MiB;
constexpr size_t WS_WF = 48 * MiB;
constexpr size_t WF_IN = 0, WF_OUT = 9 * MiB, WF_W1 = 11 * MiB, WF_W2 = 123 * MiB;
constexpr size_t WS_SS = 228 * MiB;
constexpr size_t WS_HN = 232 * MiB;
constexpr size_t WS_ACT = 360 * MiB;
constexpr size_t ACT_SLOT = 128 * MiB;
constexpr size_t WS_W2B = 1000 * MiB;
constexpr size_t WS_END = 1056 * MiB;
static_assert(WS_WL + WL_W2 + (size_t)D * FF * 2 <= WS_WF && WS_WF + WF_W2 + (size_t)NE * D * FF * 2 <= WS_SS && WS_SS + 12 * (size_t)T * 4 <= WS_HN && WS_HN + (size_t)T * D * 2 <= WS_ACT && WS_ACT + 5 * ACT_SLOT <= WS_W2B && WS_W2B + (size_t)NE * D * FF * 2 <= WS_END, "d_ws map");
constexpr int CW_BAR = 4096;

constexpr int RING_BYTES = 131072, MISC_OFF = RING_BYTES + 320, LDS_BYTES = 147456;

struct Args {
    const float* in[24]; float* out; unsigned char* ws; int ph_lo, ph_hi;
};

__device__ __forceinline__ const float* inp(int k) {
    int kk = k; asm volatile("" : "+s"(kk));
    const __attribute__((address_space(4))) unsigned long long* tab = (const __attribute__((address_space(4))) unsigned long long*)__builtin_amdgcn_kernarg_segment_ptr();
    return (const float*)(uintptr_t)tab[kk];
}
struct Frame {
    LAS unsigned char* lds; unsigned char* ldsg;
    int tid, lane, wave, G, vcu, bx;
};

struct CvtJob { const float* src; bf16* dst; int pitch, dpitch; float qs; float f8;    };
__device__ __forceinline__ void cvt_load(const CvtJob& jb, float (&r)[32], int lane) {
    const float* p = jb.src + (size_t)(lane >> 5) * jb.pitch + (lane & 31);
#pragma unroll
    for (int i = 0; i < 32; ++i) r[i] = p[(size_t)(2 * i) * jb.pitch];
#if EMU_FP8
    if (jb.qs != 0.f) {
#pragma unroll
        for (int i = 0; i < 32; ++i) r[i] = q8(r[i], jb.qs); }
#endif
}
__device__ __forceinline__ void cvt_store(const CvtJob& jb, const float (&r)[32], LAS float* scr, int lane) {
#pragma unroll
    for (int i = 0; i < 32; ++i) scr[(2 * i + (lane >> 5)) * 33 + (lane & 31)] = r[i];
    LDS_WAIT(); asm volatile("" ::: "memory");
    const int c = lane & 7;
    if (jb.f8 != 0.f) {
#pragma unroll
        for (int j = 0; j < 4; ++j) { const int n = (lane >> 3) + 8 * j; const LAS float* s = scr + (8 * c) * 33 + n;
            v2u o; o.x = pack4_fp8(s[0 * 33], s[1 * 33], s[2 * 33], s[3 * 33], jb.f8); o.y = pack4_fp8(s[4 * 33], s[5 * 33], s[6 * 33], s[7 * 33], jb.f8);
            *(GAS v2u*)((unsigned char*)jb.dst + (size_t)n * jb.dpitch + 8 * c) = o; }
    } else {
#pragma unroll
    for (int j = 0; j < 4; ++j) { const int n = (lane >> 3) + 8 * j; const LAS float* s = scr + (8 * c) * 33 + n;
        v4u o; o.x = pk2(s[0 * 33], s[1 * 33]); o.y = pk2(s[2 * 33], s[3 * 33]); o.z = pk2(s[4 * 33], s[5 * 33]); o.w = pk2(s[6 * 33], s[7 * 33]);
        *(GAS v4u*)(jb.dst + (size_t)n * jb.dpitch + 8 * c) = o; }
    }
    LDS_WAIT(); asm volatile("" ::: "memory");
}
enum { MAP_NAT = 0, MAP_FOXIN = 1, MAP_GU = 2 };
__device__ __forceinline__ int map_row(int kind, int n0, int half) {
    if (kind == MAP_NAT) return n0;
    if (kind == MAP_FOXIN) { const int tile = n0 >> 8, c = n0 & 255, wc = c >> 6, bj = (c >> 5) & 1; return tile * 256 + bj * 128 + wc * 32; }
    return (n0 >> 7) * 256 + half * 128 + (n0 & 127);
}
__device__ __forceinline__ CvtJob cvt_mk(const float* W, int N, int pitch, bf16* WT, int dpitch, int kind, int half, int drow_base, int idx) {
    const int nblk = N / 32, kb = idx / nblk, nb = idx % nblk;
    CvtJob jb; jb.src = W + (size_t)(64 * kb) * pitch + 32 * nb; jb.dst = WT + (size_t)(drow_base + map_row(kind, 32 * nb, half)) * dpitch + 64 * kb; jb.pitch = pitch; jb.dpitch = dpitch; jb.qs = 0.f; jb.f8 = 0.f; return jb;
}
__device__ __forceinline__ CvtJob cvt_mk8(const float* W, int N, int pitch, unsigned char* WT8, int K, int kind, int half, int drow_base, int idx, float sc) {
    const int nblk = N / 32, kb = idx / nblk, nb = idx % nblk;
    CvtJob jb; jb.src = W + (size_t)(64 * kb) * pitch + 32 * nb; jb.dst = (bf16*)(WT8 + (size_t)(drow_base + map_row(kind, 32 * nb, half)) * K + 64 * kb); jb.pitch = pitch; jb.dpitch = K; jb.qs = 0.f; jb.f8 = sc; return jb;
}
constexpr int CVT_L_TOTAL = 1024 + 128 + 512 + 3 * 1792, CVT_F_TOTAL = 2048 + 512 + NE * 3 * 1792;
__device__ __forceinline__ CvtJob cvt_decode_lru(int it, int j, unsigned char* wreg) {
    bf16* Win_t = (bf16*)(wreg + WL_IN); bf16* Wg_t = (bf16*)(wreg + WL_G); bf16* Wout_t = (bf16*)(wreg + WL_OUT); bf16* W1_t = (bf16*)(wreg + WL_W1); bf16* W2_t = (bf16*)(wreg + WL_W2);
    if (it < 1024) { if (FP8_LRUIN_J1 && j == 1) return cvt_mk8(inp(3) + (size_t)j * D * 2 * D, 2 * D, 2 * D, (unsigned char*)Win_t, D, MAP_NAT, 0, 0, it, 64.f);
        return cvt_mk(inp(3) + (size_t)j * D * 2 * D, 2 * D, 2 * D, Win_t, D, MAP_NAT, 0, 0, it); }
    it -= 1024;
    if (it < 128) { const int m = it >> 3, hb = m >> 1, gx = m & 1; return cvt_mk(inp(gx ? 8 : 6) + ((size_t)j * 8 + hb) * 128 * 128, 128, 128, Wg_t, 128, MAP_NAT, 0, 256 * hb + 128 * gx, it & 7); }
    it -= 128;
    if (it < 512) return cvt_mk(inp(11) + (size_t)j * D * D, D, D, Wout_t, D, MAP_NAT, 0, 0, it);
    it -= 512;
    if (FP8_L2_FFN && j == 1) {
        if (it < 1792) return cvt_mk8(inp(17) + (size_t)j * D * FF, FF, FF, (unsigned char*)W1_t, D, MAP_GU, 0, 0, it, 64.f);
        it -= 1792;
        if (it < 1792) return cvt_mk8(inp(18) + (size_t)j * D * FF, FF, FF, (unsigned char*)W1_t, D, MAP_GU, 1, 0, it, 64.f);
        it -= 1792;
        return cvt_mk8(inp(19) + (size_t)j * FF * D, D, D, (unsigned char*)W2_t, FF, MAP_NAT, 0, 0, it, 128.f);
    }
    const bool q = (EMU_FP8 >= 2 && j == 1) || EMU_FP8 >= 3;
    if (it < 1792) { CvtJob jb = cvt_mk(inp(17) + (size_t)j * D * FF, FF, FF, W1_t, D, MAP_GU, 0, 0, it); if (q) jb.qs = 64.f; return jb; }
    it -= 1792;
    if (it < 1792) { CvtJob jb = cvt_mk(inp(18) + (size_t)j * D * FF, FF, FF, W1_t, D, MAP_GU, 1, 0, it); if (q) jb.qs = 64.f; return jb; }
    it -= 1792;
    { CvtJob jb = cvt_mk(inp(19) + (size_t)j * FF * D, D, D, W2_t, FF, MAP_NAT, 0, 0, it); if (q) jb.qs = 128.f; return jb; }
}
__device__ __forceinline__ CvtJob cvt_decode_fox(int it, int j, unsigned char* wreg) {
    bf16* Win_t = (bf16*)(wreg + WF_IN); bf16* Wout_t = (bf16*)(wreg + WF_OUT); bf16* W1_t = (bf16*)(wreg + WF_W1); bf16* W2_t = (bf16*)(wreg + ((CVT_OVERLAP && j == 1) ? (WS_W2B - WS_WF) : WF_W2));
    if (it < 2048) { if (FP8_FOXIN_J1 && (j == 1 || FP8_FOXIN_J0)) return cvt_mk8(inp(12) + (size_t)j * D * (4 * D + NH), 4 * D, 4 * D + NH, (unsigned char*)Win_t, D, MAP_FOXIN, 0, 0, it, 64.f);
        return cvt_mk(inp(12) + (size_t)j * D * (4 * D + NH), 4 * D, 4 * D + NH, Win_t, D, MAP_FOXIN, 0, 0, it); }
    it -= 2048;
    if (it < 512) return cvt_mk(inp(16) + (size_t)j * D * D, D, D, Wout_t, D, MAP_NAT, 0, 0, it);
    it -= 512;
    const int e = it / (3 * 1792), q = it % (3 * 1792), m = q / 1792, idx = q % 1792;
    CvtJob jb;
    if (FP8_LAST_MOE && (j == 1 || FP8_MOE_J0)) {
        if (m == 0) return cvt_mk8(inp(21) + ((size_t)j * NE + e) * D * FF, FF, FF, (unsigned char*)W1_t, D, MAP_GU, 0, e * 2 * FF, idx, 64.f);
        if (m == 1) return cvt_mk8(inp(22) + ((size_t)j * NE + e) * D * FF, FF, FF, (unsigned char*)W1_t, D, MAP_GU, 1, e * 2 * FF, idx, 64.f);
        return cvt_mk8(inp(23) + ((size_t)j * NE + e) * FF * D, D, D, (unsigned char*)W2_t, FF, MAP_NAT, 0, e * D, idx, 128.f);
    }
    if (m == 0) jb = cvt_mk(inp(21) + ((size_t)j * NE + e) * D * FF, FF, FF, W1_t, D, MAP_GU, 0, e * 2 * FF, idx);
    else if (m == 1) jb = cvt_mk(inp(22) + ((size_t)j * NE + e) * D * FF, FF, FF, W1_t, D, MAP_GU, 1, e * 2 * FF, idx);
    else jb = cvt_mk(inp(23) + ((size_t)j * NE + e) * FF * D, D, D, W2_t, FF, MAP_NAT, 0, e * D, idx);
    if ((EMU_FP8 && j == 1) || EMU_FP8 >= 3) jb.qs = (m == 2) ? 128.f : 64.f;
    return jb;
}
template <bool FOX>
__device__ __forceinline__ void cvt_phase(Frame& F, int j, unsigned char* wreg, int isp = 0x3fffffff, int csk = 0) {
    const int gw = F.vcu * NWAVES + F.wave, NGW = F.G * NWAVES, total = FOX ? CVT_F_TOTAL : CVT_L_TOTAL;
    const int gw2 = (F.bx - csk) * NWAVES + F.wave, NGW2 = (F.G - csk) * NWAVES;
#define CVT_ITEM(i_) (((i_) < isp) ? (i_) * NGW + gw : ((F.bx < csk) ? total : isp * NGW + ((i_) - isp) * NGW2 + gw2))
    LAS float* scr = (LAS float*)(F.lds + F.wave * 16384);
    int ri = 0, it = CVT_ITEM(0);
    if (it >= total) return;
    float ra[32], rb[32];
    CvtJob ja = FOX ? cvt_decode_fox(it, j, wreg) : cvt_decode_lru(it, j, wreg), jb2 = ja;
    cvt_load(ja, ra, F.lane);
    for (;;) {
        ++ri; const int nx = CVT_ITEM(ri); const bool more = nx < total;
        if (more) { jb2 = FOX ? cvt_decode_fox(nx, j, wreg) : cvt_decode_lru(nx, j, wreg); cvt_load(jb2, rb, F.lane); }
        cvt_store(ja, ra, scr, F.lane);
        if (!more) break;
        ja = jb2;
#pragma unroll
        for (int i = 0; i < 32; ++i) ra[i] = rb[i];
    }
#undef CVT_ITEM
}

template <int NP, bool XB16 = false>
__device__ __forceinline__ void norm_phase(Frame& F, const float* xin, const float* gain, bf16* HN, const float* Wp, int wp_pitch,
                                           const float* bfv, float* LOGF, unsigned* TOPE, float* TOPW, unsigned* CNT, float hq = 0.f, xr_t* xcopy = nullptr) {
    LAS float* Wl = (LAS float*)(F.lds);
    LAS int* cnts = (LAS int*)(F.lds + 65536);
    if (NP > 0) {
        for (int idx = F.tid; idx < NP * 1024; idx += NWAVES * 64) { const int c = idx / NP, j = idx % NP; Wl[j * 1024 + c] = Wp[(size_t)c * wp_pitch + j]; }
        if (NP == 8 && F.tid < 16) cnts[F.tid] = 0;
        __syncthreads();
    }
    f32x4 gv[4];
#pragma unroll
    for (int j = 0; j < 4; ++j) gv[j] = *(const f32x4*)(gain + 4 * F.lane + 256 * j);
    const int rbase = F.bx * 256 + F.wave * 32;
    f32x4 vn[4]; v2u vb[4];
    if (XB16) { const GAS v2u* xr = (const GAS v2u*)((const xr_t*)xin + (size_t)rbase * D) + F.lane;
#pragma unroll
      for (int j = 0; j < 4; ++j) vb[j] = xr[64 * j]; }
    else { const GAS f32x4* xr = (const GAS f32x4*)(xin + (size_t)rbase * D) + F.lane;
#pragma unroll
      for (int j = 0; j < 4; ++j) vn[j] = xr[64 * j]; }
    for (int i = 0; i < 32; ++i) {
        const int m = rbase + i;
        f32x4 v[4];
        if (XB16) {
#pragma unroll
            for (int j = 0; j < 4; ++j) { v[j].x = __uint_as_float(vb[j].x << 16); v[j].y = __uint_as_float(vb[j].x & 0xffff0000u); v[j].z = __uint_as_float(vb[j].y << 16); v[j].w = __uint_as_float(vb[j].y & 0xffff0000u); }
            if (i + 1 < 32) { const GAS v2u* xr = (const GAS v2u*)((const xr_t*)xin + (size_t)(m + 1) * D) + F.lane;
#pragma unroll
                for (int j = 0; j < 4; ++j) vb[j] = xr[64 * j]; }
        } else {
#pragma unroll
            for (int j = 0; j < 4; ++j) v[j] = vn[j];
            if (i + 1 < 32) { const GAS f32x4* xr = (const GAS f32x4*)(xin + (size_t)(m + 1) * D) + F.lane;
#pragma unroll
                for (int j = 0; j < 4; ++j) vn[j] = xr[64 * j]; }
            if (xcopy) { GAS v2u* xc = (GAS v2u*)(xcopy + (size_t)m * D) + F.lane;
#pragma unroll
                for (int j = 0; j < 4; ++j) { v2u w; w.x = cvt_pk_bf16(v[j].x, v[j].y); w.y = cvt_pk_bf16(v[j].z, v[j].w); xc[64 * j] = w; } }
        }
        float s = 0.f;
#pragma unroll
        for (int j = 0; j < 4; ++j) s += (v[j].x * v[j].x + v[j].y * v[j].y) + (v[j].z * v[j].z + v[j].w * v[j].w);
        const float rs = 1.0f / __builtin_sqrtf(wave_sum(s) * (1.0f / D) + RMS_EPS);
#pragma unroll
        for (int j = 0; j < 4; ++j) v[j] = v[j] * rs * gv[j];
        GAS unsigned long long* o8 = (GAS unsigned long long*)(HN + (size_t)m * D) + F.lane;
#if EMU_FP8
        if (hq != 0.f) {
#pragma unroll
            for (int j = 0; j < 4; ++j) o8[64 * j] = (unsigned long long)pk2(q8(v[j].x, hq), q8(v[j].y, hq)) | ((unsigned long long)pk2(q8(v[j].z, hq), q8(v[j].w, hq)) << 32);
        } else
#endif
        if (hq < 0.f) {
            GAS unsigned* o4 = (GAS unsigned*)((unsigned char*)HN + (size_t)m * D) + F.lane;
#pragma unroll
            for (int j = 0; j < 4; ++j) o4[64 * j] = pack4_fp8(v[j].x, v[j].y, v[j].z, v[j].w, -hq);
        } else
#pragma unroll
        for (int j = 0; j < 4; ++j) o8[64 * j] = (unsigned long long)pk2(v[j].x, v[j].y) | ((unsigned long long)pk2(v[j].z, v[j].w) << 32);
        if (NP > 0) {
            float mine = 0.f;
#pragma unroll 2
            for (int p = 0; p < NP; ++p) { float a = 0.f;
#pragma unroll
                for (int j = 0; j < 4; ++j) { const f32x4 w = *(const LAS f32x4*)(Wl + p * 1024 + 4 * F.lane + 256 * j); a += (v[j].x * w.x + v[j].y * w.y) + (v[j].z * w.z + v[j].w * w.w); }
                a = wave_sum(a); if (F.lane == p) mine = a; }
            if (NP == 16) {
                if (F.lane < 16) { const float z = mine + bfv[F.lane]; const float ls = fminf(z, 0.f) - log1pf(__expf(-fabsf(z))); LOGF[(size_t)m * 16 + F.lane] = ls; }
            } else {
                float lg[8];
#pragma unroll
                for (int p = 0; p < 8; ++p) lg[p] = __shfl(mine, p);
                int i1 = 0; float l1 = lg[0];
#pragma unroll
                for (int p = 1; p < 8; ++p) if (lg[p] > l1) { l1 = lg[p]; i1 = p; }
                int i2 = (i1 == 0) ? 1 : 0; float l2 = (i1 == 0) ? lg[1] : lg[0];
#pragma unroll
                for (int p = 1; p < 8; ++p) if (p != i1 && lg[p] > l2) { l2 = lg[p]; i2 = p; }
                const float w1 = 1.0f / (1.0f + __expf(l2 - l1)), w2 = 1.0f - w1;
                if (F.lane == 0) { TOPE[m] = (unsigned)i1 | ((unsigned)i2 << 8); TOPW[2 * (size_t)m] = w1; TOPW[2 * (size_t)m + 1] = w2;
                    atomicAdd((int*)&cnts[i1], 1); atomicAdd((int*)&cnts[8 + i2], 1); }
            }
        }
    }
    if (NP == 8) { __syncthreads(); if (F.tid < 16) CNT[F.bx * 16 + F.tid] = (unsigned)cnts[F.tid]; }
    __syncthreads();
}

__device__ __forceinline__ void norm0_phase(Frame& F, const float* xin, const float* gain, bf16* HN, xr_t* XR) {
    f32x4 gv[4];
#pragma unroll
    for (int j = 0; j < 4; ++j) gv[j] = *(const f32x4*)(gain + 4 * F.lane + 256 * j);
    const int rbase = F.bx * 256 + F.wave * 32;
    f32x4 nb[4][4];
#pragma unroll
    for (int r = 0; r < 4; ++r) { const GAS f32x4* xr = (const GAS f32x4*)(xin + (size_t)(rbase + r) * D) + F.lane;
#pragma unroll
        for (int j = 0; j < 4; ++j) nb[r][j] = xr[64 * j]; }
    for (int g = 0; g < 8; ++g) {
        f32x4 v[4][4];
#pragma unroll
        for (int r = 0; r < 4; ++r)
#pragma unroll
            for (int j = 0; j < 4; ++j) v[r][j] = nb[r][j];
        if (g + 1 < 8) {
#pragma unroll
            for (int r = 0; r < 4; ++r) { const GAS f32x4* xr = (const GAS f32x4*)(xin + (size_t)(rbase + 4 * (g + 1) + r) * D) + F.lane;
#pragma unroll
                for (int j = 0; j < 4; ++j) nb[r][j] = xr[64 * j]; } }
        float ss[4];
#pragma unroll
        for (int r = 0; r < 4; ++r) { float s = 0.f;
#pragma unroll
            for (int j = 0; j < 4; ++j) s += (v[r][j].x * v[r][j].x + v[r][j].y * v[r][j].y) + (v[r][j].z * v[r][j].z + v[r][j].w * v[r][j].w);
            ss[r] = s; }
#pragma unroll
        for (int o = 1; o < 64; o <<= 1) {
#pragma unroll
            for (int r = 0; r < 4; ++r) ss[r] += __shfl_xor(ss[r], o); }
#pragma unroll
        for (int r = 0; r < 4; ++r) { const int m = rbase + 4 * g + r;
            const float rs = 1.0f / __builtin_sqrtf(ss[r] * (1.0f / D) + RMS_EPS);
            GAS v2u* xc = (GAS v2u*)(XR + (size_t)m * D) + F.lane; GAS v2u* o8 = (GAS v2u*)(HN + (size_t)m * D) + F.lane;
#pragma unroll
            for (int j = 0; j < 4; ++j) { v2u w; w.x = cvt_pk_bf16(v[r][j].x, v[r][j].y); w.y = cvt_pk_bf16(v[r][j].z, v[r][j].w); xc[64 * j] = w;
                const f32x4 h = v[r][j] * rs * gv[j]; v2u w2; w2.x = pk2(h.x, h.y); w2.y = pk2(h.z, h.w); o8[64 * j] = w2; } }
    }
}

__device__ __forceinline__ void router_phase(Frame& F, const xr_t* xin, const float* gain, unsigned char* HN8, const float* Wp, unsigned* TOPE, float* TOPW, unsigned* CNT, float hs) {
    LAS float* Wl = (LAS float*)(F.lds);
    LAS int* cnts = (LAS int*)(F.lds + 65536);
    for (int idx = F.tid; idx < NE * 1024; idx += NWAVES * 64) { const int c = idx / NE, p = idx % NE; Wl[p * 1024 + c] = Wp[(size_t)c * NE + p] * gain[c]; }
    if (F.tid < 16) cnts[F.tid] = 0;
    __syncthreads();
    f32x4 gv[4];
#pragma unroll
    for (int j = 0; j < 4; ++j) gv[j] = *(const f32x4*)(gain + 4 * F.lane + 256 * j);
    const int rbase = F.bx * 256 + F.wave * 32;
    const bool up1 = (F.lane & 1) != 0, up2 = (F.lane & 2) != 0, up4 = (F.lane & 4) != 0;
    v2u nb[4][4];
#pragma unroll
    for (int r = 0; r < 4; ++r) { const GAS v2u* xr = (const GAS v2u*)(xin + (size_t)(rbase + r) * D) + F.lane;
#pragma unroll
        for (int j = 0; j < 4; ++j) nb[r][j] = xr[64 * j]; }
    for (int g = 0; g < 8; ++g) {
        f32x4 v[4][4];
#pragma unroll
        for (int r = 0; r < 4; ++r)
#pragma unroll
            for (int j = 0; j < 4; ++j) { v[r][j].x = __uint_as_float(nb[r][j].x << 16); v[r][j].y = __uint_as_float(nb[r][j].x & 0xffff0000u); v[r][j].z = __uint_as_float(nb[r][j].y << 16); v[r][j].w = __uint_as_float(nb[r][j].y & 0xffff0000u); }
        if (g + 1 < 8) {
#pragma unroll
            for (int r = 0; r < 4; ++r) { const GAS v2u* xr = (const GAS v2u*)(xin + (size_t)(rbase + 4 * (g + 1) + r) * D) + F.lane;
#pragma unroll
                for (int j = 0; j < 4; ++j) nb[r][j] = xr[64 * j]; } }
        float a[4][8];
#pragma unroll
        for (int p = 0; p < 8; ++p) { f32x4 w[4];
#pragma unroll
            for (int j = 0; j < 4; ++j) w[j] = *(const LAS f32x4*)(Wl + p * 1024 + 4 * F.lane + 256 * j);
#pragma unroll
            for (int r = 0; r < 4; ++r) { float t = 0.f;
#pragma unroll
                for (int j = 0; j < 4; ++j) t += (v[r][j].x * w[j].x + v[r][j].y * w[j].y) + (v[r][j].z * w[j].z + v[r][j].w * w[j].w);
                a[r][p] = t; } }
        float d[4], ss[4];
#pragma unroll
        for (int r = 0; r < 4; ++r) { float s = 0.f;
#pragma unroll
            for (int j = 0; j < 4; ++j) s += (v[r][j].x * v[r][j].x + v[r][j].y * v[r][j].y) + (v[r][j].z * v[r][j].z + v[r][j].w * v[r][j].w);
            ss[r] = s; }
#pragma unroll
        for (int r = 0; r < 4; ++r) { float b4[4], c2[2];
#pragma unroll
            for (int k = 0; k < 4; ++k) { const float snd = up1 ? a[r][k] : a[r][k + 4], kept = up1 ? a[r][k + 4] : a[r][k]; b4[k] = kept + __shfl_xor(snd, 1); }
#pragma unroll
            for (int k = 0; k < 2; ++k) { const float snd = up2 ? b4[k] : b4[k + 2], kept = up2 ? b4[k + 2] : b4[k]; c2[k] = kept + __shfl_xor(snd, 2); }
            { const float snd = up4 ? c2[0] : c2[1], kept = up4 ? c2[1] : c2[0]; d[r] = kept + __shfl_xor(snd, 4); } }
#pragma unroll
        for (int o = 8; o < 64; o <<= 1) {
#pragma unroll
            for (int r = 0; r < 4; ++r) d[r] += __shfl_xor(d[r], o); }
#pragma unroll
        for (int o = 1; o < 64; o <<= 1) {
#pragma unroll
            for (int r = 0; r < 4; ++r) ss[r] += __shfl_xor(ss[r], o); }
#pragma unroll
        for (int r = 0; r < 4; ++r) {
            const int m = rbase + 4 * g + r;
            const float rs = 1.0f / __builtin_sqrtf(ss[r] * (1.0f / D) + RMS_EPS);
            GAS unsigned* o4 = (GAS unsigned*)(HN8 + (size_t)m * D) + F.lane;
#pragma unroll
            for (int j = 0; j < 4; ++j) { const f32x4 h = v[r][j] * rs * gv[j]; o4[64 * j] = pack4_fp8(h.x, h.y, h.z, h.w, hs); }
            float lg[8];
#pragma unroll
            for (int p = 0; p < 8; ++p) lg[p] = __shfl(d[r], (p >> 2) | (((p >> 1) & 1) << 1) | ((p & 1) << 2)) * rs;
            int i1 = 0; float l1 = lg[0];
#pragma unroll
            for (int p = 1; p < 8; ++p) if (lg[p] > l1) { l1 = lg[p]; i1 = p; }
            int i2 = (i1 == 0) ? 1 : 0; float l2 = (i1 == 0) ? lg[1] : lg[0];
#pragma unroll
            for (int p = 1; p < 8; ++p) if (p != i1 && lg[p] > l2) { l2 = lg[p]; i2 = p; }
            const float w1 = 1.0f / (1.0f + __expf(l2 - l1)), w2 = 1.0f - w1;
            if (F.lane == 0) { TOPE[m] = (unsigned)i1 | ((unsigned)i2 << 8); TOPW[2 * (size_t)m] = w1; TOPW[2 * (size_t)m + 1] = w2;
                atomicAdd((int*)&cnts[i1], 1); atomicAdd((int*)&cnts[8 + i2], 1); }
        }
    }
    __syncthreads(); if (F.tid < 16) CNT[F.bx * 16 + F.tid] = (unsigned)cnts[F.tid];
    __syncthreads();
}

__device__ __forceinline__ void split3(float v, unsigned& w01, unsigned& w2) {
    const unsigned t0 = f2bf(v); const float r1 = v - __builtin_bit_cast(float, t0 << 16);
    const unsigned t1 = f2bf(r1); const float r2 = r1 - __builtin_bit_cast(float, t1 << 16);
    w01 = t0 | (t1 << 16); w2 = f2bf(r2);
}
__device__ __forceinline__ void cumsum_phase(Frame& F, const float* LOGF, float* F2, int* T0, bf16* QX, bf16* KX, const float* qg, const float* kg) {
    if (F.bx >= BATCH * NH) return;
    const int b = F.bx >> 4, h = F.bx & 15;
    LAS float* sh = (LAS float*)(F.lds);
    LAS float* Fls = (LAS float*)(F.lds + 1024);
    float mq = fabsf(qg[F.lane]), mk = fabsf(kg[F.lane]);
#pragma unroll
    for (int o = 1; o < 64; o <<= 1) { mq = fmaxf(mq, __shfl_xor(mq, o)); mk = fmaxf(mk, __shfl_xor(mk, o)); }
    const float mfix = 8.0f * mq * mk * LOG2E * 1.02f;
    float v[16]; float run = 0.f;
#pragma unroll
    for (int k = 0; k < 16; ++k) { run += LOGF[((size_t)b * SEQ + 16 * F.tid + k) * 16 + h]; v[k] = run; }
    float inc = run;
#pragma unroll
    for (int o = 1; o < 64; o <<= 1) { const float t = __shfl_up(inc, o); if (F.lane >= o) inc += t; }
    if (F.lane == 63) sh[F.wave] = inc;
    __syncthreads();
    float pre = inc - run;
    for (int w = 0; w < F.wave; ++w) pre += sh[w];
    float* o = F2 + (size_t)F.bx * SEQ + 16 * F.tid;
    v4u* qx = (v4u*)(QX + ((size_t)F.bx * SEQ + 16 * F.tid) * 8); v4u* kx = (v4u*)(KX + ((size_t)F.bx * SEQ + 16 * F.tid) * 16);
#pragma unroll
    for (int k = 0; k < 16; k += 4) { const f32x4 q = (f32x4){(pre + v[k]) * LOG2E, (pre + v[k + 1]) * LOG2E, (pre + v[k + 2]) * LOG2E, (pre + v[k + 3]) * LOG2E};
        *(f32x4*)(o + k) = q; *(LAS f32x4*)(Fls + 16 * F.tid + k) = q;
#pragma unroll
        for (int e = 0; e < 4; ++e) { unsigned a01, a2, b01, b2; split3(q[e] - mfix, a01, a2); split3(-q[e], b01, b2);
            qx[k + e] = (v4u){a01, a2 | 0x3f800000u, 0x3f803f80u, 0u};
            kx[2 * (k + e)] = (v4u){0x3f803f80u, 0x3f80u | (b01 << 16), (b01 >> 16) | (b2 << 16), 0u};
            kx[2 * (k + e) + 1] = (v4u){0u, 0u, 0u, 0u}; } }
    __syncthreads();
    if (F.tid < 32) { const int qb = F.tid; const float target = Fls[256 * qb] + SKIP_THR; int lo_ = 0, hi_ = 4 * qb;
        while (lo_ < hi_) { const int mid = (lo_ + hi_) >> 1; if (Fls[64 * mid + 63] <= target) hi_ = mid; else lo_ = mid + 1; }
        T0[F.bx * 32 + qb] = lo_; }
    __syncthreads();
}

__device__ __forceinline__ void conv_phase(Frame& F, const bf16* XB, const float* cw, const float* cb, bf16* XC) {
    const int gt = F.bx * (NWAVES * 64) + F.tid, cg = gt & 127, c0 = cg * 8;
    float w[4][8], bias[8];
#pragma unroll
    for (int j = 0; j < 4; ++j)
#pragma unroll
        for (int c = 0; c < 8; ++c) w[j][c] = cw[j * D + c0 + c];
#pragma unroll
    for (int c = 0; c < 8; ++c) bias[c] = cb[c0 + c];
    const int nchunk_threads = (F.G * NWAVES * 64) >> 7;
    for (int chunk = gt >> 7; chunk < T / 16; chunk += nchunk_threads) {
        const int t0 = chunk * 16, s0 = t0 & (SEQ - 1);
        float xw[3][8];
#pragma unroll
        for (int r = 0; r < 3; ++r) {
            if (s0 == 0) {
#pragma unroll
                for (int c = 0; c < 8; ++c) xw[r][c] = 0.f;
            } else { const v4u q = *(const v4u*)(XB + (size_t)(t0 - 3 + r) * D + c0);
                xw[r][0] = bflo(q.x); xw[r][1] = bfhi(q.x); xw[r][2] = bflo(q.y); xw[r][3] = bfhi(q.y); xw[r][4] = bflo(q.z); xw[r][5] = bfhi(q.z); xw[r][6] = bflo(q.w); xw[r][7] = bfhi(q.w); }
        }
        v4u qr[16];
#pragma unroll
        for (int i = 0; i < 16; ++i) qr[i] = *(const v4u*)(XB + (size_t)(t0 + i) * D + c0);
#pragma unroll
        for (int i = 0; i < 16; ++i) {
            const v4u q = qr[i];
            float x3[8] = {bflo(q.x), bfhi(q.x), bflo(q.y), bfhi(q.y), bflo(q.z), bfhi(q.z), bflo(q.w), bfhi(q.w)};
            float o[8];
#pragma unroll
            for (int c = 0; c < 8; ++c) o[c] = bias[c] + w[0][c] * xw[0][c] + w[1][c] * xw[1][c] + w[2][c] * xw[2][c] + w[3][c] * x3[c];
            v4u ov; ov.x = pk2(o[0], o[1]); ov.y = pk2(o[2], o[3]); ov.z = pk2(o[4], o[5]); ov.w = pk2(o[6], o[7]);
            *(v4u*)(XC + (size_t)(t0 + i) * D + c0) = ov;
#pragma unroll
            for (int c = 0; c < 8; ++c) { xw[0][c] = xw[1][c]; xw[1][c] = xw[2][c]; xw[2][c] = x3[c]; }
        }
    }
}

constexpr int SCH = 128, NCH = SEQ / SCH;
__device__ __forceinline__ void scan_agg_phase(Frame& F, const unsigned* AB, float* AGG) {
    for (int item = F.bx; item < BATCH * NCH; item += F.G) {
        const size_t t0 = (size_t)item * SCH; const int ch = 2 * F.tid;
        float h0 = 0.f, h1 = 0.f, A0 = 1.f, A1 = 1.f;
        const unsigned* p = AB + t0 * D + ch;
        v2u qa[8], qb[8];
#pragma unroll
        for (int k = 0; k < 8; ++k) qa[k] = *(const v2u*)(p + (size_t)k * D);
        for (int t = 0; t < SCH; t += 16) {
#pragma unroll
            for (int k = 0; k < 8; ++k) qb[k] = *(const v2u*)(p + (size_t)(t + 8 + k) * D);
#pragma unroll
            for (int k = 0; k < 8; ++k) { const float a0 = fast_exp2(bfhi(qa[k].x)), a1 = fast_exp2(bfhi(qa[k].y));
                h0 = a0 * h0 + bflo(qa[k].x); h1 = a1 * h1 + bflo(qa[k].y); A0 *= a0; A1 *= a1; }
            if (t + 16 < SCH) {
#pragma unroll
                for (int k = 0; k < 8; ++k) qa[k] = *(const v2u*)(p + (size_t)(t + 16 + k) * D); }
#pragma unroll
            for (int k = 0; k < 8; ++k) { const float a0 = fast_exp2(bfhi(qb[k].x)), a1 = fast_exp2(bfhi(qb[k].y));
                h0 = a0 * h0 + bflo(qb[k].x); h1 = a1 * h1 + bflo(qb[k].y); A0 *= a0; A1 *= a1; }
        }
        *(f32x4*)(AGG + ((size_t)item * D + ch) * 2) = (f32x4){A0, h0, A1, h1};
    }
}
__device__ __forceinline__ void scan_out_phase(Frame& F, const unsigned* AB, const float* AGG, const bf16* Y, bf16* HY) {
    for (int item = F.bx; item < BATCH * NCH; item += F.G) {
        const int c = item & (NCH - 1); const size_t t0 = (size_t)item * SCH; const int ch = 2 * F.tid;
        float h0 = 0.f, h1 = 0.f;
        const float* ag = AGG + ((size_t)(item - c) * D + ch) * 2;
        const unsigned* p = AB + t0 * D + ch; const bf16* yp = Y + t0 * D + ch; bf16* op = HY + t0 * D + ch;
        v2u qa[8], qb[8]; unsigned ya[8], yb[8];
#pragma unroll
        for (int k = 0; k < 8; ++k) { qa[k] = *(const v2u*)(p + (size_t)k * D); ya[k] = *(const unsigned*)(yp + (size_t)k * D); }
        { int cc = 0;
          for (; cc + 8 <= c; cc += 8) { f32x4 g[8];
#pragma unroll
              for (int k = 0; k < 8; ++k) g[k] = *(const f32x4*)(ag + (size_t)(cc + k) * D * 2);
#pragma unroll
              for (int k = 0; k < 8; ++k) { h0 = g[k].x * h0 + g[k].y; h1 = g[k].z * h1 + g[k].w; } }
          for (; cc < c; ++cc) { const f32x4 g = *(const f32x4*)(ag + (size_t)cc * D * 2); h0 = g.x * h0 + g.y; h1 = g.z * h1 + g.w; } }
        for (int t = 0; t < SCH; t += 16) {
#pragma unroll
            for (int k = 0; k < 8; ++k) { qb[k] = *(const v2u*)(p + (size_t)(t + 8 + k) * D); yb[k] = *(const unsigned*)(yp + (size_t)(t + 8 + k) * D); }
            unsigned oa[8];
#pragma unroll
            for (int k = 0; k < 8; ++k) { const float a0 = fast_exp2(bfhi(qa[k].x)), a1 = fast_exp2(bfhi(qa[k].y));
                h0 = a0 * h0 + bflo(qa[k].x); h1 = a1 * h1 + bflo(qa[k].y); oa[k] = pk2(h0 * bflo(ya[k]), h1 * bfhi(ya[k])); }
            if (t + 16 < SCH) {
#pragma unroll
                for (int k = 0; k < 8; ++k) { qa[k] = *(const v2u*)(p + (size_t)(t + 16 + k) * D); ya[k] = *(const unsigned*)(yp + (size_t)(t + 16 + k) * D); } }
#pragma unroll
            for (int k = 0; k < 8; ++k) *(unsigned*)(op + (size_t)(t + k) * D) = oa[k];
#pragma unroll
            for (int k = 0; k < 8; ++k) { const float a0 = fast_exp2(bfhi(qb[k].x)), a1 = fast_exp2(bfhi(qb[k].y));
                h0 = a0 * h0 + bflo(qb[k].x); h1 = a1 * h1 + bflo(qb[k].y); oa[k] = pk2(h0 * bflo(yb[k]), h1 * bfhi(yb[k])); }
#pragma unroll
            for (int k = 0; k < 8; ++k) *(unsigned*)(op + (size_t)(t + 8 + k) * D) = oa[k];
        }
    }
}

__device__ __forceinline__ void moe_build_phase(Frame& F, const unsigned* TOPE, const float* TOPW, unsigned* CNT, unsigned* LIST, float* LISTW, unsigned* TILE, unsigned* NTL) {
    LAS int* sh = (LAS int*)(F.lds);
    const int bx = F.bx;
    { const int slot = F.tid & 15, grp = F.tid >> 4; int tot = 0, off = 0;
      for (int c = grp; c < F.G; c += 32) { const int v = (int)__hip_atomic_load(CNT + c * 16 + slot, RLX_AGENT); if (c < bx) off += v; tot += v; }
      sh[128 + grp * 16 + slot] = tot; sh[128 + 512 + grp * 16 + slot] = off; }
    __syncthreads();
    if (F.tid < 16) { int tot = 0, off = 0; for (int g2 = 0; g2 < 32; ++g2) { tot += sh[128 + g2 * 16 + F.tid]; off += sh[128 + 512 + g2 * 16 + F.tid]; } sh[F.tid] = tot; sh[16 + F.tid] = off; }
    __syncthreads();
    if (F.tid < 2) { const int p = F.tid; int a = 0; for (int e = 0; e < 8; ++e) { sh[32 + p * 8 + e] = a; a += (sh[p * 8 + e] + 255) & ~255; } sh[48 + p] = a >> 8; }
    __syncthreads();
    const int p = F.tid >> 8, i = F.tid & 255, t = bx * 256 + i;
    const unsigned te = TOPE[t]; const int e = (int)((te >> (8 * p)) & 0xffu); const float w = TOPW[2 * (size_t)t + p];
    int rank = 0;
    const unsigned long long lt = (F.lane == 0) ? 0ull : (~0ull >> (64 - F.lane));
#pragma unroll
    for (int ee = 0; ee < 8; ++ee) { const unsigned long long mk = __ballot(e == ee); if (e == ee) rank = __popcll(mk & lt); if (F.lane == 0) sh[64 + F.wave * 8 + ee] = __popcll(mk); }
    __syncthreads();
    int wpre = 0; for (int w2 = (F.wave & 4); w2 < F.wave; ++w2) wpre += sh[64 + w2 * 8 + e];
    const int pos = sh[32 + p * 8 + e] + sh[16 + p * 8 + e] + wpre + rank;
    LIST[(size_t)p * LISTCAP + pos] = (unsigned)t | 0x80000000u; LISTW[(size_t)p * LISTCAP + pos] = w;
    if (bx < 16) { const int pp = bx >> 3, ee = bx & 7; const int st = sh[32 + pp * 8 + ee], n = sh[pp * 8 + ee], cap = (n + 255) & ~255;
        for (int k = n + F.tid; k < cap; k += NWAVES * 64) { LIST[(size_t)pp * LISTCAP + st + k] = 0u; LISTW[(size_t)pp * LISTCAP + st + k] = 0.f; }
        for (int k = F.tid; k < (cap >> 8); k += NWAVES * 64) TILE[pp * 272 + (st >> 8) + k] = (unsigned)ee;
        if (ee == 0 && F.tid == 0) NTL[pp] = (unsigned)sh[48 + pp]; }
    __syncthreads();
}

namespace fa {
constexpr int KSLOT = 10240, VSLOT = 8192, NKS = 4, NVS = 3;
constexpr int L_K = 0, L_V = NKS * KSLOT, L_WS = L_V + NVS * VSLOT, L_OST = L_WS + NWAVES * 256, L_END = L_OST + NWAVES * 4096;
__device__ __forceinline__ int crow(int r, int hi) { return (r & 3) + 8 * (r >> 2) + 4 * hi; }
__device__ __forceinline__ void glds16(const void* gsrc, unsigned lds_dst) { unsigned keep;
    asm volatile("s_mov_b32 %0, m0\n\ts_mov_b32 m0, %2\n\ts_nop 0\n\tglobal_load_lds_dwordx4 %1, off\n\ts_mov_b32 m0, %0" : "=&s"(keep) : "v"(gsrc), "s"(lds_dst) : "memory"); }
__device__ __forceinline__ void glds16s(const void* sbase, unsigned voff, unsigned lds_dst) { unsigned keep;
    asm volatile("s_mov_b32 %0, m0\n\ts_mov_b32 m0, %3\n\ts_nop 0\n\tglobal_load_lds_dwordx4 %1, %2\n\ts_mov_b32 m0, %0" : "=&s"(keep) : "v"(voff), "s"(sbase), "s"(lds_dst) : "memory"); }
__device__ __forceinline__ void glds4(const void* gsrc, unsigned lds_dst) { unsigned keep;
    asm volatile("s_mov_b32 %0, m0\n\ts_mov_b32 m0, %2\n\ts_nop 0\n\tglobal_load_lds_dword %1, off\n\ts_mov_b32 m0, %0" : "=&s"(keep) : "v"(gsrc), "s"(lds_dst) : "memory"); }
#define FA_WAIT_BAR() asm volatile("s_waitcnt vmcnt(0) lgkmcnt(0)\n\ts_barrier" ::: "memory")

__device__ __forceinline__ void qkt(f32x16& p0, f32x16& p1, const LAS unsigned char* kb, const bf16x8 (&qr)[5]) {
    p0 = f32x16{}; p1 = f32x16{};
#pragma unroll
    for (int d0 = 0; d0 < 5; ++d0) {
        const bf16x8 b0 = *(const LAS bf16x8*)(kb + d0 * 2048);
        const bf16x8 b1 = *(const LAS bf16x8*)(kb + d0 * 2048 + 512);
        p0 = __builtin_amdgcn_mfma_f32_32x32x16_bf16(b0, qr[d0], p0, 0, 0, 0); p1 = __builtin_amdgcn_mfma_f32_32x32x16_bf16(b1, qr[d0], p1, 0, 0, 0); }
}

__device__ __forceinline__ void attn_unit(int b, int h, int qb, const bf16* Q, const bf16* K, const bf16* V, const bf16* Gt, bf16* O, const bf16* QX, const bf16* KX, LAS unsigned char* lds, unsigned lds0, int tid, int t0, gu32* qhead, LAS unsigned* uq) {
    const int lane = tid & 63, r32 = lane & 31, hi = lane >> 5; const int wid = __builtin_amdgcn_readfirstlane(tid >> 6);
    const size_t rowbase = (size_t)b * SEQ; const int q0 = qb * 256; const int bh = b * NH + h;
    const bf16* Qw = Q + (rowbase + q0 + wid * 32) * D + h * HD;
    const bf16* Kh = K + rowbase * D + h * HD; const bf16* Vh = V + rowbase * D + h * HD;
    const int NT = (q0 + 256) / 64;
    t0 -= (NT - t0) & 1;
    const bf16* ksrc = Kh + (size_t)lane * D + wid * 8;
    const bf16* vsrc = Vh + (size_t)(16 * (wid & 3) + (lane >> 2)) * D + (wid >> 2) * 32 + (lane & 3) * 8;
    const bf16* xsrc = KX + ((size_t)bh * SEQ + lane) * 16 + (wid & 1) * 8;
    const unsigned kdst = lds0 + L_K + wid * 1024, vdst = lds0 + L_V + wid * 1024, xdst = lds0 + L_K + 8192 + (wid & 1) * 1024;
#define FA_DMAK(t_) do { const int sk_ = ((t_) % NKS); \
        glds16(ksrc + (size_t)(t_) * 64 * D, (unsigned)__builtin_amdgcn_readfirstlane((int)(kdst + sk_ * KSLOT))); \
        if (wid < 2) glds16(xsrc + (size_t)(t_) * 64 * 16, (unsigned)__builtin_amdgcn_readfirstlane((int)(xdst + sk_ * KSLOT))); } while (0)
#define FA_DMAV(t_) do { const int sv_ = ((t_) % NVS); \
        glds16(vsrc + (size_t)(t_) * 64 * D, (unsigned)__builtin_amdgcn_readfirstlane((int)(vdst + sv_ * VSLOT))); } while (0)
    FA_DMAK(t0); FA_DMAV(t0);
    if (t0 + 1 < NT) FA_DMAK(t0 + 1);
    if (t0 + 2 < NT) FA_DMAK(t0 + 2);
    bf16x8 qr[5];
#pragma unroll
    for (int d0 = 0; d0 < 4; ++d0) qr[d0] = *(const bf16x8*)(Qw + (size_t)r32 * D + d0 * 16 + hi * 8);
    { const bf16x8 qx = *(const bf16x8*)(QX + ((size_t)bh * SEQ + q0 + wid * 32 + r32) * 8); qr[4] = hi ? (bf16x8){0, 0, 0, 0, 0, 0, 0, 0} : qx; }
    f32x16 o[2]; o[0] = f32x16{}; o[1] = f32x16{};
    float lsum = 0.f;
    const int qrel = wid * 32 + r32;
    const LAS unsigned char* kbase = lds + L_K + hi * 1024 + r32 * 16;
    const LAS unsigned char* vbp = lds + L_V + ((lane >> 4) & 1) * 32 + (lane & 3) * 8 + (4 * hi + ((lane & 15) >> 2)) * 64;
    FA_WAIT_BAR();
#define FA_SB() __builtin_amdgcn_sched_barrier(0)
#define FA_EX4(P, B) do { P[B] = fast_exp2(P[B]); P[B + 1] = fast_exp2(P[B + 1]); P[B + 2] = fast_exp2(P[B + 2]); P[B + 3] = fast_exp2(P[B + 3]); asm volatile("" : "+v"(P)); } while (0)
#define FA_KLD(j, T_) do { const LAS unsigned char* kb_ = kbase + ((T_) % NKS) * KSLOT; kf[2 * (j)] = *(const LAS bf16x8*)(kb_ + (j) * 2048); kf[2 * (j) + 1] = *(const LAS bf16x8*)(kb_ + (j) * 2048 + 512); } while (0)
#define FA_MASK(C0, C1, T_) do { if ((T_) >= NT - 4) { const int kb2_ = 64 * (T_) - q0 + 4 * hi; \
        _Pragma("unroll") for (int r = 0; r < 16; ++r) { const int kv = kb2_ + (r & 3) + 8 * (r >> 2); if (kv > qrel) C0[r] = -INFINITY; if (kv + 32 > qrel) C1[r] = -INFINITY; } } } while (0)
#define FA_VRD(i, VB) do { lo[i] = __builtin_bit_cast(s16x4, __builtin_amdgcn_ds_read_tr16_b64_v4i16((LAS s16x4*)((VB) + ((i) >> 2) * 4096 + ((i) & 3) * 1024))); \
        hh[i] = __builtin_bit_cast(s16x4, __builtin_amdgcn_ds_read_tr16_b64_v4i16((LAS s16x4*)((VB) + ((i) >> 2) * 4096 + ((i) & 3) * 1024 + 512))); } while (0)
#define FA_PK(k) (bf16x8){lo[k][0], lo[k][1], lo[k][2], lo[k][3], hh[k][0], hh[k][1], hh[k][2], hh[k][3]}
#define FA_AD4(P, B) do { sacc += (P[B] + P[B + 1]) + (P[B + 2] + P[B + 3]); asm volatile("" : "+v"(sacc)); } while (0)
#define FA_ENDWAIT(T_) do { const int nfl_ = (((T_) + 3 < NT) ? ((wid < 2) ? 2 : 1) : 0) + (((T_) + 1 < NT) ? 1 : 0); \
        if (nfl_ == 3) asm volatile("s_waitcnt vmcnt(3) lgkmcnt(0)\n\ts_barrier" ::: "memory"); \
        else if (nfl_ == 2) asm volatile("s_waitcnt vmcnt(2) lgkmcnt(0)\n\ts_barrier" ::: "memory"); \
        else if (nfl_ == 1) asm volatile("s_waitcnt vmcnt(1) lgkmcnt(0)\n\ts_barrier" ::: "memory"); \
        else FA_WAIT_BAR(); } while (0)
    bf16x8 kf[10];
    f32x16 c0, c1;
    s16x4 lo[8], hh[8]; v4u pw0, pw1, pw2, pw3;
    {
#pragma unroll
        for (int j = 0; j < 5; ++j) FA_KLD(j, t0);
        c0 = f32x16{}; c1 = f32x16{};
#pragma unroll
        for (int d0 = 0; d0 < 5; ++d0) { c0 = __builtin_amdgcn_mfma_f32_32x32x16_bf16(kf[2 * d0], qr[d0], c0, 0, 0, 0); c1 = __builtin_amdgcn_mfma_f32_32x32x16_bf16(kf[2 * d0 + 1], qr[d0], c1, 0, 0, 0); }
        FA_SB();
        if (t0 + 3 < NT) FA_DMAK(t0 + 3);
        if (t0 + 1 < NT) FA_DMAV(t0 + 1);
        FA_MASK(c0, c1, t0);
        FA_EX4(c0, 0); FA_EX4(c0, 4); FA_EX4(c0, 8); FA_EX4(c0, 12); FA_EX4(c1, 0); FA_EX4(c1, 4); FA_EX4(c1, 8); FA_EX4(c1, 12);
        if (t0 + 1 < NT) {
#pragma unroll
            for (int j = 0; j < 3; ++j) FA_KLD(j, t0 + 1);
        }
        FA_SB(); FA_ENDWAIT(t0); FA_SB();
    }
#define FA_STEP(T_, C0, C1, P0, P1) do { \
        const LAS unsigned char* vb = vbp + (((T_) - 1) % NVS) * VSLOT; \
        float sacc = 0.f; \
        FA_VRD(0, vb); FA_SB(); C0 = __builtin_amdgcn_mfma_f32_32x32x16_bf16(kf[0], qr[0], f32x16{}, 0, 0, 0); FA_AD4(P0, 0); pw0.x = cvt_pk_bf16(P0[0], P0[1]); pw0.y = cvt_pk_bf16(P0[2], P0[3]); FA_SB(); \
        FA_VRD(4, vb); FA_SB(); C1 = __builtin_amdgcn_mfma_f32_32x32x16_bf16(kf[1], qr[0], f32x16{}, 0, 0, 0); FA_AD4(P0, 4); pw0.z = cvt_pk_bf16(P0[4], P0[5]); pw0.w = cvt_pk_bf16(P0[6], P0[7]); FA_SB(); \
        FA_KLD(3, (T_)); FA_SB(); \
        FA_VRD(1, vb); FA_SB(); C0 = __builtin_amdgcn_mfma_f32_32x32x16_bf16(kf[2], qr[1], C0, 0, 0, 0); FA_AD4(P0, 8); pw1.x = cvt_pk_bf16(P0[8], P0[9]); pw1.y = cvt_pk_bf16(P0[10], P0[11]); FA_SB(); \
        FA_VRD(5, vb); FA_SB(); C1 = __builtin_amdgcn_mfma_f32_32x32x16_bf16(kf[3], qr[1], C1, 0, 0, 0); FA_AD4(P0, 12); pw1.z = cvt_pk_bf16(P0[12], P0[13]); pw1.w = cvt_pk_bf16(P0[14], P0[15]); FA_SB(); \
        FA_KLD(4, (T_)); FA_SB(); \
        FA_VRD(2, vb); FA_SB(); C0 = __builtin_amdgcn_mfma_f32_32x32x16_bf16(kf[4], qr[2], C0, 0, 0, 0); FA_AD4(P1, 0); pw2.x = cvt_pk_bf16(P1[0], P1[1]); pw2.y = cvt_pk_bf16(P1[2], P1[3]); FA_SB(); \
        FA_VRD(6, vb); FA_SB(); C1 = __builtin_amdgcn_mfma_f32_32x32x16_bf16(kf[5], qr[2], C1, 0, 0, 0); FA_AD4(P1, 4); pw2.z = cvt_pk_bf16(P1[4], P1[5]); pw2.w = cvt_pk_bf16(P1[6], P1[7]); FA_SB(); \
        FA_VRD(3, vb); FA_SB(); C0 = __builtin_amdgcn_mfma_f32_32x32x16_bf16(kf[6], qr[3], C0, 0, 0, 0); FA_AD4(P1, 8); pw3.x = cvt_pk_bf16(P1[8], P1[9]); pw3.y = cvt_pk_bf16(P1[10], P1[11]); FA_SB(); \
        FA_VRD(7, vb); FA_SB(); C1 = __builtin_amdgcn_mfma_f32_32x32x16_bf16(kf[7], qr[3], C1, 0, 0, 0); FA_AD4(P1, 12); pw3.z = cvt_pk_bf16(P1[12], P1[13]); pw3.w = cvt_pk_bf16(P1[14], P1[15]); FA_SB(); \
        C0 = __builtin_amdgcn_mfma_f32_32x32x16_bf16(kf[8], qr[4], C0, 0, 0, 0); \
        C1 = __builtin_amdgcn_mfma_f32_32x32x16_bf16(kf[9], qr[4], C1, 0, 0, 0); FA_SB(); \
        lsum += sacc; \
        if ((T_) + 3 < NT) FA_DMAK((T_) + 3); \
        if ((T_) + 1 < NT) FA_DMAV((T_) + 1); \
        FA_MASK(C0, C1, (T_)); \
        FA_SB(); \
        const bool more = ((T_) + 1 < NT); \
        o[0] = __builtin_amdgcn_mfma_f32_32x32x16_bf16(__builtin_bit_cast(bf16x8, pw0), FA_PK(0), o[0], 0, 0, 0); FA_EX4(C0, 0); FA_SB(); \
        o[1] = __builtin_amdgcn_mfma_f32_32x32x16_bf16(__builtin_bit_cast(bf16x8, pw0), FA_PK(4), o[1], 0, 0, 0); FA_EX4(C0, 4); FA_SB(); \
        if (more) FA_KLD(0, (T_) + 1); FA_SB(); \
        o[0] = __builtin_amdgcn_mfma_f32_32x32x16_bf16(__builtin_bit_cast(bf16x8, pw1), FA_PK(1), o[0], 0, 0, 0); FA_EX4(C0, 8); FA_SB(); \
        if (more) FA_KLD(1, (T_) + 1); FA_SB(); \
        o[1] = __builtin_amdgcn_mfma_f32_32x32x16_bf16(__builtin_bit_cast(bf16x8, pw1), FA_PK(5), o[1], 0, 0, 0); FA_EX4(C0, 12); FA_SB(); \
        if (more) FA_KLD(2, (T_) + 1); FA_SB(); \
        o[0] = __builtin_amdgcn_mfma_f32_32x32x16_bf16(__builtin_bit_cast(bf16x8, pw2), FA_PK(2), o[0], 0, 0, 0); FA_EX4(C1, 0); FA_SB(); \
        o[1] = __builtin_amdgcn_mfma_f32_32x32x16_bf16(__builtin_bit_cast(bf16x8, pw2), FA_PK(6), o[1], 0, 0, 0); FA_EX4(C1, 4); FA_SB(); \
        o[0] = __builtin_amdgcn_mfma_f32_32x32x16_bf16(__builtin_bit_cast(bf16x8, pw3), FA_PK(3), o[0], 0, 0, 0); FA_EX4(C1, 8); FA_SB(); \
        o[1] = __builtin_amdgcn_mfma_f32_32x32x16_bf16(__builtin_bit_cast(bf16x8, pw3), FA_PK(7), o[1], 0, 0, 0); FA_EX4(C1, 12); FA_SB(); \
        FA_ENDWAIT((T_)); FA_SB(); \
    } while (0)
    f32x16 d0, d1;
    int t = t0 + 1;
    FA_STEP(t, d0, d1, c0, c1); ++t;
    for (; t + 1 < NT; t += 2) { FA_STEP(t, c0, c1, d0, d1); FA_STEP(t + 1, d0, d1, c0, c1); }
#undef FA_STEP
    {
        const LAS unsigned char* vb = vbp + ((NT - 1) % NVS) * VSLOT;
#pragma unroll
        for (int i = 0; i < 8; ++i) FA_VRD(i, vb);
        float sacc = 0.f;
        FA_AD4(d0, 0); FA_AD4(d0, 4); FA_AD4(d0, 8); FA_AD4(d0, 12); FA_AD4(d1, 0); FA_AD4(d1, 4); FA_AD4(d1, 8); FA_AD4(d1, 12);
        lsum += sacc;
        pw0 = (v4u){cvt_pk_bf16(d0[0], d0[1]), cvt_pk_bf16(d0[2], d0[3]), cvt_pk_bf16(d0[4], d0[5]), cvt_pk_bf16(d0[6], d0[7])};
        pw1 = (v4u){cvt_pk_bf16(d0[8], d0[9]), cvt_pk_bf16(d0[10], d0[11]), cvt_pk_bf16(d0[12], d0[13]), cvt_pk_bf16(d0[14], d0[15])};
        pw2 = (v4u){cvt_pk_bf16(d1[0], d1[1]), cvt_pk_bf16(d1[2], d1[3]), cvt_pk_bf16(d1[4], d1[5]), cvt_pk_bf16(d1[6], d1[7])};
        pw3 = (v4u){cvt_pk_bf16(d1[8], d1[9]), cvt_pk_bf16(d1[10], d1[11]), cvt_pk_bf16(d1[12], d1[13]), cvt_pk_bf16(d1[14], d1[15])};
        FA_SB();
        o[0] = __builtin_amdgcn_mfma_f32_32x32x16_bf16(__builtin_bit_cast(bf16x8, pw0), FA_PK(0), o[0], 0, 0, 0);
        o[1] = __builtin_amdgcn_mfma_f32_32x32x16_bf16(__builtin_bit_cast(bf16x8, pw0), FA_PK(4), o[1], 0, 0, 0);
        o[0] = __builtin_amdgcn_mfma_f32_32x32x16_bf16(__builtin_bit_cast(bf16x8, pw1), FA_PK(1), o[0], 0, 0, 0);
        o[1] = __builtin_amdgcn_mfma_f32_32x32x16_bf16(__builtin_bit_cast(bf16x8, pw1), FA_PK(5), o[1], 0, 0, 0);
        o[0] = __builtin_amdgcn_mfma_f32_32x32x16_bf16(__builtin_bit_cast(bf16x8, pw2), FA_PK(2), o[0], 0, 0, 0);
        o[1] = __builtin_amdgcn_mfma_f32_32x32x16_bf16(__builtin_bit_cast(bf16x8, pw2), FA_PK(6), o[1], 0, 0, 0);
        o[0] = __builtin_amdgcn_mfma_f32_32x32x16_bf16(__builtin_bit_cast(bf16x8, pw3), FA_PK(3), o[0], 0, 0, 0);
        o[1] = __builtin_amdgcn_mfma_f32_32x32x16_bf16(__builtin_bit_cast(bf16x8, pw3), FA_PK(7), o[1], 0, 0, 0);
        FA_SB();
    }
#undef FA_SB
#undef FA_EX4
#undef FA_KLD
#undef FA_MASK
#undef FA_VRD
#undef FA_PK
#undef FA_AD4
#undef FA_ENDWAIT
#undef FA_DMAK
#undef FA_DMAV
    unsigned nxt_ticket = 0u; if (tid == 0) nxt_ticket = __hip_atomic_fetch_add(qhead, 1u, RLX_AGENT);
    bf16* Ow = O + (rowbase + q0 + wid * 32) * D + h * HD; const bf16* Gw = Gt + (rowbase + q0 + wid * 32) * D + h * HD;
    v4u gq4[4];
#pragma unroll
    for (int i = 0; i < 4; ++i) gq4[i] = *(const v4u*)(Gw + (size_t)(i * 8 + (lane >> 3)) * D + (lane & 7) * 8);
    { auto rr = __builtin_amdgcn_permlane32_swap(__float_as_uint(lsum), __float_as_uint(lsum), false, false); lsum = __uint_as_float(rr[0]) + __uint_as_float(rr[1]); }
    LAS float* wsf = (LAS float*)(lds + L_WS) + wid * 64;
    if (hi == 0) wsf[r32] = lsum;
    asm volatile("s_waitcnt lgkmcnt(0)" ::: "memory");
    float rli[16];
#pragma unroll
    for (int r = 0; r < 16; ++r) rli[r] = fast_rcp(wsf[crow(r, hi)]);
    LAS bf16* stg = (LAS bf16*)(lds + L_OST) + wid * 2048;
#pragma unroll
    for (int r = 0; r < 16; ++r) { const int orow = crow(r, hi);
#pragma unroll
        for (int d0 = 0; d0 < 2; ++d0) stg[orow * 64 + d0 * 32 + r32] = (bf16)f2bf(o[d0][r] * rli[r]); }
    asm volatile("s_waitcnt lgkmcnt(0)" ::: "memory");
#pragma unroll
    for (int i = 0; i < 4; ++i) { const int row = i * 8 + (lane >> 3), chn = lane & 7; const v4u v = *(const LAS v4u*)(stg + row * 64 + chn * 8); const v4u gq = gq4[i];
        v4u w; w.x = pk2(bflo(v.x) * bflo(gq.x), bfhi(v.x) * bfhi(gq.x)); w.y = pk2(bflo(v.y) * bflo(gq.y), bfhi(v.y) * bfhi(gq.y)); w.z = pk2(bflo(v.z) * bflo(gq.z), bfhi(v.z) * bfhi(gq.z)); w.w = pk2(bflo(v.w) * bflo(gq.w), bfhi(v.w) * bfhi(gq.w));
        *(v4u*)(Ow + (size_t)row * D + chn * 8) = w; }
    if (tid == 0) *uq = nxt_ticket;
    FA_WAIT_BAR();
}
}

__device__ __forceinline__ void attn_phase(Frame& F, const bf16* Q, const bf16* K, const bf16* V, const bf16* Gt, bf16* O, const bf16* QX, const bf16* KX, const int* T0, const float* bfv, gu32* qctr) {
    const unsigned lds0 = (unsigned)(uintptr_t)F.ldsg;
    int myrank = 99;
    if (F.lane < NH) { const float mine = bfv[F.lane]; myrank = 0; for (int h2 = 0; h2 < NH; ++h2) { const float o = bfv[h2]; myrank += (o > mine || (o == mine && h2 < F.lane)) ? 1 : 0; } }
    LAS unsigned* uq = (LAS unsigned*)(F.lds + fa::L_END);
    const int x0 = (int)(xb_xcc_id() & 7u);
    LAS int* t0tab = (LAS int*)(F.lds + fa::L_END + 64);
    for (int qi = 0; qi < BATCH; ++qi) {
        const int b = (x0 + qi) & (BATCH - 1);
        __syncthreads();
        t0tab[F.tid] = __hip_atomic_load(T0 + b * NH * 32 + F.tid, RLX_AGENT);
        if (F.tid == 0) *uq = __hip_atomic_fetch_add(qctr + b, 1u, RLX_AGENT);
        __syncthreads();
        for (;;) {
            const int u = __builtin_amdgcn_readfirstlane((int)*uq);
            if (u >= NH * 32) break;
            const int r = u >> 5, qb = 31 - (u & 31);
            const unsigned long long mk_ = __ballot(myrank == r);
            const int h = __builtin_amdgcn_readfirstlane((int)__builtin_ctzll(mk_));
            const int t0 = __builtin_amdgcn_readfirstlane(t0tab[h * 32 + qb]);
            fa::attn_unit(b, h, qb, Q, K, V, Gt, O, QX, KX, F.lds, lds0, F.tid, t0, qctr + b, uq);
        }
    }
}

constexpr int NPH_PAIR = 19, NPH = 2 * NPH_PAIR;
#define OPAQUE_S(x) asm volatile("" : "+s"(x))
__global__ void __launch_bounds__(NWAVES * 64, 2) trunk_fwd(Args args) {
    extern __shared__ __attribute__((aligned(16))) unsigned char lds_raw[];
    const int tid0 = threadIdx.x;
    volatile LAS unsigned* MISC = (volatile LAS unsigned*)((LAS unsigned char*)lds_raw + MISC_OFF);
    for (int u = tid0; u < (LDS_BYTES - RING_BYTES) / 4; u += NWAVES * 64) ((LAS unsigned*)((LAS unsigned char*)lds_raw + RING_BYTES))[u] = 0u;
    __syncthreads();
    const int lo = args.ph_lo, hi = args.ph_hi;
    const bool use_bar = (hi - lo) > 1;
    XcdBarrier bar; bar.bar = (unsigned*)(args.ws + WS_CTL) + CW_BAR; bar.x = 0; bar.st = nullptr;
    if (use_bar) bar = xcd_barrier_post((unsigned*)(args.ws + WS_CTL) + CW_BAR, MISC + 8);

#ifndef PROBE_NULL_EPI
#define PROBE_NULL_EPI 0
#endif
#ifndef PROBE_DUP_MASK
#define PROBE_DUP_MASK 0u
#endif
#define PHASE(k) (lo <= base + (k) && base + (k) < hi)
#define DUP(k) (((PROBE_DUP_MASK) >> (k)) & 1u)
#define PHASE_FOR(k) for (int rep_ = 0; rep_ < (PHASE(k) ? 1 + (int)DUP(k) : 0); ++rep_)
#define SEAM(k) do { if (PHASE(k) && base + (k) + 1 < hi) xcd_barrier(bar); } while (0)
#define PH_BEGIN if (rep_) xcd_barrier(bar); unsigned char* ws = args.ws; OPAQUE_S(ws); int bx = blockIdx.x; OPAQUE_S(bx); float* xo = args.out; OPAQUE_S(xo); \
        Frame F; { int t_ = threadIdx.x; asm volatile("" : "+v"(t_)); F.lds = (LAS unsigned char*)lds_raw; F.ldsg = lds_raw; F.tid = t_; F.lane = t_ & 63; F.wave = __builtin_amdgcn_readfirstlane(t_ >> 6); \
          F.G = gridDim.x; F.bx = bx; F.vcu = (F.G % 8 == 0) ? (bx % 8) * (F.G / 8) + bx / 8 : bx; } \
        unsigned char* act = ws + WS_ACT; unsigned char* wl = ws + WS_WL; unsigned char* wf = ws + WS_WF; unsigned char* small = ws + WS_SMALL; bf16* HN = (bf16*)(ws + WS_HN); (void)act; (void)wl; (void)wf; (void)small; (void)HN; (void)bx; (void)xo;

    for (int j = 0; j < 2; ++j) {
        const int base = j * NPH_PAIR;
        PHASE_FOR(0) { PH_BEGIN
            cvt_phase<false>(F, j, wl);
            { int isp = 0x3fffffff, csk = 0;
              if (CVT_OVERLAP && MOE_OVERLAP && j == 1 && FP8_LAST_MOE && FP8_MOE_J0) {
                  const int ntl1 = __builtin_amdgcn_readfirstlane((int)__hip_atomic_load((unsigned*)(small + SM_NT) + 1, RLX_AGENT));
                  const int ntail = ntl1 * (D / 256) - 4 * F.G, rnd = CVT_F_TOTAL / (F.G * NWAVES);
                  if (ntail > 0 && ntail <= F.G / 2 && rnd > 9) { isp = rnd - 9; csk = ntail; } }
              cvt_phase<true>(F, j, wf, isp, csk); }
            if (bx == 0) { float* C8 = (float*)(small + SM_C8); const float* ll = inp(10) + (size_t)j * D; for (int c = F.tid; c < D; c += NWAVES * 64) { const float L = ll[c]; C8[c] = 8.0f * LOG2E * log1pf(__expf(-L)); } }
            if (bx == 1) { bf16* Wf = (bf16*)(wf + WF_IN) + (size_t)4 * D * D; unsigned char* Wf8 = (unsigned char*)(wf + WF_IN) + (size_t)4 * D * D; const float* src = inp(12) + (size_t)j * D * (4 * D + NH) + 4 * D;
                const bool f8 = FP8_FOXIN_J1 && (j == 1 || FP8_FOXIN_J0);
                for (int k = F.tid; k < D; k += NWAVES * 64) { const f32x4* p = (const f32x4*)(src + (size_t)k * (4 * D + NH));
#pragma unroll
                    for (int q4 = 0; q4 < 4; ++q4) { const f32x4 v = p[q4];
#pragma unroll
                        for (int e = 0; e < 4; ++e) { if (f8) Wf8[(size_t)(4 * q4 + e) * D + k] = (unsigned char)(pack4_fp8(v[e], 0.f, 0.f, 0.f, 64.f) & 0xffu); else Wf[(size_t)(4 * q4 + e) * D + k] = (bf16)f2bf(v[e]); } } } }
            __syncthreads();
            if (j == 0) norm0_phase(F, inp(0), inp(1), HN, (xr_t*)xo);
        }
        SEAM(0);
        PHASE_FOR(1) { PH_BEGIN
            pg8::StaticOrder S; S.init(T / 256, 2 * D / 256, F.G, bx);
            pg8::EpiLruIn E{(bf16*)(act), (bf16*)(act + ACT_SLOT), (j == 0) ? (const float*)nullptr : (const float*)(ws + WS_SS) + 8 * (size_t)T};
            if (FP8_LRUIN_J1 && j == 1) {
                pg8::GemmT<false, false, true> g8{HN, (bf16*)(wl + WL_IN), D / 2, D / 2, D / 128, 0, (long)256 * (D / 2), nullptr, nullptr, 0, 0x7d7d7d7d, 0x79797979};
                pg8::gemm_phase<pg8::EpiLruIn, pg8::StaticOrder, pg8::GemmT<false, false, true>, true>(F.lds, g8, S, E);
            } else {
                pg8::GemmT<false, false> g{HN, (bf16*)(wl + WL_IN), D, D, D / 64, 0, (long)256 * D, nullptr, nullptr, 0};
                pg8::gemm_phase<pg8::EpiLruIn, pg8::StaticOrder, pg8::GemmT<false, false>, true>(F.lds, g, S, E);
            }
        }
        SEAM(1);
        PHASE_FOR(2) { PH_BEGIN
            conv_phase(F, (const bf16*)(act + ACT_SLOT), inp(4) + (size_t)j * 4 * D, inp(5) + (size_t)j * D, (bf16*)(act + 2 * ACT_SLOT)); }
        SEAM(2);
        PHASE_FOR(3) { PH_BEGIN
            bf16* XC = (bf16*)(act + 2 * ACT_SLOT);
            pg8::GemmT<false, false> g{XC, (bf16*)(wl + WL_G), D, 128, 2, 128, (long)256 * 128, nullptr, nullptr, 0};
            pg8::StaticOrder S; S.init(T / 256, 8, F.G, bx);
            pg8::EpiGate E{XC, inp(7) + (size_t)j * D, inp(9) + (size_t)j * D, (const float*)(small + SM_C8), (unsigned*)(act + 3 * ACT_SLOT)};
            pg8::gemm_phase<pg8::EpiGate, pg8::StaticOrder, pg8::GemmT<false, false>, true>(F.lds, g, S, E);
        }
        SEAM(3);
        PHASE_FOR(4) { PH_BEGIN scan_agg_phase(F, (const unsigned*)(act + 3 * ACT_SLOT), (float*)(ws + WS_AGG)); }
        SEAM(4);
        PHASE_FOR(5) { PH_BEGIN scan_out_phase(F, (const unsigned*)(act + 3 * ACT_SLOT), (const float*)(ws + WS_AGG), (const bf16*)(act), (bf16*)(act + ACT_SLOT)); }
        SEAM(5);
        PHASE_FOR(6) { PH_BEGIN
            pg8::GemmT<false, false> g{(bf16*)(act + ACT_SLOT), (bf16*)(wl + WL_OUT), D, D, D / 64, 0, (long)256 * D, nullptr, nullptr, 0};
            pg8::StaticOrder S; S.init(T / 256, D / 256, F.G, bx);
            pg8::EpiResid E{(const xr_t*)xo, (xr_t*)xo, inp(2) + (size_t)(2 * j) * D, HN, (float*)(ws + WS_SS), F.lds, (FP8_L2_FFN && j == 1) ? 4.f : 0.f};
            pg8::gemm_phase<pg8::EpiResid, pg8::StaticOrder, pg8::GemmT<false, false>, true>(F.lds, g, S, E);
        }
        SEAM(6);
        PHASE_FOR(7) { PH_BEGIN
            pg8::StaticOrder S; S.init(T / 256, 2 * FF / 256, F.G, bx);
            if (FP8_L2_FFN && j == 1) {
                pg8::GemmT<false, false, true> g8{HN, (bf16*)(wl + WL_W1), D / 2, D / 2, D / 128, 0, (long)256 * (D / 2), nullptr, nullptr, 0, 0x7d7d7d7d, 0x79797979};
                pg8::EpiSwiglu8 E8{(unsigned char*)(act), FF, 8.f, (const float*)(ws + WS_SS)};
                pg8::gemm_phase<pg8::EpiSwiglu8, pg8::StaticOrder, pg8::GemmT<false, false, true>, true>(F.lds, g8, S, E8);
            } else {
                pg8::GemmT<false, false> g{HN, (bf16*)(wl + WL_W1), D, D, D / 64, 0, (long)256 * D, nullptr, nullptr, 0};
                pg8::EpiSwiglu E{(bf16*)(act), FF, (const float*)(ws + WS_SS), ((EMU_FP8 >= 2 && j == 1) || EMU_FP8 >= 3) ? 8.f : 0.f};
                pg8::gemm_phase<pg8::EpiSwiglu, pg8::StaticOrder, pg8::GemmT<false, false>, true>(F.lds, g, S, E);
            }
        }
        SEAM(7);
        PHASE_FOR(8) { PH_BEGIN
            pg8::StaticOrder S; S.init(T / 256, D / 256, F.G, bx);
            pg8::EpiResid E{(const xr_t*)xo, (xr_t*)xo, inp(1) + (size_t)(2 * j + 1) * D, HN, (float*)(ws + WS_SS) + 4 * (size_t)T, F.lds, (FP8_FOXIN_J1 && (j == 1 || FP8_FOXIN_J0)) ? 4.f : 0.f};
            if (FP8_L2_FFN && j == 1) {
                pg8::GemmT<false, false, true> g8{(bf16*)(act), (bf16*)(wl + WL_W2), FF / 2, FF / 2, FF / 128, 0, (long)256 * (FF / 2), nullptr, nullptr, 0, 0x7c7c7c7c, 0x78787878};
                pg8::gemm_phase<pg8::EpiResid, pg8::StaticOrder, pg8::GemmT<false, false, true>, true>(F.lds, g8, S, E);
            } else {
                pg8::GemmT<false, false> g{(bf16*)(act), (bf16*)(wl + WL_W2), FF, FF, FF / 64, 0, (long)256 * FF, nullptr, nullptr, 0};
                pg8::gemm_phase<pg8::EpiResid, pg8::StaticOrder, pg8::GemmT<false, false>, true>(F.lds, g, S, E);
            }
        }
        SEAM(8);
        PHASE_FOR(9) { PH_BEGIN
            pg8::GemmT<false, false> g{HN, (bf16*)(wf + WF_IN), D, D, D / 64, 0, (long)256 * D, nullptr, nullptr, 0};
            pg8::StaticOrder S; S.init(T / 256, 4 * D / 256 + 1, F.G, bx);
            pg8::EpiFoxIn E{(bf16*)(act), (size_t)T * D, inp(14) + (size_t)j * HD, inp(15) + (size_t)j * HD, 0.125f * LOG2E, (const float*)(ws + WS_SS) + 4 * (size_t)T, inp(13) + (size_t)j * NH, (float*)(ws + WS_LOGF)};
#if PROBE_NULL_EPI
            if (rep_) { pg8::EpiNull E0{(float*)(ws + WS_AGG)}; pg8::gemm_phase<pg8::EpiNull, pg8::StaticOrder, pg8::GemmT<false, false>, true>(F.lds, g, S, E0); } else
#endif
            if (FP8_FOXIN_J1 && (j == 1 || FP8_FOXIN_J0)) {
                pg8::GemmT<false, false, true> g8{HN, (bf16*)(wf + WF_IN), D / 2, D / 2, D / 128, 0, (long)256 * (D / 2), nullptr, nullptr, 0, 0x7d7d7d7d, 0x79797979};
                pg8::gemm_phase<pg8::EpiFoxIn, pg8::StaticOrder, pg8::GemmT<false, false, true>, true>(F.lds, g8, S, E);
            } else
            pg8::gemm_phase<pg8::EpiFoxIn, pg8::StaticOrder, pg8::GemmT<false, false>, true>(F.lds, g, S, E);
        }
        SEAM(9);
        PHASE_FOR(10) { PH_BEGIN cumsum_phase(F, (const float*)(ws + WS_LOGF), (float*)(ws + WS_F2), (int*)(small + SM_T0), (bf16*)(act + 4 * ACT_SLOT + 32 * MiB), (bf16*)(act + 4 * ACT_SLOT), inp(14) + (size_t)j * HD, inp(15) + (size_t)j * HD); }
        SEAM(10);
        PHASE_FOR(11) { PH_BEGIN attn_phase(F, (const bf16*)(act), (const bf16*)(act + ACT_SLOT), (const bf16*)(act + 2 * ACT_SLOT), (const bf16*)(act + 3 * ACT_SLOT), HN, (const bf16*)(act + 4 * ACT_SLOT + 32 * MiB), (const bf16*)(act + 4 * ACT_SLOT), (const int*)(small + SM_T0), inp(13) + (size_t)j * NH, (gu32*)(ws + WS_CTL) + CW_QCTR + 64 * j + 16 * rep_); }
        SEAM(11);
        PHASE_FOR(12) { PH_BEGIN
            pg8::GemmT<false, false> g{HN, (bf16*)(wf + WF_OUT), D, D, D / 64, 0, (long)256 * D, nullptr, nullptr, 0};
            pg8::StaticOrder S; S.init(T / 256, D / 256, F.G, bx);
            pg8::EpiResid E{(const xr_t*)xo, (xr_t*)xo, nullptr, nullptr, nullptr, F.lds};
            pg8::gemm_phase<pg8::EpiResid, pg8::StaticOrder, pg8::GemmT<false, false>, true>(F.lds, g, S, E);
        }
        SEAM(12);
        PHASE_FOR(13) { PH_BEGIN
            if (FP8_LAST_MOE && (j == 1 || FP8_MOE_J0)) router_phase(F, (const xr_t*)xo, inp(2) + (size_t)(2 * j + 1) * D, (unsigned char*)HN, inp(20) + (size_t)j * D * NE, (unsigned*)(ws + WS_TOPE), (float*)(ws + WS_TOPW), (unsigned*)(small + SM_CNT), 4.f);
            else norm_phase<8, true>(F, xo, inp(2) + (size_t)(2 * j + 1) * D, HN, inp(20) + (size_t)j * D * NE, NE, nullptr, nullptr, (unsigned*)(ws + WS_TOPE), (float*)(ws + WS_TOPW), (unsigned*)(small + SM_CNT), (FP8_LAST_MOE && (j == 1 || FP8_MOE_J0)) ? -4.f : (((EMU_FP8 && j == 1) || EMU_FP8 >= 3) ? 4.f : 0.f)); }
        SEAM(13);
        PHASE_FOR(14) { PH_BEGIN moe_build_phase(F, (const unsigned*)(ws + WS_TOPE), (const float*)(ws + WS_TOPW), (unsigned*)(small + SM_CNT), (unsigned*)(ws + WS_LIST), (float*)(ws + WS_LISTW), (unsigned*)(small + SM_TILE) + j * 2 * 272, (unsigned*)(small + SM_NT) + j * 2); }
        SEAM(14);
#pragma unroll
        for (int p = 0; p < 2; ++p) {
            PHASE_FOR(15 + 2 * p) { PH_BEGIN
                unsigned* TILE = (unsigned*)(small + SM_TILE) + j * 2 * 272 + p * 272; unsigned* NTL = (unsigned*)(small + SM_NT) + j * 2 + p;
                const int ntl = __builtin_amdgcn_readfirstlane((int)__hip_atomic_load(NTL, RLX_AGENT));
                pg8::StaticOrder S; S.init(ntl, 2 * FF / 256, F.G, bx);
                if (FP8_LAST_MOE && (j == 1 || FP8_MOE_J0)) {
                    if (MOE_OVERLAP && p == 1) {
                        const int ntl0 = __builtin_amdgcn_readfirstlane((int)__hip_atomic_load((unsigned*)(small + SM_NT) + j * 2, RLX_AGENT));
                        const int ntail = ntl0 * (D / 256) - 4 * F.G, rnd = (ntl * (2 * FF / 256)) / F.G;
                        if (ntail > 0 && ntail <= F.G / 2 && rnd > 3) S.split(rnd - 3, ntail);
                    }
                    pg8::GemmT<true, true, true> g{HN, (bf16*)(wf + WF_W1), D / 2, D / 2, D / 128, 0, (long)256 * (D / 2), (const unsigned*)(ws + WS_LIST) + (size_t)p * LISTCAP, TILE, (long)2 * FF * (D / 2), 0x7d7d7d7d, 0x79797979};
                    pg8::EpiSwiglu8 E{(unsigned char*)(act) + (MOE_OVERLAP ? (size_t)p * LISTCAP * FF : (size_t)0), FF, 8.f};
                    pg8::gemm_phase<pg8::EpiSwiglu8, pg8::StaticOrder, pg8::GemmT<true, true, true>, true>(F.lds, g, S, E);
                } else {
                    pg8::GemmT<true, true> g{HN, (bf16*)(wf + WF_W1), D, D, D / 64, 0, (long)256 * D, (const unsigned*)(ws + WS_LIST) + (size_t)p * LISTCAP, TILE, (long)2 * FF * D};
                    pg8::EpiSwiglu E{(bf16*)(act), FF, nullptr, ((EMU_FP8 && j == 1) || EMU_FP8 >= 3) ? 8.f : 0.f};
                    pg8::gemm_phase<pg8::EpiSwiglu, pg8::StaticOrder, pg8::GemmT<true, true>, true>(F.lds, g, S, E);
                }
            }
            SEAM(15 + 2 * p);
            PHASE_FOR(16 + 2 * p) { PH_BEGIN
                unsigned* TILE = (unsigned*)(small + SM_TILE) + j * 2 * 272 + p * 272; unsigned* NTL = (unsigned*)(small + SM_NT) + j * 2 + p;
                const int ntl = __builtin_amdgcn_readfirstlane((int)__hip_atomic_load(NTL, RLX_AGENT));
                pg8::StaticOrder S; S.init(ntl, D / 256, F.G, bx);
                const bool fuse = (p == 1) && (j == 0);
                xr_t* XR2 = (xr_t*)(act + 480 * MiB);
                pg8::EpiScatter E{(j == 1 && p == 1) ? (const xr_t*)XR2 : (const xr_t*)xo, (j == 1 && p == 0) ? XR2 : (xr_t*)xo, (j == 1 && p == 1) ? xo : (float*)nullptr, (const unsigned*)(ws + WS_LIST) + (size_t)p * LISTCAP, (const float*)(ws + WS_LISTW) + (size_t)p * LISTCAP,
                                  fuse ? inp(1) + (size_t)(2 * j + 2) * D : (const float*)nullptr, fuse ? HN : (bf16*)nullptr, fuse ? (float*)(ws + WS_SS) + 8 * (size_t)T : (float*)nullptr, F.lds, FP8_LRUIN_J1 ? 4.f : 0.f};
                if (FP8_LAST_MOE && (j == 1 || FP8_MOE_J0)) {
                    pg8::GemmT<false, true, true> g{(bf16*)(act + (MOE_OVERLAP ? (size_t)p * LISTCAP * FF : (size_t)0)), (bf16*)((CVT_OVERLAP && j == 1) ? ws + WS_W2B : wf + WF_W2), FF / 2, FF / 2, FF / 128, 0, (long)256 * (FF / 2), nullptr, TILE, (long)D * (FF / 2), 0x7c7c7c7c, 0x78787878};
                    pg8::gemm_phase<pg8::EpiScatter, pg8::StaticOrder, pg8::GemmT<false, true, true>, true>(F.lds, g, S, E);
                } else {
                    pg8::GemmT<false, true> g{(bf16*)(act), (bf16*)((CVT_OVERLAP && j == 1) ? ws + WS_W2B : wf + WF_W2), FF, FF, FF / 64, 0, (long)256 * FF, nullptr, TILE, (long)D * FF};
                    pg8::gemm_phase<pg8::EpiScatter, pg8::StaticOrder, pg8::GemmT<false, true>, true>(F.lds, g, S, E);
                }
            }
            if (MOE_OVERLAP && p == 0 && FP8_LAST_MOE && (j == 1 || FP8_MOE_J0)) { if (PHASE(16) && PHASE(17)) __syncthreads(); else SEAM(16); }
            else if (CVT_OVERLAP && MOE_OVERLAP && p == 1 && j == 0 && FP8_LAST_MOE && FP8_MOE_J0 && PHASE(18) && base + 19 < hi) __syncthreads();
            else SEAM(16 + 2 * p);
        }
    }
#undef PHASE
#undef SEAM
#undef PH_BEGIN
}

extern "C" void kernel_launch(void* const* d_in, const int* in_sizes, int n_in, void* d_out, int out_size, void* d_ws, size_t ws_size, hipStream_t stream) {
    static int grid = 0;
    if (grid == 0) {
        if (n_in != 24 || in_sizes[0] != T * D || out_size != T * D || ws_size < WS_END) { fprintf(stderr, "kernel_launch: unexpected problem (n_in %d in0 %d out %d ws %zu)\n", n_in, n_in > 0 ? in_sizes[0] : -1, out_size, ws_size); grid = -1; return; }
        int dev = 0, cus = 0, per_cu = 0;
        if (hipGetDevice(&dev) != hipSuccess || hipDeviceGetAttribute(&cus, hipDeviceAttributeMultiprocessorCount, dev) != hipSuccess) { grid = -1; return; }
        if (hipFuncSetAttribute((const void*)trunk_fwd, hipFuncAttributeMaxDynamicSharedMemorySize, LDS_BYTES) != hipSuccess) { fprintf(stderr, "kernel_launch: hipFuncSetAttribute failed\n"); grid = -1; return; }
        if (hipOccupancyMaxActiveBlocksPerMultiprocessor(&per_cu, (const void*)trunk_fwd, NWAVES * 64, LDS_BYTES) != hipSuccess || per_cu < 1)
            fprintf(stderr, "kernel_launch: occupancy query reports %d workgroups per CU\n", per_cu);
        (void)hipGetLastError();
        grid = cus;
        if (grid != 256) { fprintf(stderr, "kernel_launch: %d CUs; this kernel is built for 256\n", grid); grid = -1; return; }
    }
    if (grid < 0) return;
    if (hipMemsetAsync((char*)d_ws + WS_CTL, 0, CTL_ZERO_BYTES, stream) != hipSuccess) return;
    Args a{};
    for (int i = 0; i < 24; ++i) a.in[i] = (const float*)d_in[i];
    a.out = (float*)d_out; a.ws = (unsigned char*)d_ws;
#if MK_PER_PHASE
    for (int ph = 0; ph < NPH; ++ph) { a.ph_lo = ph; a.ph_hi = ph + 1; hipLaunchKernelGGL(trunk_fwd, dim3(grid), dim3(NWAVES * 64), LDS_BYTES, stream, a); }
#else
    a.ph_lo = 0; a.ph_hi = NPH;
    hipLaunchKernelGGL(trunk_fwd, dim3(grid), dim3(NWAVES * 64), LDS_BYTES, stream, a);
#endif
    const hipError_t le = hipPeekAtLastError();
    if (le != hipSuccess) fprintf(stderr, "kernel_launch: launch failed: %s\n", hipGetErrorName(le));
}
```

```cpp
#include <hip/hip_runtime.h>
#include <cstdio>
#include <cstdint>

#ifndef MK_PER_PHASE
#define MK_PER_PHASE 0
#endif

constexpr int BATCH = 8, SEQ = 8192, D = 1024, T = BATCH * SEQ, NH = 16, HD = 64, FF = 3584, NE = 8;
constexpr int NWAVES = 8;
constexpr float RMS_EPS = 1e-6f;
constexpr float LOG2E = 1.4426950408889634f;

#define GAS __attribute__((address_space(1)))
#define LAS __attribute__((address_space(3)))
typedef unsigned short bf16;
typedef unsigned v4u __attribute__((ext_vector_type(4)));
typedef unsigned v2u __attribute__((ext_vector_type(2)));
typedef float f32x4 __attribute__((ext_vector_type(4)));
typedef float f32x2 __attribute__((ext_vector_type(2)));
typedef float f32x16 __attribute__((ext_vector_type(16)));
typedef short bf16x8 __attribute__((ext_vector_type(8)));
typedef short s16x4 __attribute__((ext_vector_type(4)));
typedef GAS unsigned gu32;
#define RLX_AGENT __ATOMIC_RELAXED, __HIP_MEMORY_SCOPE_AGENT
#define LDS_WAIT() asm volatile("s_waitcnt lgkmcnt(0)" ::: "memory")
#define VM_WAIT() asm volatile("s_waitcnt vmcnt(0)" ::: "memory")

__device__ __forceinline__ unsigned f2bf(float f) { unsigned u = __builtin_bit_cast(unsigned, f); return (u + 0x7fffu + ((u >> 16) & 1u)) >> 16; }
__device__ __forceinline__ unsigned pk2(float lo, float hi) { unsigned r; asm("v_cvt_pk_bf16_f32 %0, %1, %2" : "=v"(r) : "v"(lo), "v"(hi)); return r; }
__device__ __forceinline__ float bflo(unsigned w) { return __builtin_bit_cast(float, w << 16); }
__device__ __forceinline__ float bfhi(unsigned w) { return __builtin_bit_cast(float, w & 0xffff0000u); }
__device__ __forceinline__ unsigned cvt_pk_bf16(float lo, float hi) { unsigned r; asm volatile("v_cvt_pk_bf16_f32 %0, %1, %2" : "=v"(r) : "v"(lo), "v"(hi)); return r; }
typedef unsigned short xr_t;
__device__ __forceinline__ void xr_unpack8(const v4u& r, f32x4& a, f32x4& b) {
    a[0] = __uint_as_float(r.x << 16); a[1] = __uint_as_float(r.x & 0xffff0000u); a[2] = __uint_as_float(r.y << 16); a[3] = __uint_as_float(r.y & 0xffff0000u);
    b[0] = __uint_as_float(r.z << 16); b[1] = __uint_as_float(r.z & 0xffff0000u); b[2] = __uint_as_float(r.w << 16); b[3] = __uint_as_float(r.w & 0xffff0000u); }
__device__ __forceinline__ v4u xr_pack8(const f32x4& a, const f32x4& b) { v4u w; w.x = cvt_pk_bf16(a[0], a[1]); w.y = cvt_pk_bf16(a[2], a[3]); w.z = cvt_pk_bf16(b[0], b[1]); w.w = cvt_pk_bf16(b[2], b[3]); return w; }
__device__ __forceinline__ float fast_exp2(float x) { return __builtin_amdgcn_exp2f(x); }
__device__ __forceinline__ float fast_rcp(float x) { return __builtin_amdgcn_rcpf(x); }
__device__ __forceinline__ float sigmoidf_(float x) { return fast_rcp(1.0f + fast_exp2(-x * LOG2E)); }
__device__ __forceinline__ float q8(float x, float sc) { const float y = fminf(fmaxf(x * sc, -448.f), 448.f); const int p = __builtin_amdgcn_cvt_pk_fp8_f32(y, y, 0, false); return __builtin_amdgcn_cvt_f32_fp8(p, 0) * (1.0f / sc); }
__device__ __forceinline__ unsigned pack4_fp8(float a, float b, float c, float d, float sc) {
    a = fminf(fmaxf(a * sc, -448.f), 448.f); b = fminf(fmaxf(b * sc, -448.f), 448.f); c = fminf(fmaxf(c * sc, -448.f), 448.f); d = fminf(fmaxf(d * sc, -448.f), 448.f);
    int p = __builtin_amdgcn_cvt_pk_fp8_f32(a, b, 0, false); p = __builtin_amdgcn_cvt_pk_fp8_f32(c, d, p, true); return (unsigned)p;
}
#ifndef EMU_FP8
#define EMU_FP8 0
#endif
#ifndef FP8_LRUIN_J1
#define FP8_LRUIN_J1 1
#endif
#ifndef FP8_FOXIN_J0
#define FP8_FOXIN_J0 1
#endif
#ifndef FP8_FOXIN_J1
#define FP8_FOXIN_J1 1
#endif
#ifndef FP8_L2_FFN
#define FP8_L2_FFN 1
#endif
#ifndef FP8_MOE_J0
#define FP8_MOE_J0 1
#endif
#ifndef FP8_L0_FFN2
#define FP8_L0_FFN2 1
#endif
#ifndef MOE_OVERLAP
#define MOE_OVERLAP 1
#endif
#ifndef FP8_LAST_MOE
#define FP8_LAST_MOE 1
#endif
__device__ __forceinline__ float wave_sum(float v) {
#pragma unroll
    for (int o = 1; o < 64; o <<= 1) v += __shfl_xor(v, o);
    return v;
}

namespace pg8 {
#define PG8_LAS __attribute__((address_space(3)))
constexpr int BM = 256, BK = 64, HALF = 128, HTB = HALF * BK * 2, STAGE_BYTES = 8 * HTB, NXCD = 8, WGM = 8;
__host__ __device__ __forceinline__ int lds_byte(int r, int c) { const int st = (r >> 4) * 2 + (c >> 5), rr = r & 15, cc = c & 31, ob = rr * 64 + cc * 2; return st * 1024 + (ob ^ (((ob >> 9) & 1) << 5)); }
__host__ __device__ __forceinline__ void stage_rc(int b, int& R, int& C) { const int st = b / 1024, sb = b % 1024, swz = sb ^ (((sb >> 9) & 1) << 5); R = (st >> 1) * 16 + swz / 64; C = (st & 1) * 32 + (swz % 64) / 2; }
__host__ __device__ __forceinline__ int perm32(int rho) { const int n = rho >> 4, i = rho & 15; return 8 * (i >> 2) + 4 * n + (i & 3); }

typedef int v8i_t __attribute__((ext_vector_type(8)));
typedef int v4i_t __attribute__((ext_vector_type(4)));
__device__ __forceinline__ v8i_t cat8(bf16x8 lo, bf16x8 hi) { const v4i_t a = __builtin_bit_cast(v4i_t, lo), b = __builtin_bit_cast(v4i_t, hi); return __builtin_shufflevector(a, b, 0, 1, 2, 3, 4, 5, 6, 7); }
struct Unit { int pm, pn; };
struct StaticOrder {
    int nM, nN, nwg, G, c, isp, csk;
    __device__ void init(int nM_, int nN_, int G_, int c_) { nM = nM_; nN = nN_; nwg = nM * nN; G = G_; c = c_; isp = 0x7fffffff; csk = 0; }
    __device__ void split(int isp_, int csk_) { isp = isp_; csk = csk_; }
    __device__ bool next(int i, Unit& u) const {
        long L;
        if (i < isp) L = (long)i * G + c; else { if (c < csk) return false; L = (long)isp * G + (long)(i - isp) * (G - csk) + (c - csk); }
        if (L >= nwg) return false;
        int wgid = (int)L; { const int q = nwg / NXCD, r = nwg % NXCD, xcd = wgid % NXCD, off = wgid / NXCD; wgid = (xcd < r ? xcd * (q + 1) : r * (q + 1) + (xcd - r) * q) + off; }
        const int nig = WGM * nN, gid = wgid / nig, fm = gid * WGM, gsz = (nM - fm) < WGM ? (nM - fm) : WGM;
        u.pm = fm + ((wgid % nig) % gsz); u.pn = (wgid % nig) / gsz; return true;
    }
};

template <bool GATHER_, bool EXPERT_, bool FP8_ = false> struct GemmT {
    static constexpr bool GATHER = GATHER_, EXPERT = EXPERT_, FP8 = FP8_;
    const bf16* A; const bf16* Bt; int lda, ldb, nt;
    long a_pn, b_pn;
    const unsigned* list;
    const unsigned* tile_e; long b_e;
    int scA = 0x7f7f7f7f, scB = 0x7f7f7f7f;
    __device__ __forceinline__ const char* a_tile(const Unit& u) const { return (const char*)(A + (GATHER ? 0 : (size_t)u.pm * BM * lda) + (size_t)u.pn * a_pn); }
    __device__ __forceinline__ const char* b_tile(const Unit& u) const {
        size_t off = (size_t)u.pn * b_pn;
        if (EXPERT) { const unsigned e = (unsigned)__builtin_amdgcn_readfirstlane((int)__hip_atomic_load(tile_e + u.pm, RLX_AGENT)); off += (size_t)e * b_e; }
        return (const char*)(Bt + off);
    }
    __device__ __forceinline__ void a_voff(const Unit& u, const int (&sR)[2], const int (&sC)[2], unsigned (&vo)[2][2]) const {
        if (GATHER) {
            unsigned idx[2][2];
#pragma unroll
            for (int h = 0; h < 2; ++h)
#pragma unroll
                for (int i = 0; i < 2; ++i) idx[h][i] = list[u.pm * BM + h * HALF + sR[i]];
            asm volatile("s_waitcnt vmcnt(0)" ::: "memory");
#pragma unroll
            for (int h = 0; h < 2; ++h)
#pragma unroll
                for (int i = 0; i < 2; ++i) vo[h][i] = ((idx[h][i] & 0xffffu) * (unsigned)lda + (unsigned)sC[i]) * 2u;
        } else {
#pragma unroll
            for (int h = 0; h < 2; ++h)
#pragma unroll
                for (int i = 0; i < 2; ++i) vo[h][i] = (unsigned)((h * HALF + sR[i]) * lda + sC[i]) * 2u;
        }
    }
};

template <class Epi, class Sched, class GD, bool ALIGN_EPI>
__device__ __forceinline__ void gemm_phase(PG8_LAS unsigned char* lds, const GD& g, const Sched& S, const Epi& E) {
    int tid = threadIdx.x; asm volatile("" : "+v"(tid));
    const int wid = __builtin_amdgcn_readfirstlane(tid >> 6), lane = tid & 63, wr = wid >> 2, wc = wid & 3, fr = lane & 15, fq = lane >> 4;
    int nt = g.nt; asm volatile("" : "+s"(nt));
    int sR[2], sC[2]; unsigned voffB[2];
#pragma unroll
    for (int i = 0; i < 2; ++i) { int R, C; stage_rc(tid * 16 + i * 8192, R, C); sR[i] = R; sC[i] = C; const int Rb = Epi::PERM ? ((R & ~31) + perm32(R & 31)) : R;
        voffB[i] = (unsigned)(Rb * g.ldb + C) * 2u; }
    const size_t kstep = (size_t)(BK * 2);
    const size_t hstepB = (size_t)HALF * g.ldb * 2;
    const size_t hstepA = (size_t)HALF * g.lda * 2;
    unsigned voffA[2];
#pragma unroll
    for (int i = 0; i < 2; ++i) voffA[i] = (unsigned)(sR[i] * g.lda + sC[i]) * 2u;
    const unsigned ldsw = (unsigned)wid * 1024u;
    const int aoff = lds_byte(wr * 64 + fr, fq * 8), boff = lds_byte(wc * 32 + fr, fq * 8);
#define PG8_SA(b, h) (((b) * 2 + (h)) * HTB)
#define PG8_SB(b, h) ((4 + (b) * 2 + (h)) * HTB)
#define PG8_STAGE(bufoff, gbase, voff) do { _Pragma("unroll") for (int _i = 0; _i < 2; ++_i) \
        __builtin_amdgcn_global_load_lds((const unsigned*)((const char*)(gbase) + (voff)[_i]), (PG8_LAS unsigned*)(lds + (bufoff) + ldsw + _i * 8192), 16, 0, 0); } while (0)
#define PG8_STAGE_A(bufoff, gbase, h, VA) do { if constexpr (GD::GATHER) { PG8_STAGE(bufoff, gbase, VA[h]); } else { PG8_STAGE(bufoff, (gbase) + (h) * hstepA, voffA); } } while (0)
#define PG8_LDA(dst, b, h) do { _Pragma("unroll") for (int m = 0; m < 4; ++m) _Pragma("unroll") for (int k = 0; k < 2; ++k) dst[m][k] = *(const PG8_LAS bf16x8*)(lds + PG8_SA(b, h) + aoff + m * 2048 + k * 1024); } while (0)
#define PG8_LDB(dst, b, h) do { _Pragma("unroll") for (int n = 0; n < 2; ++n) _Pragma("unroll") for (int k = 0; k < 2; ++k) dst[n][k] = *(const PG8_LAS bf16x8*)(lds + PG8_SB(b, h) + boff + n * 2048 + k * 1024); } while (0)
#define PG8_MMA(ai, bj, At, Bt) do { __builtin_amdgcn_s_setprio(1); \
        if constexpr (GD::FP8) { _Pragma("unroll") for (int m = 0; m < 4; ++m) _Pragma("unroll") for (int n = 0; n < 2; ++n) \
            asm volatile("v_mfma_scale_f32_16x16x128_f8f6f4 %0, %1, %2, %0, %3, %4 op_sel_hi:[0,0,0]" : "+v"(acc[ai][bj][m][n]) : "v"(cat8(Bt[n][0], Bt[n][1])), "v"(cat8(At[m][0], At[m][1])), "v"(vscB), "v"(vscA)); } \
        else { _Pragma("unroll") for (int m = 0; m < 4; ++m) _Pragma("unroll") for (int n = 0; n < 2; ++n) _Pragma("unroll") for (int k = 0; k < 2; ++k) \
            acc[ai][bj][m][n] = __builtin_amdgcn_mfma_f32_16x16x32_bf16(Bt[n][k], At[m][k], acc[ai][bj][m][n], 0, 0, 0); } \
        __builtin_amdgcn_s_setprio(0); } while (0)
#define PG8_WAIT_V(n) asm volatile("s_waitcnt vmcnt(" #n ")" ::: "memory")
#define PG8_WAIT_L(n) asm volatile("s_waitcnt lgkmcnt(" #n ")" ::: "memory")
#define PG8_BAR __builtin_amdgcn_s_barrier()
#define PG8_SCHED __builtin_amdgcn_sched_barrier(0)
    Unit cur, nxt; int ui = 0;
    if (!S.next(0, cur)) return;
    int vscA = g.scA, vscB = g.scB; asm volatile("" : "+v"(vscA), "+v"(vscB));
    f32x4 acc[2][2][4][2];
#pragma unroll
    for (int a = 0; a < 2; ++a)
#pragma unroll
        for (int b = 0; b < 2; ++b)
#pragma unroll
            for (int m = 0; m < 4; ++m)
#pragma unroll
                for (int n = 0; n < 2; ++n) acc[a][b][m][n] = (f32x4){0.f, 0.f, 0.f, 0.f};
    bf16x8 At[4][2], B0[2][2], B1[2][2];
    const char* cA = g.a_tile(cur); const char* cB = g.b_tile(cur);
    unsigned vAc[2][2], vAn[2][2];
    if constexpr (GD::GATHER) g.a_voff(cur, sR, sC, vAc);
    else {
#pragma unroll
        for (int h = 0; h < 2; ++h)
#pragma unroll
            for (int i = 0; i < 2; ++i) vAc[h][i] = 0u;
    }
#pragma unroll
    for (int h = 0; h < 2; ++h)
#pragma unroll
        for (int i = 0; i < 2; ++i) vAn[h][i] = vAc[h][i];
    PG8_STAGE(PG8_SB(0, 0), cB, voffB); PG8_STAGE(PG8_SB(0, 1), cB + hstepB, voffB); PG8_STAGE_A(PG8_SA(0, 0), cA, 0, vAc); PG8_STAGE_A(PG8_SA(0, 1), cA, 1, vAc);
    if (wr == 1) PG8_BAR;
    PG8_WAIT_V(2); PG8_BAR;
    PG8_STAGE(PG8_SB(1, 0), cB + kstep, voffB); PG8_STAGE_A(PG8_SA(1, 0), cA + kstep, 0, vAc); PG8_STAGE(PG8_SB(1, 1), cB + hstepB + kstep, voffB);
    PG8_WAIT_V(6); PG8_BAR;
    for (;;) {
        const bool has_next = S.next(ui + 1, nxt);
        const char* nA = has_next ? g.a_tile(nxt) : cA; const char* nB = has_next ? g.b_tile(nxt) : cB;
        for (int t = 0; t < nt; t += 2) {
            const bool last = (t == nt - 2);
            const char* a1 = cA + (size_t)(t + 1) * kstep;
            const char* a2 = last ? nA : cA + (size_t)(t + 2) * kstep; const char* b2 = last ? nB : cB + (size_t)(t + 2) * kstep;
            const char* a3 = a2 + kstep; const char* b3 = b2 + kstep;
            if (GD::GATHER && last && has_next) g.a_voff(nxt, sR, sC, vAn);
            PG8_LDB(B0, 0, 0); PG8_LDB(B1, 0, 1); PG8_SCHED; PG8_LDA(At, 0, 0); PG8_STAGE_A(PG8_SA(1, 1), a1, 1, vAc);
            PG8_WAIT_V(8); PG8_WAIT_L(0); PG8_BAR; PG8_MMA(0, 0, At, B0); PG8_MMA(0, 1, At, B1); PG8_BAR; PG8_SCHED;
            PG8_LDA(At, 0, 1); PG8_STAGE(PG8_SB(0, 0), b2, voffB); PG8_STAGE(PG8_SB(0, 1), b2 + hstepB, voffB); PG8_STAGE_A(PG8_SA(0, 0), a2, 0, vAn);
            PG8_WAIT_V(8); PG8_WAIT_L(0); PG8_BAR; PG8_MMA(1, 0, At, B0); PG8_MMA(1, 1, At, B1); PG8_BAR; PG8_SCHED;
            PG8_LDB(B0, 1, 0); PG8_LDB(B1, 1, 1); PG8_SCHED; PG8_LDA(At, 1, 0); PG8_STAGE_A(PG8_SA(0, 1), a2, 1, vAn);
            PG8_WAIT_V(8); PG8_WAIT_L(0); PG8_BAR; PG8_MMA(0, 0, At, B0); PG8_MMA(0, 1, At, B1); PG8_BAR; PG8_SCHED;
            PG8_LDA(At, 1, 1); PG8_STAGE(PG8_SB(1, 0), b3, voffB); PG8_STAGE(PG8_SB(1, 1), b3 + hstepB, voffB); PG8_STAGE_A(PG8_SA(1, 0), a3, 0, vAn);
            PG8_WAIT_V(8); PG8_WAIT_L(0); PG8_BAR; PG8_MMA(1, 0, At, B0); PG8_MMA(1, 1, At, B1); PG8_BAR; PG8_SCHED;
        }
        if constexpr (ALIGN_EPI) { if (wr == 0) PG8_BAR; }
        if constexpr (GD::FP8) asm volatile("s_nop 15\n\ts_nop 7" ::: "memory");
        E(acc, cur, wr, wc, fr, fq);
        if (!has_next) break;
#pragma unroll
        for (int a = 0; a < 2; ++a)
#pragma unroll
            for (int b = 0; b < 2; ++b)
#pragma unroll
                for (int m = 0; m < 4; ++m)
#pragma unroll
                    for (int n = 0; n < 2; ++n) acc[a][b][m][n] = (f32x4){0.f, 0.f, 0.f, 0.f};
        cur = nxt; cA = nA; cB = nB; ++ui;
#pragma unroll
        for (int h = 0; h < 2; ++h)
#pragma unroll
            for (int i = 0; i < 2; ++i) vAc[h][i] = vAn[h][i];
        if constexpr (ALIGN_EPI) { if (wr == 1) PG8_BAR; }
    }
    PG8_WAIT_V(0);
    if constexpr (!ALIGN_EPI) { if (wr == 0) PG8_BAR; }
    PG8_BAR;
#undef PG8_SA
#undef PG8_SB
#undef PG8_STAGE
#undef PG8_STAGE_A
#undef PG8_LDA
#undef PG8_LDB
#undef PG8_MMA
#undef PG8_WAIT_V
#undef PG8_WAIT_L
#undef PG8_BAR
#undef PG8_SCHED
}

__device__ __forceinline__ float gelu_tanh(float v) { const float z2 = (2.0f * 0.7978845608028654f * LOG2E) * (v + 0.044715f * v * v * v); return v * fast_rcp(1.0f + fast_exp2(-z2)); }

constexpr int XCH_OFF = 131072 + 1024;
__device__ __forceinline__ float row_rs(const float* ssp, int row, int fq) {
    float p = ssp[(size_t)fq * T + row]; p += __shfl_xor(p, 16); p += __shfl_xor(p, 32);
    return __builtin_amdgcn_rsqf(p * (1.0f / D) + RMS_EPS);
}
__device__ __forceinline__ void row_rs8(const float* ssp, int row0, int fq, float (&rs)[2][4]) {
    if (!ssp) {
#pragma unroll
        for (int ai = 0; ai < 2; ++ai)
#pragma unroll
            for (int m = 0; m < 4; ++m) rs[ai][m] = 1.0f;
        return; }
    float p[2][4];
#pragma unroll
    for (int ai = 0; ai < 2; ++ai)
#pragma unroll
        for (int m = 0; m < 4; ++m) p[ai][m] = ssp[(size_t)fq * T + row0 + ai * HALF + m * 16];
#pragma unroll
    for (int ai = 0; ai < 2; ++ai)
#pragma unroll
        for (int m = 0; m < 4; ++m) { float q = p[ai][m]; q += __shfl_xor(q, 16); q += __shfl_xor(q, 32); rs[ai][m] = __builtin_amdgcn_rsqf(q * (1.0f / D) + RMS_EPS); }
}
struct EpiLruIn {
    static constexpr bool PERM = true;
    bf16* Y; bf16* XB; const float* ss;
    __device__ __forceinline__ void operator()(const f32x4 (&acc)[2][2][4][2], const Unit& u, int wr, int wc, int fr, int fq) const {
        int row0 = u.pm * BM + wr * 64 + fr; asm volatile("" : "+v"(row0)); const bool act = (u.pn < 4);
        bf16* base = act ? Y : XB; const int col0 = (u.pn & 3) * BM + wc * 32 + 8 * fq;
        float rs8[2][4]; row_rs8(ss, row0, fq, rs8);
#pragma unroll
        for (int ai = 0; ai < 2; ++ai)
#pragma unroll
            for (int m = 0; m < 4; ++m) { bf16* rowp = base + (size_t)(row0 + ai * HALF + m * 16) * D + col0;
                const float rs = rs8[ai][m];
#pragma unroll
                for (int bj = 0; bj < 2; ++bj) { f32x4 v0 = acc[ai][bj][m][0] * rs, v1 = acc[ai][bj][m][1] * rs;
                    if (act) {
#pragma unroll
                        for (int j = 0; j < 4; ++j) { v0[j] = gelu_tanh(v0[j]); v1[j] = gelu_tanh(v1[j]); } }
                    v4u w; w.x = cvt_pk_bf16(v0[0], v0[1]); w.y = cvt_pk_bf16(v0[2], v0[3]); w.z = cvt_pk_bf16(v1[0], v1[1]); w.w = cvt_pk_bf16(v1[2], v1[3]);
                    *(v4u*)(rowp + bj * HALF) = w; }
                asm volatile("" ::: "memory"); }
    }
};
struct EpiGate {
    static constexpr bool PERM = false;
    const bf16* XC; const float* ba; const float* bx; const float* c8; unsigned* AB;
    __device__ __forceinline__ void operator()(const f32x4 (&acc)[2][2][4][2], const Unit& u, int wr, int wc, int fr, int fq) const {
        int row0 = u.pm * BM + wr * 64 + fr; asm volatile("" : "+v"(row0)); const int ch0 = u.pn * HALF + wc * 32 + 4 * fq;
        v2u xall[2][2][4];
#pragma unroll
        for (int n = 0; n < 2; ++n)
#pragma unroll
            for (int ai = 0; ai < 2; ++ai)
#pragma unroll
                for (int m = 0; m < 4; ++m) xall[n][ai][m] = *(const v2u*)(XC + (size_t)(row0 + ai * HALF + m * 16) * D + ch0 + 16 * n);
#pragma unroll
        for (int n = 0; n < 2; ++n) {
            const f32x4 vba = *(const f32x4*)(ba + ch0 + 16 * n), vbx = *(const f32x4*)(bx + ch0 + 16 * n), vc8 = *(const f32x4*)(c8 + ch0 + 16 * n);
#pragma unroll
            for (int ai = 0; ai < 2; ++ai)
#pragma unroll
                for (int m = 0; m < 4; ++m) { const size_t ro = (size_t)(row0 + ai * HALF + m * 16) * D + ch0 + 16 * n;
                    const v2u xw = xall[n][ai][m];
                    const float xc[4] = {bflo(xw.x), bfhi(xw.x), bflo(xw.y), bfhi(xw.y)}; v4u o;
#pragma unroll
                    for (int j = 0; j < 4; ++j) { const float r = sigmoidf_(acc[ai][0][m][n][j] + vba[j]), gi = sigmoidf_(acc[ai][1][m][n][j] + vbx[j]);
                        const float la2 = -vc8[j] * r, a2 = fast_exp2(2.0f * la2), mult = __builtin_amdgcn_sqrtf(fmaxf(1.0f - a2, 0.f));
                        o[j] = pk2(mult * gi * xc[j], la2); }
                    *(v4u*)(AB + ro) = o;
                    if (m & 1) asm volatile("" ::: "memory"); }
        }
    }
};
struct EpiResid {
    static constexpr bool PERM = true;
    const xr_t* xin; xr_t* out;
    const float* gnext; bf16* hn; float* ssp; PG8_LAS unsigned char* lds;
    float h8s = 0.f;
    __device__ __forceinline__ void operator()(const f32x4 (&acc)[2][2][4][2], const Unit& u, int wr, int wc, int fr, int fq) const {
        int row0 = u.pm * BM + wr * 64 + fr; asm volatile("" : "+v"(row0)); const int col0 = u.pn * BM + wc * 32 + 8 * fq;
        PG8_LAS float* xch = (PG8_LAS float*)(lds + XCH_OFF);
        f32x4 gv[2][2];
        if (hn) {
#pragma unroll
            for (int bj = 0; bj < 2; ++bj)
#pragma unroll
                for (int n = 0; n < 2; ++n) gv[bj][n] = *(const f32x4*)(gnext + col0 + bj * HALF + 4 * n); }
        v4u xn[2];
#pragma unroll
        for (int bj = 0; bj < 2; ++bj) xn[bj] = *(const v4u*)(xin + (size_t)row0 * D + col0 + bj * HALF);
#pragma unroll
        for (int g8 = 0; g8 < 8; ++g8) { const int ai = g8 >> 2, m = g8 & 3; const int row = row0 + ai * HALF + m * 16; const size_t ro = (size_t)row * D + col0; float sq = 0.f;
                f32x4 xc[2][2];
#pragma unroll
                for (int bj = 0; bj < 2; ++bj) xr_unpack8(xn[bj], xc[bj][0], xc[bj][1]);
                if (g8 < 7) { const size_t rn = (size_t)(row0 + ((g8 + 1) >> 2) * HALF + ((g8 + 1) & 3) * 16) * D + col0;
#pragma unroll
                    for (int bj = 0; bj < 2; ++bj) xn[bj] = *(const v4u*)(xin + rn + bj * HALF); }
#pragma unroll
                for (int bj = 0; bj < 2; ++bj) { f32x4 o[2];
#pragma unroll
                    for (int n = 0; n < 2; ++n) o[n] = xc[bj][n] + acc[ai][bj][m][n];
                    *(v4u*)(out + ro + bj * HALF) = xr_pack8(o[0], o[1]);
                    if (hn) { sq += (o[0][0] * o[0][0] + o[0][1] * o[0][1]) + (o[0][2] * o[0][2] + o[0][3] * o[0][3]) + (o[1][0] * o[1][0] + o[1][1] * o[1][1]) + (o[1][2] * o[1][2] + o[1][3] * o[1][3]);
                        const f32x4 h0 = o[0] * gv[bj][0], h1 = o[1] * gv[bj][1];
                        if (h8s != 0.f) { v2u w; w.x = pack4_fp8(h0[0], h0[1], h0[2], h0[3], h8s); w.y = pack4_fp8(h1[0], h1[1], h1[2], h1[3], h8s); *(v2u*)((unsigned char*)hn + ro + bj * HALF) = w; }
                        else { v4u w; w.x = cvt_pk_bf16(h0[0], h0[1]); w.y = cvt_pk_bf16(h0[2], h0[3]); w.z = cvt_pk_bf16(h1[0], h1[1]); w.w = cvt_pk_bf16(h1[2], h1[3]);
                        *(v4u*)(hn + ro + bj * HALF) = w; } } }
                if (hn) { sq += __shfl_xor(sq, 16); sq += __shfl_xor(sq, 32); if (fq == 0) xch[wc * 256 + ai * HALF + wr * 64 + m * 16 + fr] = sq; }
                asm volatile("" ::: "memory"); }
        if (hn) {
            asm volatile("s_waitcnt lgkmcnt(0)" ::: "memory"); __builtin_amdgcn_s_barrier(); asm volatile("" ::: "memory");
            const int t = (wr * 4 + wc) * 64 + fq * 16 + fr;
            if (t < 256) ssp[(size_t)u.pn * T + u.pm * BM + t] = (xch[t] + xch[256 + t]) + (xch[512 + t] + xch[768 + t]);
        }
    }
};
struct EpiFoxIn {
    static constexpr bool PERM = true;
    bf16* base; size_t kstride; const float* qg; const float* kg; float c2;
    const float* ss;
    const float* bfv; float* LOGF;
    __device__ __forceinline__ void operator()(const f32x4 (&acc)[2][2][4][2], const Unit& u, int wr, int wc, int fr, int fq) const {
        const int kind = u.pn >> 2, head = 4 * (u.pn & 3) + wc; int row0 = u.pm * BM + wr * 64 + fr; asm volatile("" : "+v"(row0));
        float rs8[2][4]; row_rs8(ss, row0, fq, rs8);
        if (kind == 4) {
            if (wc == 0) { f32x4 bb[2];
#pragma unroll
                for (int n = 0; n < 2; ++n) bb[n] = *(const f32x4*)(bfv + 8 * (fq & 1) + 4 * n);
#pragma unroll
                for (int ai = 0; ai < 2; ++ai)
#pragma unroll
                    for (int m = 0; m < 4; ++m) { const int row = row0 + ai * HALF + m * 16; const float rs = rs8[ai][m];
                        if (fq < 2) {
#pragma unroll
                            for (int n = 0; n < 2; ++n) { f32x4 o;
#pragma unroll
                                for (int j = 0; j < 4; ++j) { const float z = acc[ai][0][m][n][j] * rs + bb[n][j]; o[j] = fminf(z, 0.f) - log1pf(__expf(-fabsf(z))); }
                                *(f32x4*)(LOGF + (size_t)row * 16 + 8 * fq + 4 * n) = o; } } } }
            return;
        }
        bf16* tb = base + (size_t)kind * kstride + head * HD + 8 * fq;
        f32x4 gn[2][2];
        if (kind < 2) { const float* gp = (kind == 0 ? qg : kg) + 8 * fq;
#pragma unroll
            for (int bj = 0; bj < 2; ++bj)
#pragma unroll
                for (int n = 0; n < 2; ++n) gn[bj][n] = *(const f32x4*)(gp + 32 * bj + 4 * n); }
        const float sc = (kind == 0) ? c2 : 1.0f;
#pragma unroll
        for (int ai = 0; ai < 2; ++ai)
#pragma unroll
            for (int m = 0; m < 4; ++m) { const int row = row0 + ai * HALF + m * 16; bf16* rowp = tb + (size_t)row * D;
                const float rsx = rs8[ai][m];
                f32x4 v[2][2];
#pragma unroll
                for (int bj = 0; bj < 2; ++bj)
#pragma unroll
                    for (int n = 0; n < 2; ++n) v[bj][n] = acc[ai][bj][m][n] * rsx;
                if (kind < 2) { float s2 = 0.f;
#pragma unroll
                    for (int bj = 0; bj < 2; ++bj)
#pragma unroll
                        for (int n = 0; n < 2; ++n) s2 += (v[bj][n][0] * v[bj][n][0] + v[bj][n][1] * v[bj][n][1]) + (v[bj][n][2] * v[bj][n][2] + v[bj][n][3] * v[bj][n][3]);
                    s2 += __shfl_xor(s2, 16); s2 += __shfl_xor(s2, 32);
                    const float rs = __builtin_amdgcn_rsqf(s2 * (1.0f / HD) + RMS_EPS) * sc;
#pragma unroll
                    for (int bj = 0; bj < 2; ++bj)
#pragma unroll
                        for (int n = 0; n < 2; ++n) v[bj][n] = v[bj][n] * rs * gn[bj][n];
                } else if (kind == 3) {
#pragma unroll
                    for (int bj = 0; bj < 2; ++bj)
#pragma unroll
                        for (int n = 0; n < 2; ++n)
#pragma unroll
                            for (int j = 0; j < 4; ++j) v[bj][n][j] = sigmoidf_(v[bj][n][j]);
                }
#pragma unroll
                for (int bj = 0; bj < 2; ++bj) { v4u w; w.x = cvt_pk_bf16(v[bj][0][0], v[bj][0][1]); w.y = cvt_pk_bf16(v[bj][0][2], v[bj][0][3]); w.z = cvt_pk_bf16(v[bj][1][0], v[bj][1][1]); w.w = cvt_pk_bf16(v[bj][1][2], v[bj][1][3]);
                    *(v4u*)(rowp + 32 * bj) = w; }
                asm volatile("" ::: "memory"); }
    }
};
struct EpiSwiglu {
    static constexpr bool PERM = true;
    bf16* Hb; int ldh; const float* ss; float hq;
    __device__ __forceinline__ void operator()(const f32x4 (&acc)[2][2][4][2], const Unit& u, int wr, int wc, int fr, int fq) const {
        int row0 = u.pm * BM + wr * 64 + fr; asm volatile("" : "+v"(row0)); const int col0 = u.pn * HALF + wc * 32 + 8 * fq;
        float rs8[2][4]; row_rs8(ss, row0, fq, rs8);
#pragma unroll
        for (int ai = 0; ai < 2; ++ai)
#pragma unroll
            for (int m = 0; m < 4; ++m) { bf16* rowp = Hb + (size_t)(row0 + ai * HALF + m * 16) * ldh + col0; float h[8];
                const float rs = rs8[ai][m];
#pragma unroll
                for (int n = 0; n < 2; ++n)
#pragma unroll
                    for (int j = 0; j < 4; ++j) { const float gv = acc[ai][0][m][n][j] * rs, uv = acc[ai][1][m][n][j] * rs; h[4 * n + j] = gv * uv * fast_rcp(1.0f + fast_exp2(-gv * LOG2E));
#if EMU_FP8
                        if (hq != 0.f) h[4 * n + j] = q8(h[4 * n + j], hq);
#endif
                    }
                v4u w; w.x = cvt_pk_bf16(h[0], h[1]); w.y = cvt_pk_bf16(h[2], h[3]); w.z = cvt_pk_bf16(h[4], h[5]); w.w = cvt_pk_bf16(h[6], h[7]);
                *(v4u*)rowp = w;
                asm volatile("" ::: "memory"); }
    }
};
struct EpiNull {
    static constexpr bool PERM = true;
    float* sink;
    __device__ __forceinline__ void operator()(const f32x4 (&acc)[2][2][4][2], const Unit& u, int wr, int wc, int fr, int fq) const {
        float s = 0.f;
#pragma unroll
        for (int ai = 0; ai < 2; ++ai)
#pragma unroll
            for (int bj = 0; bj < 2; ++bj)
#pragma unroll
                for (int m = 0; m < 4; ++m)
#pragma unroll
                    for (int n = 0; n < 2; ++n) s += acc[ai][bj][m][n][0] + acc[ai][bj][m][n][1] + acc[ai][bj][m][n][2] + acc[ai][bj][m][n][3];
        if (s == 12345.678f) *sink = s;
    }
};
struct EpiSwiglu8 {
    static constexpr bool PERM = true;
    unsigned char* H8; int ldh; float hs; const float* ss = nullptr;
    __device__ __forceinline__ void operator()(const f32x4 (&acc)[2][2][4][2], const Unit& u, int wr, int wc, int fr, int fq) const {
        int row0 = u.pm * BM + wr * 64 + fr; asm volatile("" : "+v"(row0)); const int col0 = u.pn * HALF + wc * 32 + 8 * fq;
        float rs8[2][4]; row_rs8(ss, row0, fq, rs8);
#pragma unroll
        for (int ai = 0; ai < 2; ++ai)
#pragma unroll
            for (int m = 0; m < 4; ++m) { unsigned char* rowp = H8 + (size_t)(row0 + ai * HALF + m * 16) * ldh + col0; float h[8];
                const float rs = rs8[ai][m];
#pragma unroll
                for (int n = 0; n < 2; ++n)
#pragma unroll
                    for (int j = 0; j < 4; ++j) { const float gv = acc[ai][0][m][n][j] * rs, uv = acc[ai][1][m][n][j] * rs; h[4 * n + j] = gv * uv * fast_rcp(1.0f + fast_exp2(-gv * LOG2E)); }
                v2u w; w.x = pack4_fp8(h[0], h[1], h[2], h[3], hs); w.y = pack4_fp8(h[4], h[5], h[6], h[7], hs);
                *(v2u*)rowp = w;
                asm volatile("" ::: "memory"); }
    }
};
struct EpiScatter {
    static constexpr bool PERM = true; static constexpr int NST = 0;
    const xr_t* xr; xr_t* xw; float* fout; const unsigned* list; const float* listw;
    const float* gnext; bf16* hn; float* ssp; PG8_LAS unsigned char* lds;
    float h8s = 0.f;
    __device__ __forceinline__ void operator()(const f32x4 (&acc)[2][2][4][2], const Unit& u, int wr, int wc, int fr, int fq) const {
        int row0 = u.pm * BM + wr * 64 + fr; asm volatile("" : "+v"(row0)); const int col0 = u.pn * BM + wc * 32 + 8 * fq;
        PG8_LAS float* xch = (PG8_LAS float*)(lds + XCH_OFF);
        unsigned idx8[8]; float w8[8];
#pragma unroll
        for (int g8 = 0; g8 < 8; ++g8) { const int row = row0 + (g8 >> 2) * HALF + (g8 & 3) * 16; idx8[g8] = list[row]; w8[g8] = listw[row]; }
        v4u xn[2];
        { const size_t r0 = (size_t)(idx8[0] & 0xffffu) * D + col0;
#pragma unroll
          for (int bj = 0; bj < 2; ++bj) xn[bj] = *(const v4u*)(xr + r0 + bj * HALF); }
#pragma unroll
        for (int g8 = 0; g8 < 8; ++g8) { const int ai = g8 >> 2, m = g8 & 3; const unsigned idx = idx8[g8]; const float w = w8[g8]; const bool valid = (idx & 0x80000000u) != 0u;
                const int tok = (int)(idx & 0xffffu); const size_t ro = (size_t)tok * D + col0; float sq = 0.f;
                f32x4 xc[2][2];
#pragma unroll
                for (int bj = 0; bj < 2; ++bj) xr_unpack8(xn[bj], xc[bj][0], xc[bj][1]);
                if (g8 < 7) { const size_t rn = (size_t)(idx8[g8 + 1 < 8 ? g8 + 1 : 7] & 0xffffu) * D + col0;
#pragma unroll
                    for (int bj = 0; bj < 2; ++bj) xn[bj] = *(const v4u*)(xr + rn + bj * HALF); }
                if (valid) {
#pragma unroll
                    for (int bj = 0; bj < 2; ++bj) { f32x4 o[2];
#pragma unroll
                        for (int n = 0; n < 2; ++n) o[n] = xc[bj][n] + acc[ai][bj][m][n] * w;
                        if (fout) { *(f32x4*)(fout + ro + bj * HALF) = o[0]; *(f32x4*)(fout + ro + bj * HALF + 4) = o[1]; }
                        else *(v4u*)(xw + ro + bj * HALF) = xr_pack8(o[0], o[1]);
                        if (hn) { sq += (o[0][0] * o[0][0] + o[0][1] * o[0][1]) + (o[0][2] * o[0][2] + o[0][3] * o[0][3]) + (o[1][0] * o[1][0] + o[1][1] * o[1][1]) + (o[1][2] * o[1][2] + o[1][3] * o[1][3]);
                            const f32x4 g0 = *(const f32x4*)(gnext + col0 + bj * HALF), g1 = *(const f32x4*)(gnext + col0 + bj * HALF + 4);
                            const f32x4 h0 = o[0] * g0, h1 = o[1] * g1;
                            if (h8s != 0.f) { v2u w2; w2.x = pack4_fp8(h0[0], h0[1], h0[2], h0[3], h8s); w2.y = pack4_fp8(h1[0], h1[1], h1[2], h1[3], h8s); *(v2u*)((unsigned char*)hn + ro + bj * HALF) = w2; }
                            else { v4u w4; w4.x = cvt_pk_bf16(h0[0], h0[1]); w4.y = cvt_pk_bf16(h0[2], h0[3]); w4.z = cvt_pk_bf16(h1[0], h1[1]); w4.w = cvt_pk_bf16(h1[2], h1[3]);
                            *(v4u*)(hn + ro + bj * HALF) = w4; } }
                        asm volatile("" ::: "memory"); } }
                if (hn) { sq += __shfl_xor(sq, 16); sq += __shfl_xor(sq, 32); if (fq == 0) xch[wc * 256 + ai * HALF + wr * 64 + m * 16 + fr] = sq; }
                asm volatile("" ::: "memory"); }
        if (hn) {
            asm volatile("s_waitcnt lgkmcnt(0)" ::: "memory"); __builtin_amdgcn_s_barrier(); asm volatile("" ::: "memory");
            const int t = (wr * 4 + wc) * 64 + fq * 16 + fr;
            if (t < 256) { const unsigned idx = list[u.pm * BM + t];
                if (idx & 0x80000000u) ssp[(size_t)u.pn * T + (idx & 0xffffu)] = (xch[t] + xch[256 + t]) + (xch[512 + t] + xch[768 + t]); }
        }
    }
};
}

#define XB_TMO      128
#define XB_XCNT(j)  (256  + 64 * (j))
#define XB_XSUB(j)  (1280 + 64 * (j))
#define XB_XGEN(j)  (2304 + 64 * (j))
#define XB_TOP      3328
#define XB_TOPGEN   3392
#define XCD_BAR_WORDS 3456
#define XB_SPIN_CAP (1u << 21)
__device__ __forceinline__ unsigned xb_ld(unsigned* p)              { return __hip_atomic_load(p, __ATOMIC_RELAXED, __HIP_MEMORY_SCOPE_AGENT); }
__device__ __forceinline__ unsigned xb_add(unsigned* p, unsigned v) { return __hip_atomic_fetch_add(p, v, __ATOMIC_RELAXED, __HIP_MEMORY_SCOPE_AGENT); }
__device__ __forceinline__ unsigned xb_xcc_id() { return (unsigned)__builtin_amdgcn_s_getreg((3 << 11) | 20) & 0xFu; }
#define XB_SPIN(cond, bar) do { unsigned _sp = 0; while (cond) { __builtin_amdgcn_s_sleep(1); \
    if ((++_sp & 255u) == 0u) { if (xb_ld(&(bar)[XB_TMO])) break; if (_sp > XB_SPIN_CAP) { atomicAdd(&(bar)[XB_TMO], 1u); break; } } } } while (0)
struct XcdBarrier { unsigned* bar; unsigned x; volatile LAS unsigned* st; };
__device__ __forceinline__ XcdBarrier xcd_barrier_post(unsigned* bar, volatile LAS unsigned* st) {
    XcdBarrier b; b.bar = bar; b.x = xb_xcc_id(); b.st = st;
    if (threadIdx.x == 0) (void)xb_add(&bar[XB_XCNT(b.x)], 1u);
    return b;
}
__device__ __forceinline__ void xcd_barrier_complete(unsigned* bar, unsigned x, unsigned& nloc, unsigned& nx) {
    const unsigned G = gridDim.x * gridDim.y * gridDim.z;
    unsigned sum, cnt, mine, sp = 0u;
    for (;;) {
        sum = 0u; cnt = 0u; mine = 0u;
#pragma unroll
        for (unsigned j = 0; j < 16; ++j) { const unsigned c = xb_ld(&bar[XB_XCNT(j)]); sum += c; cnt += (c > 0u) ? 1u : 0u; mine = (j == x) ? c : mine; }
        if (sum == G) break;
        __builtin_amdgcn_s_sleep(1);
        if ((++sp & 255u) == 0u) { if (xb_ld(&bar[XB_TMO])) break; if (sp > XB_SPIN_CAP) { atomicAdd(&bar[XB_TMO], 1u); break; } }
    }
    nloc = mine > 0u ? mine : 1u; nx = cnt > 0u ? cnt : 1u;
}
__device__ __forceinline__ void xcd_barrier(const XcdBarrier& b) {
    asm volatile("s_waitcnt vmcnt(0)" ::: "memory");
    __syncthreads();
    if (threadIdx.x == 0) {
        unsigned* bar = b.bar; asm volatile("" : "+s"(bar));
        __builtin_amdgcn_s_waitcnt(0);
        unsigned nloc = b.st[0], nx = b.st[1];
        if (nloc == 0u) { xcd_barrier_complete(bar, b.x, nloc, nx); b.st[0] = nloc; b.st[1] = nx; }
        const unsigned old = xb_add(&bar[XB_XSUB(b.x)], 1u);
        const unsigned gen = old / nloc;
        if (old + 1u == (gen + 1u) * nloc) {
            __builtin_amdgcn_fence(__ATOMIC_RELEASE, "agent");
            asm volatile("s_waitcnt vmcnt(0)" ::: "memory");
            const unsigned og = xb_add(&bar[XB_TOP], 1u);
            const unsigned tg = og / nx;
            if (og + 1u == (tg + 1u) * nx) xb_add(&bar[XB_TOPGEN], 1u);
            else XB_SPIN(xb_ld(&bar[XB_TOPGEN]) == tg, bar);
            __builtin_amdgcn_fence(__ATOMIC_ACQUIRE, "agent");
            xb_add(&bar[XB_XGEN(b.x)], 1u);
            asm volatile("s_waitcnt vmcnt(0)" ::: "memory");
        } else {
            XB_SPIN(xb_ld(&bar[XB_XGEN(b.x)]) == gen, bar);
            __builtin_amdgcn_fence(__ATOMIC_ACQUIRE, "agent");
            asm volatile("s_waitcnt vmcnt(0)" ::: "memory");
        }
    }
    __syncthreads();
}

constexpr size_t MiB = 1u << 20;
constexpr size_t WS_CTL = 0, CTL_ZERO_BYTES = 1 * MiB;
constexpr size_t WS_F2 = 1 * MiB;
constexpr size_t WS_LOGF = 5 * MiB;
constexpr size_t WS_AGG = 9 * MiB;
constexpr size_t WS_TOPE = 13 * MiB;
constexpr size_t WS_TOPW = 13 * MiB + 256 * 1024;
constexpr size_t WS_SMALL = 13 * MiB + 768 * 1024;
constexpr size_t SM_CNT = 0, SM_TILE = 16384, SM_NT = 16384 + 8192, SM_C8 = 16384 + 8192 + 256, SM_T0 = SM_C8 + 4096;
constexpr int CW_QCTR = 2048;
constexpr float SKIP_THR = 64.0f;
constexpr int LISTCAP = 264 * 256;
constexpr size_t WS_LIST = 14 * MiB;
constexpr size_t WS_LISTW = 15 * MiB;
constexpr size_t WS_WL = 16 * MiB;
constexpr size_t WL_IN = 0, WL_G = 4 * MiB, WL_OUT = 5 * MiB, WL_W1 = 8 * MiB, WL_W2 = 22 * MiB;
constexpr size_t WS_WF = 48 * MiB;
constexpr size_t WF_IN = 0, WF_OUT = 9 * MiB, WF_W1 = 11 * MiB, WF_W2 = 123 * MiB;
constexpr size_t WS_SS = 228 * MiB;
constexpr size_t WS_HN = 232 * MiB;
constexpr size_t WS_ACT = 360 * MiB;
constexpr size_t ACT_SLOT = 128 * MiB;
constexpr size_t WS_END = 1000 * MiB;
static_assert(WS_WL + WL_W2 + (size_t)D * FF * 2 <= WS_WF && WS_WF + WF_W2 + (size_t)NE * D * FF * 2 <= WS_SS && WS_SS + 12 * (size_t)T * 4 <= WS_HN && WS_HN + (size_t)T * D * 2 <= WS_ACT && WS_ACT + 5 * ACT_SLOT <= WS_END, "d_ws map");
constexpr int CW_BAR = 4096;

constexpr int RING_BYTES = 131072, MISC_OFF = RING_BYTES + 320, LDS_BYTES = 147456;

struct Args {
    const float* in[24]; float* out; unsigned char* ws; int ph_lo, ph_hi;
};

__device__ __forceinline__ const float* inp(int k) {
    int kk = k; asm volatile("" : "+s"(kk));
    const __attribute__((address_space(4))) unsigned long long* tab = (const __attribute__((address_space(4))) unsigned long long*)__builtin_amdgcn_kernarg_segment_ptr();
    return (const float*)(uintptr_t)tab[kk];
}
struct Frame {
    LAS unsigned char* lds; unsigned char* ldsg;
    int tid, lane, wave, G, vcu, bx;
};

struct CvtJob { const float* src; bf16* dst; int pitch, dpitch; float qs; float f8;    };
__device__ __forceinline__ void cvt_load(const CvtJob& jb, float (&r)[32], int lane) {
    const float* p = jb.src + (size_t)(lane >> 5) * jb.pitch + (lane & 31);
#pragma unroll
    for (int i = 0; i < 32; ++i) r[i] = p[(size_t)(2 * i) * jb.pitch];
#if EMU_FP8
    if (jb.qs != 0.f) {
#pragma unroll
        for (int i = 0; i < 32; ++i) r[i] = q8(r[i], jb.qs); }
#endif
}
__device__ __forceinline__ void cvt_store(const CvtJob& jb, const float (&r)[32], LAS float* scr, int lane) {
#pragma unroll
    for (int i = 0; i < 32; ++i) scr[(2 * i + (lane >> 5)) * 33 + (lane & 31)] = r[i];
    LDS_WAIT(); asm volatile("" ::: "memory");
    const int c = lane & 7;
    if (jb.f8 != 0.f) {
#pragma unroll
        for (int j = 0; j < 4; ++j) { const int n = (lane >> 3) + 8 * j; const LAS float* s = scr + (8 * c) * 33 + n;
            v2u o; o.x = pack4_fp8(s[0 * 33], s[1 * 33], s[2 * 33], s[3 * 33], jb.f8); o.y = pack4_fp8(s[4 * 33], s[5 * 33], s[6 * 33], s[7 * 33], jb.f8);
            *(GAS v2u*)((unsigned char*)jb.dst + (size_t)n * jb.dpitch + 8 * c) = o; }
    } else {
#pragma unroll
    for (int j = 0; j < 4; ++j) { const int n = (lane >> 3) + 8 * j; const LAS float* s = scr + (8 * c) * 33 + n;
        v4u o; o.x = pk2(s[0 * 33], s[1 * 33]); o.y = pk2(s[2 * 33], s[3 * 33]); o.z = pk2(s[4 * 33], s[5 * 33]); o.w = pk2(s[6 * 33], s[7 * 33]);
        *(GAS v4u*)(jb.dst + (size_t)n * jb.dpitch + 8 * c) = o; }
    }
    LDS_WAIT(); asm volatile("" ::: "memory");
}
enum { MAP_NAT = 0, MAP_FOXIN = 1, MAP_GU = 2 };
__device__ __forceinline__ int map_row(int kind, int n0, int half) {
    if (kind == MAP_NAT) return n0;
    if (kind == MAP_FOXIN) { const int tile = n0 >> 8, c = n0 & 255, wc = c >> 6, bj = (c >> 5) & 1; return tile * 256 + bj * 128 + wc * 32; }
    return (n0 >> 7) * 256 + half * 128 + (n0 & 127);
}
__device__ __forceinline__ CvtJob cvt_mk(const float* W, int N, int pitch, bf16* WT, int dpitch, int kind, int half, int drow_base, int idx) {
    const int nblk = N / 32, kb = idx / nblk, nb = idx % nblk;
    CvtJob jb; jb.src = W + (size_t)(64 * kb) * pitch + 32 * nb; jb.dst = WT + (size_t)(drow_base + map_row(kind, 32 * nb, half)) * dpitch + 64 * kb; jb.pitch = pitch; jb.dpitch = dpitch; jb.qs = 0.f; jb.f8 = 0.f; return jb;
}
__device__ __forceinline__ CvtJob cvt_mk8(const float* W, int N, int pitch, unsigned char* WT8, int K, int kind, int half, int drow_base, int idx, float sc) {
    const int nblk = N / 32, kb = idx / nblk, nb = idx % nblk;
    CvtJob jb; jb.src = W + (size_t)(64 * kb) * pitch + 32 * nb; jb.dst = (bf16*)(WT8 + (size_t)(drow_base + map_row(kind, 32 * nb, half)) * K + 64 * kb); jb.pitch = pitch; jb.dpitch = K; jb.qs = 0.f; jb.f8 = sc; return jb;
}
constexpr int CVT_L_TOTAL = 1024 + 128 + 512 + 3 * 1792, CVT_F_TOTAL = 2048 + 512 + NE * 3 * 1792;
__device__ __forceinline__ CvtJob cvt_decode_lru(int it, int j, unsigned char* wreg) {
    bf16* Win_t = (bf16*)(wreg + WL_IN); bf16* Wg_t = (bf16*)(wreg + WL_G); bf16* Wout_t = (bf16*)(wreg + WL_OUT); bf16* W1_t = (bf16*)(wreg + WL_W1); bf16* W2_t = (bf16*)(wreg + WL_W2);
    if (it < 1024) { if (FP8_LRUIN_J1 && j == 1) return cvt_mk8(inp(3) + (size_t)j * D * 2 * D, 2 * D, 2 * D, (unsigned char*)Win_t, D, MAP_NAT, 0, 0, it, 64.f);
        return cvt_mk(inp(3) + (size_t)j * D * 2 * D, 2 * D, 2 * D, Win_t, D, MAP_NAT, 0, 0, it); }
    it -= 1024;
    if (it < 128) { const int m = it >> 3, hb = m >> 1, gx = m & 1; return cvt_mk(inp(gx ? 8 : 6) + ((size_t)j * 8 + hb) * 128 * 128, 128, 128, Wg_t, 128, MAP_NAT, 0, 256 * hb + 128 * gx, it & 7); }
    it -= 128;
    if (it < 512) return cvt_mk(inp(11) + (size_t)j * D * D, D, D, Wout_t, D, MAP_NAT, 0, 0, it);
    it -= 512;
    if (FP8_L2_FFN && j == 1) {
        if (it < 1792) return cvt_mk8(inp(17) + (size_t)j * D * FF, FF, FF, (unsigned char*)W1_t, D, MAP_GU, 0, 0, it, 64.f);
        it -= 1792;
        if (it < 1792) return cvt_mk8(inp(18) + (size_t)j * D * FF, FF, FF, (unsigned char*)W1_t, D, MAP_GU, 1, 0, it, 64.f);
        it -= 1792;
        return cvt_mk8(inp(19) + (size_t)j * FF * D, D, D, (unsigned char*)W2_t, FF, MAP_NAT, 0, 0, it, 128.f);
    }
    if (FP8_L2_FFN && FP8_L0_FFN2 && it >= 2 * 1792) return cvt_mk8(inp(19) + (size_t)j * FF * D, D, D, (unsigned char*)W2_t, FF, MAP_NAT, 0, 0, it - 2 * 1792, 128.f);
    const bool q = (EMU_FP8 >= 2 && j == 1) || EMU_FP8 >= 3;
    if (it < 1792) { CvtJob jb = cvt_mk(inp(17) + (size_t)j * D * FF, FF, FF, W1_t, D, MAP_GU, 0, 0, it); if (q) jb.qs = 64.f; return jb; }
    it -= 1792;
    if (it < 1792) { CvtJob jb = cvt_mk(inp(18) + (size_t)j * D * FF, FF, FF, W1_t, D, MAP_GU, 1, 0, it); if (q) jb.qs = 64.f; return jb; }
    it -= 1792;
    { CvtJob jb = cvt_mk(inp(19) + (size_t)j * FF * D, D, D, W2_t, FF, MAP_NAT, 0, 0, it); if (q) jb.qs = 128.f; return jb; }
}
__device__ __forceinline__ CvtJob cvt_decode_fox(int it, int j, unsigned char* wreg) {
    bf16* Win_t = (bf16*)(wreg + WF_IN); bf16* Wout_t = (bf16*)(wreg + WF_OUT); bf16* W1_t = (bf16*)(wreg + WF_W1); bf16* W2_t = (bf16*)(wreg + WF_W2);
    if (it < 2048) { if (FP8_FOXIN_J1 && (j == 1 || FP8_FOXIN_J0)) return cvt_mk8(inp(12) + (size_t)j * D * (4 * D + NH), 4 * D, 4 * D + NH, (unsigned char*)Win_t, D, MAP_FOXIN, 0, 0, it, 64.f);
        return cvt_mk(inp(12) + (size_t)j * D * (4 * D + NH), 4 * D, 4 * D + NH, Win_t, D, MAP_FOXIN, 0, 0, it); }
    it -= 2048;
    if (it < 512) return cvt_mk(inp(16) + (size_t)j * D * D, D, D, Wout_t, D, MAP_NAT, 0, 0, it);
    it -= 512;
    const int e = it / (3 * 1792), q = it % (3 * 1792), m = q / 1792, idx = q % 1792;
    CvtJob jb;
    if (FP8_LAST_MOE && (j == 1 || FP8_MOE_J0)) {
        if (m == 0) return cvt_mk8(inp(21) + ((size_t)j * NE + e) * D * FF, FF, FF, (unsigned char*)W1_t, D, MAP_GU, 0, e * 2 * FF, idx, 64.f);
        if (m == 1) return cvt_mk8(inp(22) + ((size_t)j * NE + e) * D * FF, FF, FF, (unsigned char*)W1_t, D, MAP_GU, 1, e * 2 * FF, idx, 64.f);
        return cvt_mk8(inp(23) + ((size_t)j * NE + e) * FF * D, D, D, (unsigned char*)W2_t, FF, MAP_NAT, 0, e * D, idx, 128.f);
    }
    if (m == 0) jb = cvt_mk(inp(21) + ((size_t)j * NE + e) * D * FF, FF, FF, W1_t, D, MAP_GU, 0, e * 2 * FF, idx);
    else if (m == 1) jb = cvt_mk(inp(22) + ((size_t)j * NE + e) * D * FF, FF, FF, W1_t, D, MAP_GU, 1, e * 2 * FF, idx);
    else jb = cvt_mk(inp(23) + ((size_t)j * NE + e) * FF * D, D, D, W2_t, FF, MAP_NAT, 0, e * D, idx);
    if ((EMU_FP8 && j == 1) || EMU_FP8 >= 3) jb.qs = (m == 2) ? 128.f : 64.f;
    return jb;
}
template <bool FOX>
__device__ __forceinline__ void cvt_phase(Frame& F, int j, unsigned char* wreg) {
    const int gw = F.vcu * NWAVES + F.wave, NGW = F.G * NWAVES, total = FOX ? CVT_F_TOTAL : CVT_L_TOTAL;
    LAS float* scr = (LAS float*)(F.lds + F.wave * 16384);
    if (gw >= total) return;
    float ra[32], rb[32];
    CvtJob ja = FOX ? cvt_decode_fox(gw, j, wreg) : cvt_decode_lru(gw, j, wreg), jb2 = ja;
    cvt_load(ja, ra, F.lane);
    for (int it = gw; it < total; it += NGW) {
        const int nx = it + NGW; const bool more = nx < total;
        if (more) { jb2 = FOX ? cvt_decode_fox(nx, j, wreg) : cvt_decode_lru(nx, j, wreg); cvt_load(jb2, rb, F.lane); }
        cvt_store(ja, ra, scr, F.lane);
        ja = jb2;
#pragma unroll
        for (int i = 0; i < 32; ++i) ra[i] = rb[i];
    }
}

template <int NP, bool XB16 = false>
__device__ __forceinline__ void norm_phase(Frame& F, const float* xin, const float* gain, bf16* HN, const float* Wp, int wp_pitch,
                                           const float* bfv, float* LOGF, unsigned* TOPE, float* TOPW, unsigned* CNT, float hq = 0.f, xr_t* xcopy = nullptr) {
    LAS float* Wl = (LAS float*)(F.lds);
    LAS int* cnts = (LAS int*)(F.lds + 65536);
    if (NP > 0) {
        for (int idx = F.tid; idx < NP * 1024; idx += NWAVES * 64) { const int c = idx / NP, j = idx % NP; Wl[j * 1024 + c] = Wp[(size_t)c * wp_pitch + j]; }
        if (NP == 8 && F.tid < 16) cnts[F.tid] = 0;
        __syncthreads();
    }
    f32x4 gv[4];
#pragma unroll
    for (int j = 0; j < 4; ++j) gv[j] = *(const f32x4*)(gain + 4 * F.lane + 256 * j);
    const int rbase = F.bx * 256 + F.wave * 32;
    f32x4 vn[4]; v2u vb[4];
    if (XB16) { const GAS v2u* xr = (const GAS v2u*)((const xr_t*)xin + (size_t)rbase * D) + F.lane;
#pragma unroll
      for (int j = 0; j < 4; ++j) vb[j] = xr[64 * j]; }
    else { const GAS f32x4* xr = (const GAS f32x4*)(xin + (size_t)rbase * D) + F.lane;
#pragma unroll
      for (int j = 0; j < 4; ++j) vn[j] = xr[64 * j]; }
    for (int i = 0; i < 32; ++i) {
        const int m = rbase + i;
        f32x4 v[4];
        if (XB16) {
#pragma unroll
            for (int j = 0; j < 4; ++j) { v[j].x = __uint_as_float(vb[j].x << 16); v[j].y = __uint_as_float(vb[j].x & 0xffff0000u); v[j].z = __uint_as_float(vb[j].y << 16); v[j].w = __uint_as_float(vb[j].y & 0xffff0000u); }
            if (i + 1 < 32) { const GAS v2u* xr = (const GAS v2u*)((const xr_t*)xin + (size_t)(m + 1) * D) + F.lane;
#pragma unroll
                for (int j = 0; j < 4; ++j) vb[j] = xr[64 * j]; }
        } else {
#pragma unroll
            for (int j = 0; j < 4; ++j) v[j] = vn[j];
            if (i + 1 < 32) { const GAS f32x4* xr = (const GAS f32x4*)(xin + (size_t)(m + 1) * D) + F.lane;
#pragma unroll
                for (int j = 0; j < 4; ++j) vn[j] = xr[64 * j]; }
            if (xcopy) { GAS v2u* xc = (GAS v2u*)(xcopy + (size_t)m * D) + F.lane;
#pragma unroll
                for (int j = 0; j < 4; ++j) { v2u w; w.x = cvt_pk_bf16(v[j].x, v[j].y); w.y = cvt_pk_bf16(v[j].z, v[j].w); xc[64 * j] = w; } }
        }
        float s = 0.f;
#pragma unroll
        for (int j = 0; j < 4; ++j) s += (v[j].x * v[j].x + v[j].y * v[j].y) + (v[j].z * v[j].z + v[j].w * v[j].w);
        const float rs = 1.0f / __builtin_sqrtf(wave_sum(s) * (1.0f / D) + RMS_EPS);
#pragma unroll
        for (int j = 0; j < 4; ++j) v[j] = v[j] * rs * gv[j];
        GAS unsigned long long* o8 = (GAS unsigned long long*)(HN + (size_t)m * D) + F.lane;
#if EMU_FP8
        if (hq != 0.f) {
#pragma unroll
            for (int j = 0; j < 4; ++j) o8[64 * j] = (unsigned long long)pk2(q8(v[j].x, hq), q8(v[j].y, hq)) | ((unsigned long long)pk2(q8(v[j].z, hq), q8(v[j].w, hq)) << 32);
        } else
#endif
        if (hq < 0.f) {
            GAS unsigned* o4 = (GAS unsigned*)((unsigned char*)HN + (size_t)m * D) + F.lane;
#pragma unroll
            for (int j = 0; j < 4; ++j) o4[64 * j] = pack4_fp8(v[j].x, v[j].y, v[j].z, v[j].w, -hq);
        } else
#pragma unroll
        for (int j = 0; j < 4; ++j) o8[64 * j] = (unsigned long long)pk2(v[j].x, v[j].y) | ((unsigned long long)pk2(v[j].z, v[j].w) << 32);
        if (NP > 0) {
            float mine = 0.f;
#pragma unroll 2
            for (int p = 0; p < NP; ++p) { float a = 0.f;
#pragma unroll
                for (int j = 0; j < 4; ++j) { const f32x4 w = *(const LAS f32x4*)(Wl + p * 1024 + 4 * F.lane + 256 * j); a += (v[j].x * w.x + v[j].y * w.y) + (v[j].z * w.z + v[j].w * w.w); }
                a = wave_sum(a); if (F.lane == p) mine = a; }
            if (NP == 16) {
                if (F.lane < 16) { const float z = mine + bfv[F.lane]; const float ls = fminf(z, 0.f) - log1pf(__expf(-fabsf(z))); LOGF[(size_t)m * 16 + F.lane] = ls; }
            } else {
                float lg[8];
#pragma unroll
                for (int p = 0; p < 8; ++p) lg[p] = __shfl(mine, p);
                int i1 = 0; float l1 = lg[0];
#pragma unroll
                for (int p = 1; p < 8; ++p) if (lg[p] > l1) { l1 = lg[p]; i1 = p; }
                int i2 = (i1 == 0) ? 1 : 0; float l2 = (i1 == 0) ? lg[1] : lg[0];
#pragma unroll
                for (int p = 1; p < 8; ++p) if (p != i1 && lg[p] > l2) { l2 = lg[p]; i2 = p; }
                const float w1 = 1.0f / (1.0f + __expf(l2 - l1)), w2 = 1.0f - w1;
                if (F.lane == 0) { TOPE[m] = (unsigned)i1 | ((unsigned)i2 << 8); TOPW[2 * (size_t)m] = w1; TOPW[2 * (size_t)m + 1] = w2;
                    atomicAdd((int*)&cnts[i1], 1); atomicAdd((int*)&cnts[8 + i2], 1); }
            }
        }
    }
    if (NP == 8) { __syncthreads(); if (F.tid < 16) CNT[F.bx * 16 + F.tid] = (unsigned)cnts[F.tid]; }
    __syncthreads();
}

__device__ __forceinline__ void norm0_phase(Frame& F, const float* xin, const float* gain, bf16* HN, xr_t* XR) {
    f32x4 gv[4];
#pragma unroll
    for (int j = 0; j < 4; ++j) gv[j] = *(const f32x4*)(gain + 4 * F.lane + 256 * j);
    const int rbase = F.bx * 256 + F.wave * 32;
    f32x4 nb[4][4];
#pragma unroll
    for (int r = 0; r < 4; ++r) { const GAS f32x4* xr = (const GAS f32x4*)(xin + (size_t)(rbase + r) * D) + F.lane;
#pragma unroll
        for (int j = 0; j < 4; ++j) nb[r][j] = xr[64 * j]; }
    for (int g = 0; g < 8; ++g) {
        f32x4 v[4][4];
#pragma unroll
        for (int r = 0; r < 4; ++r)
#pragma unroll
            for (int j = 0; j < 4; ++j) v[r][j] = nb[r][j];
        if (g + 1 < 8) {
#pragma unroll
            for (int r = 0; r < 4; ++r) { const GAS f32x4* xr = (const GAS f32x4*)(xin + (size_t)(rbase + 4 * (g + 1) + r) * D) + F.lane;
#pragma unroll
                for (int j = 0; j < 4; ++j) nb[r][j] = xr[64 * j]; } }
        float ss[4];
#pragma unroll
        for (int r = 0; r < 4; ++r) { float s = 0.f;
#pragma unroll
            for (int j = 0; j < 4; ++j) s += (v[r][j].x * v[r][j].x + v[r][j].y * v[r][j].y) + (v[r][j].z * v[r][j].z + v[r][j].w * v[r][j].w);
            ss[r] = s; }
#pragma unroll
        for (int o = 1; o < 64; o <<= 1) {
#pragma unroll
            for (int r = 0; r < 4; ++r) ss[r] += __shfl_xor(ss[r], o); }
#pragma unroll
        for (int r = 0; r < 4; ++r) { const int m = rbase + 4 * g + r;
            const float rs = 1.0f / __builtin_sqrtf(ss[r] * (1.0f / D) + RMS_EPS);
            GAS v2u* xc = (GAS v2u*)(XR + (size_t)m * D) + F.lane; GAS v2u* o8 = (GAS v2u*)(HN + (size_t)m * D) + F.lane;
#pragma unroll
            for (int j = 0; j < 4; ++j) { v2u w; w.x = cvt_pk_bf16(v[r][j].x, v[r][j].y); w.y = cvt_pk_bf16(v[r][j].z, v[r][j].w); xc[64 * j] = w;
                const f32x4 h = v[r][j] * rs * gv[j]; v2u w2; w2.x = pk2(h.x, h.y); w2.y = pk2(h.z, h.w); o8[64 * j] = w2; } }
    }
}

__device__ __forceinline__ void router_phase(Frame& F, const xr_t* xin, const float* gain, unsigned char* HN8, const float* Wp, unsigned* TOPE, float* TOPW, unsigned* CNT, float hs) {
    LAS float* Wl = (LAS float*)(F.lds);
    LAS int* cnts = (LAS int*)(F.lds + 65536);
    for (int idx = F.tid; idx < NE * 1024; idx += NWAVES * 64) { const int c = idx / NE, p = idx % NE; Wl[p * 1024 + c] = Wp[(size_t)c * NE + p] * gain[c]; }
    if (F.tid < 16) cnts[F.tid] = 0;
    __syncthreads();
    f32x4 gv[4];
#pragma unroll
    for (int j = 0; j < 4; ++j) gv[j] = *(const f32x4*)(gain + 4 * F.lane + 256 * j);
    const int rbase = F.bx * 256 + F.wave * 32;
    const bool up1 = (F.lane & 1) != 0, up2 = (F.lane & 2) != 0, up4 = (F.lane & 4) != 0;
    v2u nb[4][4];
#pragma unroll
    for (int r = 0; r < 4; ++r) { const GAS v2u* xr = (const GAS v2u*)(xin + (size_t)(rbase + r) * D) + F.lane;
#pragma unroll
        for (int j = 0; j < 4; ++j) nb[r][j] = xr[64 * j]; }
    for (int g = 0; g < 8; ++g) {
        f32x4 v[4][4];
#pragma unroll
        for (int r = 0; r < 4; ++r)
#pragma unroll
            for (int j = 0; j < 4; ++j) { v[r][j].x = __uint_as_float(nb[r][j].x << 16); v[r][j].y = __uint_as_float(nb[r][j].x & 0xffff0000u); v[r][j].z = __uint_as_float(nb[r][j].y << 16); v[r][j].w = __uint_as_float(nb[r][j].y & 0xffff0000u); }
        if (g + 1 < 8) {
#pragma unroll
            for (int r = 0; r < 4; ++r) { const GAS v2u* xr = (const GAS v2u*)(xin + (size_t)(rbase + 4 * (g + 1) + r) * D) + F.lane;
#pragma unroll
                for (int j = 0; j < 4; ++j) nb[r][j] = xr[64 * j]; } }
        float a[4][8];
#pragma unroll
        for (int p = 0; p < 8; ++p) { f32x4 w[4];
#pragma unroll
            for (int j = 0; j < 4; ++j) w[j] = *(const LAS f32x4*)(Wl + p * 1024 + 4 * F.lane + 256 * j);
#pragma unroll
            for (int r = 0; r < 4; ++r) { float t = 0.f;
#pragma unroll
                for (int j = 0; j < 4; ++j) t += (v[r][j].x * w[j].x + v[r][j].y * w[j].y) + (v[r][j].z * w[j].z + v[r][j].w * w[j].w);
                a[r][p] = t; } }
        float d[4], ss[4];
#pragma unroll
        for (int r = 0; r < 4; ++r) { float s = 0.f;
#pragma unroll
            for (int j = 0; j < 4; ++j) s += (v[r][j].x * v[r][j].x + v[r][j].y * v[r][j].y) + (v[r][j].z * v[r][j].z + v[r][j].w * v[r][j].w);
            ss[r] = s; }
#pragma unroll
        for (int r = 0; r < 4; ++r) { float b4[4], c2[2];
#pragma unroll
            for (int k = 0; k < 4; ++k) { const float snd = up1 ? a[r][k] : a[r][k + 4], kept = up1 ? a[r][k + 4] : a[r][k]; b4[k] = kept + __shfl_xor(snd, 1); }
#pragma unroll
            for (int k = 0; k < 2; ++k) { const float snd = up2 ? b4[k] : b4[k + 2], kept = up2 ? b4[k + 2] : b4[k]; c2[k] = kept + __shfl_xor(snd, 2); }
            { const float snd = up4 ? c2[0] : c2[1], kept = up4 ? c2[1] : c2[0]; d[r] = kept + __shfl_xor(snd, 4); } }
#pragma unroll
        for (int o = 8; o < 64; o <<= 1) {
#pragma unroll
            for (int r = 0; r < 4; ++r) d[r] += __shfl_xor(d[r], o); }
#pragma unroll
        for (int o = 1; o < 64; o <<= 1) {
#pragma unroll
            for (int r = 0; r < 4; ++r) ss[r] += __shfl_xor(ss[r], o); }
#pragma unroll
        for (int r = 0; r < 4; ++r) {
            const int m = rbase + 4 * g + r;
            const float rs = 1.0f / __builtin_sqrtf(ss[r] * (1.0f / D) + RMS_EPS);
            GAS unsigned* o4 = (GAS unsigned*)(HN8 + (size_t)m * D) + F.lane;
#pragma unroll
            for (int j = 0; j < 4; ++j) { const f32x4 h = v[r][j] * rs * gv[j]; o4[64 * j] = pack4_fp8(h.x, h.y, h.z, h.w, hs); }
            float lg[8];
#pragma unroll
            for (int p = 0; p < 8; ++p) lg[p] = __shfl(d[r], (p >> 2) | (((p >> 1) & 1) << 1) | ((p & 1) << 2)) * rs;
            int i1 = 0; float l1 = lg[0];
#pragma unroll
            for (int p = 1; p < 8; ++p) if (lg[p] > l1) { l1 = lg[p]; i1 = p; }
            int i2 = (i1 == 0) ? 1 : 0; float l2 = (i1 == 0) ? lg[1] : lg[0];
#pragma unroll
            for (int p = 1; p < 8; ++p) if (p != i1 && lg[p] > l2) { l2 = lg[p]; i2 = p; }
            const float w1 = 1.0f / (1.0f + __expf(l2 - l1)), w2 = 1.0f - w1;
            if (F.lane == 0) { TOPE[m] = (unsigned)i1 | ((unsigned)i2 << 8); TOPW[2 * (size_t)m] = w1; TOPW[2 * (size_t)m + 1] = w2;
                atomicAdd((int*)&cnts[i1], 1); atomicAdd((int*)&cnts[8 + i2], 1); }
        }
    }
    __syncthreads(); if (F.tid < 16) CNT[F.bx * 16 + F.tid] = (unsigned)cnts[F.tid];
    __syncthreads();
}

__device__ __forceinline__ void split3(float v, unsigned& w01, unsigned& w2) {
    const unsigned t0 = f2bf(v); const float r1 = v - __builtin_bit_cast(float, t0 << 16);
    const unsigned t1 = f2bf(r1); const float r2 = r1 - __builtin_bit_cast(float, t1 << 16);
    w01 = t0 | (t1 << 16); w2 = f2bf(r2);
}
__device__ __forceinline__ void cumsum_phase(Frame& F, const float* LOGF, float* F2, int* T0, bf16* QX, bf16* KX, const float* qg, const float* kg) {
    if (F.bx >= BATCH * NH) return;
    const int b = F.bx >> 4, h = F.bx & 15;
    LAS float* sh = (LAS float*)(F.lds);
    LAS float* Fls = (LAS float*)(F.lds + 1024);
    float mq = fabsf(qg[F.lane]), mk = fabsf(kg[F.lane]);
#pragma unroll
    for (int o = 1; o < 64; o <<= 1) { mq = fmaxf(mq, __shfl_xor(mq, o)); mk = fmaxf(mk, __shfl_xor(mk, o)); }
    const float mfix = 8.0f * mq * mk * LOG2E * 1.02f;
    float v[16]; float run = 0.f;
#pragma unroll
    for (int k = 0; k < 16; ++k) { run += LOGF[((size_t)b * SEQ + 16 * F.tid + k) * 16 + h]; v[k] = run; }
    float inc = run;
#pragma unroll
    for (int o = 1; o < 64; o <<= 1) { const float t = __shfl_up(inc, o); if (F.lane >= o) inc += t; }
    if (F.lane == 63) sh[F.wave] = inc;
    __syncthreads();
    float pre = inc - run;
    for (int w = 0; w < F.wave; ++w) pre += sh[w];
    float* o = F2 + (size_t)F.bx * SEQ + 16 * F.tid;
    v4u* qx = (v4u*)(QX + ((size_t)F.bx * SEQ + 16 * F.tid) * 8); v4u* kx = (v4u*)(KX + ((size_t)F.bx * SEQ + 16 * F.tid) * 16);
#pragma unroll
    for (int k = 0; k < 16; k += 4) { const f32x4 q = (f32x4){(pre + v[k]) * LOG2E, (pre + v[k + 1]) * LOG2E, (pre + v[k + 2]) * LOG2E, (pre + v[k + 3]) * LOG2E};
        *(f32x4*)(o + k) = q; *(LAS f32x4*)(Fls + 16 * F.tid + k) = q;
#pragma unroll
        for (int e = 0; e < 4; ++e) { unsigned a01, a2, b01, b2; split3(q[e] - mfix, a01, a2); split3(-q[e], b01, b2);
            qx[k + e] = (v4u){a01, a2 | 0x3f800000u, 0x3f803f80u, 0u};
            kx[2 * (k + e)] = (v4u){0x3f803f80u, 0x3f80u | (b01 << 16), (b01 >> 16) | (b2 << 16), 0u};
            kx[2 * (k + e) + 1] = (v4u){0u, 0u, 0u, 0u}; } }
    __syncthreads();
    if (F.tid < 32) { const int qb = F.tid; const float target = Fls[256 * qb] + SKIP_THR; int lo_ = 0, hi_ = 4 * qb;
        while (lo_ < hi_) { const int mid = (lo_ + hi_) >> 1; if (Fls[64 * mid + 63] <= target) hi_ = mid; else lo_ = mid + 1; }
        T0[F.bx * 32 + qb] = lo_; }
    __syncthreads();
}

__device__ __forceinline__ void conv_phase(Frame& F, const bf16* XB, const float* cw, const float* cb, bf16* XC) {
    const int gt = F.bx * (NWAVES * 64) + F.tid, cg = gt & 127, c0 = cg * 8;
    float w[4][8], bias[8];
#pragma unroll
    for (int j = 0; j < 4; ++j)
#pragma unroll
        for (int c = 0; c < 8; ++c) w[j][c] = cw[j * D + c0 + c];
#pragma unroll
    for (int c = 0; c < 8; ++c) bias[c] = cb[c0 + c];
    const int nchunk_threads = (F.G * NWAVES * 64) >> 7;
    for (int chunk = gt >> 7; chunk < T / 16; chunk += nchunk_threads) {
        const int t0 = chunk * 16, s0 = t0 & (SEQ - 1);
        float xw[3][8];
#pragma unroll
        for (int r = 0; r < 3; ++r) {
            if (s0 == 0) {
#pragma unroll
                for (int c = 0; c < 8; ++c) xw[r][c] = 0.f;
            } else { const v4u q = *(const v4u*)(XB + (size_t)(t0 - 3 + r) * D + c0);
                xw[r][0] = bflo(q.x); xw[r][1] = bfhi(q.x); xw[r][2] = bflo(q.y); xw[r][3] = bfhi(q.y); xw[r][4] = bflo(q.z); xw[r][5] = bfhi(q.z); xw[r][6] = bflo(q.w); xw[r][7] = bfhi(q.w); }
        }
        v4u qr[16];
#pragma unroll
        for (int i = 0; i < 16; ++i) qr[i] = *(const v4u*)(XB + (size_t)(t0 + i) * D + c0);
#pragma unroll
        for (int i = 0; i < 16; ++i) {
            const v4u q = qr[i];
            float x3[8] = {bflo(q.x), bfhi(q.x), bflo(q.y), bfhi(q.y), bflo(q.z), bfhi(q.z), bflo(q.w), bfhi(q.w)};
            float o[8];
#pragma unroll
            for (int c = 0; c < 8; ++c) o[c] = bias[c] + w[0][c] * xw[0][c] + w[1][c] * xw[1][c] + w[2][c] * xw[2][c] + w[3][c] * x3[c];
            v4u ov; ov.x = pk2(o[0], o[1]); ov.y = pk2(o[2], o[3]); ov.z = pk2(o[4], o[5]); ov.w = pk2(o[6], o[7]);
            *(v4u*)(XC + (size_t)(t0 + i) * D + c0) = ov;
#pragma unroll
            for (int c = 0; c < 8; ++c) { xw[0][c] = xw[1][c]; xw[1][c] = xw[2][c]; xw[2][c] = x3[c]; }
        }
    }
}

constexpr int SCH = 128, NCH = SEQ / SCH;
__device__ __forceinline__ void scan_agg_phase(Frame& F, const unsigned* AB, float* AGG) {
    for (int item = F.bx; item < BATCH * NCH; item += F.G) {
        const size_t t0 = (size_t)item * SCH; const int ch = 2 * F.tid;
        float h0 = 0.f, h1 = 0.f, A0 = 1.f, A1 = 1.f;
        const unsigned* p = AB + t0 * D + ch;
        v2u qa[8], qb[8];
#pragma unroll
        for (int k = 0; k < 8; ++k) qa[k] = *(const v2u*)(p + (size_t)k * D);
        for (int t = 0; t < SCH; t += 16) {
#pragma unroll
            for (int k = 0; k < 8; ++k) qb[k] = *(const v2u*)(p + (size_t)(t + 8 + k) * D);
#pragma unroll
            for (int k = 0; k < 8; ++k) { const float a0 = fast_exp2(bfhi(qa[k].x)), a1 = fast_exp2(bfhi(qa[k].y));
                h0 = a0 * h0 + bflo(qa[k].x); h1 = a1 * h1 + bflo(qa[k].y); A0 *= a0; A1 *= a1; }
            if (t + 16 < SCH) {
#pragma unroll
                for (int k = 0; k < 8; ++k) qa[k] = *(const v2u*)(p + (size_t)(t + 16 + k) * D); }
#pragma unroll
            for (int k = 0; k < 8; ++k) { const float a0 = fast_exp2(bfhi(qb[k].x)), a1 = fast_exp2(bfhi(qb[k].y));
                h0 = a0 * h0 + bflo(qb[k].x); h1 = a1 * h1 + bflo(qb[k].y); A0 *= a0; A1 *= a1; }
        }
        *(f32x4*)(AGG + ((size_t)item * D + ch) * 2) = (f32x4){A0, h0, A1, h1};
    }
}
__device__ __forceinline__ void scan_out_phase(Frame& F, const unsigned* AB, const float* AGG, const bf16* Y, bf16* HY) {
    for (int item = F.bx; item < BATCH * NCH; item += F.G) {
        const int c = item & (NCH - 1); const size_t t0 = (size_t)item * SCH; const int ch = 2 * F.tid;
        float h0 = 0.f, h1 = 0.f;
        const float* ag = AGG + ((size_t)(item - c) * D + ch) * 2;
        const unsigned* p = AB + t0 * D + ch; const bf16* yp = Y + t0 * D + ch; bf16* op = HY + t0 * D + ch;
        v2u qa[8], qb[8]; unsigned ya[8], yb[8];
#pragma unroll
        for (int k = 0; k < 8; ++k) { qa[k] = *(const v2u*)(p + (size_t)k * D); ya[k] = *(const unsigned*)(yp + (size_t)k * D); }
        { int cc = 0;
          for (; cc + 8 <= c; cc += 8) { f32x4 g[8];
#pragma unroll
              for (int k = 0; k < 8; ++k) g[k] = *(const f32x4*)(ag + (size_t)(cc + k) * D * 2);
#pragma unroll
              for (int k = 0; k < 8; ++k) { h0 = g[k].x * h0 + g[k].y; h1 = g[k].z * h1 + g[k].w; } }
          for (; cc < c; ++cc) { const f32x4 g = *(const f32x4*)(ag + (size_t)cc * D * 2); h0 = g.x * h0 + g.y; h1 = g.z * h1 + g.w; } }
        for (int t = 0; t < SCH; t += 16) {
#pragma unroll
            for (int k = 0; k < 8; ++k) { qb[k] = *(const v2u*)(p + (size_t)(t + 8 + k) * D); yb[k] = *(const unsigned*)(yp + (size_t)(t + 8 + k) * D); }
            unsigned oa[8];
#pragma unroll
            for (int k = 0; k < 8; ++k) { const float a0 = fast_exp2(bfhi(qa[k].x)), a1 = fast_exp2(bfhi(qa[k].y));
                h0 = a0 * h0 + bflo(qa[k].x); h1 = a1 * h1 + bflo(qa[k].y); oa[k] = pk2(h0 * bflo(ya[k]), h1 * bfhi(ya[k])); }
            if (t + 16 < SCH) {
#pragma unroll
                for (int k = 0; k < 8; ++k) { qa[k] = *(const v2u*)(p + (size_t)(t + 16 + k) * D); ya[k] = *(const unsigned*)(yp + (size_t)(t + 16 + k) * D); } }
#pragma unroll
            for (int k = 0; k < 8; ++k) *(unsigned*)(op + (size_t)(t + k) * D) = oa[k];
#pragma unroll
            for (int k = 0; k < 8; ++k) { const float a0 = fast_exp2(bfhi(qb[k].x)), a1 = fast_exp2(bfhi(qb[k].y));
                h0 = a0 * h0 + bflo(qb[k].x); h1 = a1 * h1 + bflo(qb[k].y); oa[k] = pk2(h0 * bflo(yb[k]), h1 * bfhi(yb[k])); }
#pragma unroll
            for (int k = 0; k < 8; ++k) *(unsigned*)(op + (size_t)(t + 8 + k) * D) = oa[k];
        }
    }
}

__device__ __forceinline__ void moe_build_phase(Frame& F, const unsigned* TOPE, const float* TOPW, unsigned* CNT, unsigned* LIST, float* LISTW, unsigned* TILE, unsigned* NTL) {
    LAS int* sh = (LAS int*)(F.lds);
    const int bx = F.bx;
    { const int slot = F.tid & 15, grp = F.tid >> 4; int tot = 0, off = 0;
      for (int c = grp; c < F.G; c += 32) { const int v = (int)__hip_atomic_load(CNT + c * 16 + slot, RLX_AGENT); if (c < bx) off += v; tot += v; }
      sh[128 + grp * 16 + slot] = tot; sh[128 + 512 + grp * 16 + slot] = off; }
    __syncthreads();
    if (F.tid < 16) { int tot = 0, off = 0; for (int g2 = 0; g2 < 32; ++g2) { tot += sh[128 + g2 * 16 + F.tid]; off += sh[128 + 512 + g2 * 16 + F.tid]; } sh[F.tid] = tot; sh[16 + F.tid] = off; }
    __syncthreads();
    if (F.tid < 2) { const int p = F.tid; int a = 0; for (int e = 0; e < 8; ++e) { sh[32 + p * 8 + e] = a; a += (sh[p * 8 + e] + 255) & ~255; } sh[48 + p] = a >> 8; }
    __syncthreads();
    const int p = F.tid >> 8, i = F.tid & 255, t = bx * 256 + i;
    const unsigned te = TOPE[t]; const int e = (int)((te >> (8 * p)) & 0xffu); const float w = TOPW[2 * (size_t)t + p];
    int rank = 0;
    const unsigned long long lt = (F.lane == 0) ? 0ull : (~0ull >> (64 - F.lane));
#pragma unroll
    for (int ee = 0; ee < 8; ++ee) { const unsigned long long mk = __ballot(e == ee); if (e == ee) rank = __popcll(mk & lt); if (F.lane == 0) sh[64 + F.wave * 8 + ee] = __popcll(mk); }
    __syncthreads();
    int wpre = 0; for (int w2 = (F.wave & 4); w2 < F.wave; ++w2) wpre += sh[64 + w2 * 8 + e];
    const int pos = sh[32 + p * 8 + e] + sh[16 + p * 8 + e] + wpre + rank;
    LIST[(size_t)p * LISTCAP + pos] = (unsigned)t | 0x80000000u; LISTW[(size_t)p * LISTCAP + pos] = w;
    if (bx < 16) { const int pp = bx >> 3, ee = bx & 7; const int st = sh[32 + pp * 8 + ee], n = sh[pp * 8 + ee], cap = (n + 255) & ~255;
        for (int k = n + F.tid; k < cap; k += NWAVES * 64) { LIST[(size_t)pp * LISTCAP + st + k] = 0u; LISTW[(size_t)pp * LISTCAP + st + k] = 0.f; }
        for (int k = F.tid; k < (cap >> 8); k += NWAVES * 64) TILE[pp * 272 + (st >> 8) + k] = (unsigned)ee;
        if (ee == 0 && F.tid == 0) NTL[pp] = (unsigned)sh[48 + pp]; }
    __syncthreads();
}

namespace fa {
constexpr int KSLOT = 10240, VSLOT = 8192, NKS = 4, NVS = 3;
constexpr int L_K = 0, L_V = NKS * KSLOT, L_WS = L_V + NVS * VSLOT, L_OST = L_WS + NWAVES * 256, L_END = L_OST + NWAVES * 4096;
__device__ __forceinline__ int crow(int r, int hi) { return (r & 3) + 8 * (r >> 2) + 4 * hi; }
__device__ __forceinline__ void glds16(const void* gsrc, unsigned lds_dst) { unsigned keep;
    asm volatile("s_mov_b32 %0, m0\n\ts_mov_b32 m0, %2\n\ts_nop 0\n\tglobal_load_lds_dwordx4 %1, off\n\ts_mov_b32 m0, %0" : "=&s"(keep) : "v"(gsrc), "s"(lds_dst) : "memory"); }
__device__ __forceinline__ void glds16s(const void* sbase, unsigned voff, unsigned lds_dst) { unsigned keep;
    asm volatile("s_mov_b32 %0, m0\n\ts_mov_b32 m0, %3\n\ts_nop 0\n\tglobal_load_lds_dwordx4 %1, %2\n\ts_mov_b32 m0, %0" : "=&s"(keep) : "v"(voff), "s"(sbase), "s"(lds_dst) : "memory"); }
__device__ __forceinline__ void glds4(const void* gsrc, unsigned lds_dst) { unsigned keep;
    asm volatile("s_mov_b32 %0, m0\n\ts_mov_b32 m0, %2\n\ts_nop 0\n\tglobal_load_lds_dword %1, off\n\ts_mov_b32 m0, %0" : "=&s"(keep) : "v"(gsrc), "s"(lds_dst) : "memory"); }
#define FA_WAIT_BAR() asm volatile("s_waitcnt vmcnt(0) lgkmcnt(0)\n\ts_barrier" ::: "memory")

__device__ __forceinline__ void qkt(f32x16& p0, f32x16& p1, const LAS unsigned char* kb, const bf16x8 (&qr)[5]) {
    p0 = f32x16{}; p1 = f32x16{};
#pragma unroll
    for (int d0 = 0; d0 < 5; ++d0) {
        const bf16x8 b0 = *(const LAS bf16x8*)(kb + d0 * 2048);
        const bf16x8 b1 = *(const LAS bf16x8*)(kb + d0 * 2048 + 512);
        p0 = __builtin_amdgcn_mfma_f32_32x32x16_bf16(b0, qr[d0], p0, 0, 0, 0); p1 = __builtin_amdgcn_mfma_f32_32x32x16_bf16(b1, qr[d0], p1, 0, 0, 0); }
}

__device__ __forceinline__ void attn_unit(int b, int h, int qb, const bf16* Q, const bf16* K, const bf16* V, const bf16* Gt, bf16* O, const bf16* QX, const bf16* KX, LAS unsigned char* lds, unsigned lds0, int tid, int t0, gu32* qhead, LAS unsigned* uq) {
    const int lane = tid & 63, r32 = lane & 31, hi = lane >> 5; const int wid = __builtin_amdgcn_readfirstlane(tid >> 6);
    const size_t rowbase = (size_t)b * SEQ; const int q0 = qb * 256; const int bh = b * NH + h;
    const bf16* Qw = Q + (rowbase + q0 + wid * 32) * D + h * HD;
    const bf16* Kh = K + rowbase * D + h * HD; const bf16* Vh = V + rowbase * D + h * HD;
    const int NT = (q0 + 256) / 64;
    t0 -= (NT - t0) & 1;
    const bf16* ksrc = Kh + (size_t)lane * D + wid * 8;
    const bf16* vsrc = Vh + (size_t)(16 * (wid & 3) + (lane >> 2)) * D + (wid >> 2) * 32 + (lane & 3) * 8;
    const bf16* xsrc = KX + ((size_t)bh * SEQ + lane) * 16 + (wid & 1) * 8;
    const unsigned kdst = lds0 + L_K + wid * 1024, vdst = lds0 + L_V + wid * 1024, xdst = lds0 + L_K + 8192 + (wid & 1) * 1024;
#define FA_DMAK(t_) do { const int sk_ = ((t_) % NKS); \
        glds16(ksrc + (size_t)(t_) * 64 * D, (unsigned)__builtin_amdgcn_readfirstlane((int)(kdst + sk_ * KSLOT))); \
        if (wid < 2) glds16(xsrc + (size_t)(t_) * 64 * 16, (unsigned)__builtin_amdgcn_readfirstlane((int)(xdst + sk_ * KSLOT))); } while (0)
#define FA_DMAV(t_) do { const int sv_ = ((t_) % NVS); \
        glds16(vsrc + (size_t)(t_) * 64 * D, (unsigned)__builtin_amdgcn_readfirstlane((int)(vdst + sv_ * VSLOT))); } while (0)
    FA_DMAK(t0); FA_DMAV(t0);
    if (t0 + 1 < NT) FA_DMAK(t0 + 1);
    if (t0 + 2 < NT) FA_DMAK(t0 + 2);
    bf16x8 qr[5];
#pragma unroll
    for (int d0 = 0; d0 < 4; ++d0) qr[d0] = *(const bf16x8*)(Qw + (size_t)r32 * D + d0 * 16 + hi * 8);
    { const bf16x8 qx = *(const bf16x8*)(QX + ((size_t)bh * SEQ + q0 + wid * 32 + r32) * 8); qr[4] = hi ? (bf16x8){0, 0, 0, 0, 0, 0, 0, 0} : qx; }
    f32x16 o[2]; o[0] = f32x16{}; o[1] = f32x16{};
    float lsum = 0.f;
    const int qrel = wid * 32 + r32;
    const LAS unsigned char* kbase = lds + L_K + hi * 1024 + r32 * 16;
    const LAS unsigned char* vbp = lds + L_V + ((lane >> 4) & 1) * 32 + (lane & 3) * 8 + (4 * hi + ((lane & 15) >> 2)) * 64;
    FA_WAIT_BAR();
#define FA_SB() __builtin_amdgcn_sched_barrier(0)
#define FA_EX4(P, B) do { P[B] = fast_exp2(P[B]); P[B + 1] = fast_exp2(P[B + 1]); P[B + 2] = fast_exp2(P[B + 2]); P[B + 3] = fast_exp2(P[B + 3]); asm volatile("" : "+v"(P)); } while (0)
#define FA_KLD(j, T_) do { const LAS unsigned char* kb_ = kbase + ((T_) % NKS) * KSLOT; kf[2 * (j)] = *(const LAS bf16x8*)(kb_ + (j) * 2048); kf[2 * (j) + 1] = *(const LAS bf16x8*)(kb_ + (j) * 2048 + 512); } while (0)
#define FA_MASK(C0, C1, T_) do { if ((T_) >= NT - 4) { const int kb2_ = 64 * (T_) - q0 + 4 * hi; \
        _Pragma("unroll") for (int r = 0; r < 16; ++r) { const int kv = kb2_ + (r & 3) + 8 * (r >> 2); if (kv > qrel) C0[r] = -INFINITY; if (kv + 32 > qrel) C1[r] = -INFINITY; } } } while (0)
#define FA_VRD(i, VB) do { lo[i] = __builtin_bit_cast(s16x4, __builtin_amdgcn_ds_read_tr16_b64_v4i16((LAS s16x4*)((VB) + ((i) >> 2) * 4096 + ((i) & 3) * 1024))); \
        hh[i] = __builtin_bit_cast(s16x4, __builtin_amdgcn_ds_read_tr16_b64_v4i16((LAS s16x4*)((VB) + ((i) >> 2) * 4096 + ((i) & 3) * 1024 + 512))); } while (0)
#define FA_PK(k) (bf16x8){lo[k][0], lo[k][1], lo[k][2], lo[k][3], hh[k][0], hh[k][1], hh[k][2], hh[k][3]}
#define FA_AD4(P, B) do { sacc += (P[B] + P[B + 1]) + (P[B + 2] + P[B + 3]); asm volatile("" : "+v"(sacc)); } while (0)
#define FA_ENDWAIT(T_) do { const int nfl_ = (((T_) + 3 < NT) ? ((wid < 2) ? 2 : 1) : 0) + (((T_) + 1 < NT) ? 1 : 0); \
        if (nfl_ == 3) asm volatile("s_waitcnt vmcnt(3) lgkmcnt(0)\n\ts_barrier" ::: "memory"); \
        else if (nfl_ == 2) asm volatile("s_waitcnt vmcnt(2) lgkmcnt(0)\n\ts_barrier" ::: "memory"); \
        else if (nfl_ == 1) asm volatile("s_waitcnt vmcnt(1) lgkmcnt(0)\n\ts_barrier" ::: "memory"); \
        else FA_WAIT_BAR(); } while (0)
    bf16x8 kf[10];
    f32x16 c0, c1;
    s16x4 lo[8], hh[8]; v4u pw0, pw1, pw2, pw3;
    {
#pragma unroll
        for (int j = 0; j < 5; ++j) FA_KLD(j, t0);
        c0 = f32x16{}; c1 = f32x16{};
#pragma unroll
        for (int d0 = 0; d0 < 5; ++d0) { c0 = __builtin_amdgcn_mfma_f32_32x32x16_bf16(kf[2 * d0], qr[d0], c0, 0, 0, 0); c1 = __builtin_amdgcn_mfma_f32_32x32x16_bf16(kf[2 * d0 + 1], qr[d0], c1, 0, 0, 0); }
        FA_SB();
        if (t0 + 3 < NT) FA_DMAK(t0 + 3);
        if (t0 + 1 < NT) FA_DMAV(t0 + 1);
        FA_MASK(c0, c1, t0);
        FA_EX4(c0, 0); FA_EX4(c0, 4); FA_EX4(c0, 8); FA_EX4(c0, 12); FA_EX4(c1, 0); FA_EX4(c1, 4); FA_EX4(c1, 8); FA_EX4(c1, 12);
        if (t0 + 1 < NT) {
#pragma unroll
            for (int j = 0; j < 3; ++j) FA_KLD(j, t0 + 1);
        }
        FA_SB(); FA_ENDWAIT(t0); FA_SB();
    }
#define FA_STEP(T_, C0, C1, P0, P1) do { \
        const LAS unsigned char* vb = vbp + (((T_) - 1) % NVS) * VSLOT; \
        float sacc = 0.f; \
        FA_VRD(0, vb); FA_SB(); C0 = __builtin_amdgcn_mfma_f32_32x32x16_bf16(kf[0], qr[0], f32x16{}, 0, 0, 0); FA_AD4(P0, 0); pw0.x = cvt_pk_bf16(P0[0], P0[1]); pw0.y = cvt_pk_bf16(P0[2], P0[3]); FA_SB(); \
        FA_VRD(4, vb); FA_SB(); C1 = __builtin_amdgcn_mfma_f32_32x32x16_bf16(kf[1], qr[0], f32x16{}, 0, 0, 0); FA_AD4(P0, 4); pw0.z = cvt_pk_bf16(P0[4], P0[5]); pw0.w = cvt_pk_bf16(P0[6], P0[7]); FA_SB(); \
        FA_KLD(3, (T_)); FA_SB(); \
        FA_VRD(1, vb); FA_SB(); C0 = __builtin_amdgcn_mfma_f32_32x32x16_bf16(kf[2], qr[1], C0, 0, 0, 0); FA_AD4(P0, 8); pw1.x = cvt_pk_bf16(P0[8], P0[9]); pw1.y = cvt_pk_bf16(P0[10], P0[11]); FA_SB(); \
        FA_VRD(5, vb); FA_SB(); C1 = __builtin_amdgcn_mfma_f32_32x32x16_bf16(kf[3], qr[1], C1, 0, 0, 0); FA_AD4(P0, 12); pw1.z = cvt_pk_bf16(P0[12], P0[13]); pw1.w = cvt_pk_bf16(P0[14], P0[15]); FA_SB(); \
        FA_KLD(4, (T_)); FA_SB(); \
        FA_VRD(2, vb); FA_SB(); C0 = __builtin_amdgcn_mfma_f32_32x32x16_bf16(kf[4], qr[2], C0, 0, 0, 0); FA_AD4(P1, 0); pw2.x = cvt_pk_bf16(P1[0], P1[1]); pw2.y = cvt_pk_bf16(P1[2], P1[3]); FA_SB(); \
        FA_VRD(6, vb); FA_SB(); C1 = __builtin_amdgcn_mfma_f32_32x32x16_bf16(kf[5], qr[2], C1, 0, 0, 0); FA_AD4(P1, 4); pw2.z = cvt_pk_bf16(P1[4], P1[5]); pw2.w = cvt_pk_bf16(P1[6], P1[7]); FA_SB(); \
        FA_VRD(3, vb); FA_SB(); C0 = __builtin_amdgcn_mfma_f32_32x32x16_bf16(kf[6], qr[3], C0, 0, 0, 0); FA_AD4(P1, 8); pw3.x = cvt_pk_bf16(P1[8], P1[9]); pw3.y = cvt_pk_bf16(P1[10], P1[11]); FA_SB(); \
        FA_VRD(7, vb); FA_SB(); C1 = __builtin_amdgcn_mfma_f32_32x32x16_bf16(kf[7], qr[3], C1, 0, 0, 0); FA_AD4(P1, 12); pw3.z = cvt_pk_bf16(P1[12], P1[13]); pw3.w = cvt_pk_bf16(P1[14], P1[15]); FA_SB(); \
        C0 = __builtin_amdgcn_mfma_f32_32x32x16_bf16(kf[8], qr[4], C0, 0, 0, 0); \
        C1 = __builtin_amdgcn_mfma_f32_32x32x16_bf16(kf[9], qr[4], C1, 0, 0, 0); FA_SB(); \
        lsum += sacc; \
        if ((T_) + 3 < NT) FA_DMAK((T_) + 3); \
        if ((T_) + 1 < NT) FA_DMAV((T_) + 1); \
        FA_MASK(C0, C1, (T_)); \
        FA_SB(); \
        const bool more = ((T_) + 1 < NT); \
        o[0] = __builtin_amdgcn_mfma_f32_32x32x16_bf16(__builtin_bit_cast(bf16x8, pw0), FA_PK(0), o[0], 0, 0, 0); FA_EX4(C0, 0); FA_SB(); \
        o[1] = __builtin_amdgcn_mfma_f32_32x32x16_bf16(__builtin_bit_cast(bf16x8, pw0), FA_PK(4), o[1], 0, 0, 0); FA_EX4(C0, 4); FA_SB(); \
        if (more) FA_KLD(0, (T_) + 1); FA_SB(); \
        o[0] = __builtin_amdgcn_mfma_f32_32x32x16_bf16(__builtin_bit_cast(bf16x8, pw1), FA_PK(1), o[0], 0, 0, 0); FA_EX4(C0, 8); FA_SB(); \
        if (more) FA_KLD(1, (T_) + 1); FA_SB(); \
        o[1] = __builtin_amdgcn_mfma_f32_32x32x16_bf16(__builtin_bit_cast(bf16x8, pw1), FA_PK(5), o[1], 0, 0, 0); FA_EX4(C0, 12); FA_SB(); \
        if (more) FA_KLD(2, (T_) + 1); FA_SB(); \
        o[0] = __builtin_amdgcn_mfma_f32_32x32x16_bf16(__builtin_bit_cast(bf16x8, pw2), FA_PK(2), o[0], 0, 0, 0); FA_EX4(C1, 0); FA_SB(); \
        o[1] = __builtin_amdgcn_mfma_f32_32x32x16_bf16(__builtin_bit_cast(bf16x8, pw2), FA_PK(6), o[1], 0, 0, 0); FA_EX4(C1, 4); FA_SB(); \
        o[0] = __builtin_amdgcn_mfma_f32_32x32x16_bf16(__builtin_bit_cast(bf16x8, pw3), FA_PK(3), o[0], 0, 0, 0); FA_EX4(C1, 8); FA_SB(); \
        o[1] = __builtin_amdgcn_mfma_f32_32x32x16_bf16(__builtin_bit_cast(bf16x8, pw3), FA_PK(7), o[1], 0, 0, 0); FA_EX4(C1, 12); FA_SB(); \
        FA_ENDWAIT((T_)); FA_SB(); \
    } while (0)
    f32x16 d0, d1;
    int t = t0 + 1;
    FA_STEP(t, d0, d1, c0, c1); ++t;
    for (; t + 1 < NT; t += 2) { FA_STEP(t, c0, c1, d0, d1); FA_STEP(t + 1, d0, d1, c0, c1); }
#undef FA_STEP
    {
        const LAS unsigned char* vb = vbp + ((NT - 1) % NVS) * VSLOT;
#pragma unroll
        for (int i = 0; i < 8; ++i) FA_VRD(i, vb);
        float sacc = 0.f;
        FA_AD4(d0, 0); FA_AD4(d0, 4); FA_AD4(d0, 8); FA_AD4(d0, 12); FA_AD4(d1, 0); FA_AD4(d1, 4); FA_AD4(d1, 8); FA_AD4(d1, 12);
        lsum += sacc;
        pw0 = (v4u){cvt_pk_bf16(d0[0], d0[1]), cvt_pk_bf16(d0[2], d0[3]), cvt_pk_bf16(d0[4], d0[5]), cvt_pk_bf16(d0[6], d0[7])};
        pw1 = (v4u){cvt_pk_bf16(d0[8], d0[9]), cvt_pk_bf16(d0[10], d0[11]), cvt_pk_bf16(d0[12], d0[13]), cvt_pk_bf16(d0[14], d0[15])};
        pw2 = (v4u){cvt_pk_bf16(d1[0], d1[1]), cvt_pk_bf16(d1[2], d1[3]), cvt_pk_bf16(d1[4], d1[5]), cvt_pk_bf16(d1[6], d1[7])};
        pw3 = (v4u){cvt_pk_bf16(d1[8], d1[9]), cvt_pk_bf16(d1[10], d1[11]), cvt_pk_bf16(d1[12], d1[13]), cvt_pk_bf16(d1[14], d1[15])};
        FA_SB();
        o[0] = __builtin_amdgcn_mfma_f32_32x32x16_bf16(__builtin_bit_cast(bf16x8, pw0), FA_PK(0), o[0], 0, 0, 0);
        o[1] = __builtin_amdgcn_mfma_f32_32x32x16_bf16(__builtin_bit_cast(bf16x8, pw0), FA_PK(4), o[1], 0, 0, 0);
        o[0] = __builtin_amdgcn_mfma_f32_32x32x16_bf16(__builtin_bit_cast(bf16x8, pw1), FA_PK(1), o[0], 0, 0, 0);
        o[1] = __builtin_amdgcn_mfma_f32_32x32x16_bf16(__builtin_bit_cast(bf16x8, pw1), FA_PK(5), o[1], 0, 0, 0);
        o[0] = __builtin_amdgcn_mfma_f32_32x32x16_bf16(__builtin_bit_cast(bf16x8, pw2), FA_PK(2), o[0], 0, 0, 0);
        o[1] = __builtin_amdgcn_mfma_f32_32x32x16_bf16(__builtin_bit_cast(bf16x8, pw2), FA_PK(6), o[1], 0, 0, 0);
        o[0] = __builtin_amdgcn_mfma_f32_32x32x16_bf16(__builtin_bit_cast(bf16x8, pw3), FA_PK(3), o[0], 0, 0, 0);
        o[1] = __builtin_amdgcn_mfma_f32_32x32x16_bf16(__builtin_bit_cast(bf16x8, pw3), FA_PK(7), o[1], 0, 0, 0);
        FA_SB();
    }
#undef FA_SB
#undef FA_EX4
#undef FA_KLD
#undef FA_MASK
#undef FA_VRD
#undef FA_PK
#undef FA_AD4
#undef FA_ENDWAIT
#undef FA_DMAK
#undef FA_DMAV
    unsigned nxt_ticket = 0u; if (tid == 0) nxt_ticket = __hip_atomic_fetch_add(qhead, 1u, RLX_AGENT);
    bf16* Ow = O + (rowbase + q0 + wid * 32) * D + h * HD; const bf16* Gw = Gt + (rowbase + q0 + wid * 32) * D + h * HD;
    v4u gq4[4];
#pragma unroll
    for (int i = 0; i < 4; ++i) gq4[i] = *(const v4u*)(Gw + (size_t)(i * 8 + (lane >> 3)) * D + (lane & 7) * 8);
    { auto rr = __builtin_amdgcn_permlane32_swap(__float_as_uint(lsum), __float_as_uint(lsum), false, false); lsum = __uint_as_float(rr[0]) + __uint_as_float(rr[1]); }
    LAS float* wsf = (LAS float*)(lds + L_WS) + wid * 64;
    if (hi == 0) wsf[r32] = lsum;
    asm volatile("s_waitcnt lgkmcnt(0)" ::: "memory");
    float rli[16];
#pragma unroll
    for (int r = 0; r < 16; ++r) rli[r] = fast_rcp(wsf[crow(r, hi)]);
    LAS bf16* stg = (LAS bf16*)(lds + L_OST) + wid * 2048;
#pragma unroll
    for (int r = 0; r < 16; ++r) { const int orow = crow(r, hi);
#pragma unroll
        for (int d0 = 0; d0 < 2; ++d0) stg[orow * 64 + d0 * 32 + r32] = (bf16)f2bf(o[d0][r] * rli[r]); }
    asm volatile("s_waitcnt lgkmcnt(0)" ::: "memory");
#pragma unroll
    for (int i = 0; i < 4; ++i) { const int row = i * 8 + (lane >> 3), chn = lane & 7; const v4u v = *(const LAS v4u*)(stg + row * 64 + chn * 8); const v4u gq = gq4[i];
        v4u w; w.x = pk2(bflo(v.x) * bflo(gq.x), bfhi(v.x) * bfhi(gq.x)); w.y = pk2(bflo(v.y) * bflo(gq.y), bfhi(v.y) * bfhi(gq.y)); w.z = pk2(bflo(v.z) * bflo(gq.z), bfhi(v.z) * bfhi(gq.z)); w.w = pk2(bflo(v.w) * bflo(gq.w), bfhi(v.w) * bfhi(gq.w));
        *(v4u*)(Ow + (size_t)row * D + chn * 8) = w; }
    if (tid == 0) *uq = nxt_ticket;
    FA_WAIT_BAR();
}
}

__device__ __forceinline__ void attn_phase(Frame& F, const bf16* Q, const bf16* K, const bf16* V, const bf16* Gt, bf16* O, const bf16* QX, const bf16* KX, const int* T0, const float* bfv, gu32* qctr) {
    const unsigned lds0 = (unsigned)(uintptr_t)F.ldsg;
    int myrank = 99;
    if (F.lane < NH) { const float mine = bfv[F.lane]; myrank = 0; for (int h2 = 0; h2 < NH; ++h2) { const float o = bfv[h2]; myrank += (o > mine || (o == mine && h2 < F.lane)) ? 1 : 0; } }
    LAS unsigned* uq = (LAS unsigned*)(F.lds + fa::L_END);
    const int x0 = (int)(xb_xcc_id() & 7u);
    LAS int* t0tab = (LAS int*)(F.lds + fa::L_END + 64);
    for (int qi = 0; qi < BATCH; ++qi) {
        const int b = (x0 + qi) & (BATCH - 1);
        __syncthreads();
        t0tab[F.tid] = __hip_atomic_load(T0 + b * NH * 32 + F.tid, RLX_AGENT);
        if (F.tid == 0) *uq = __hip_atomic_fetch_add(qctr + b, 1u, RLX_AGENT);
        __syncthreads();
        for (;;) {
            const int u = __builtin_amdgcn_readfirstlane((int)*uq);
            if (u >= NH * 32) break;
            const int r = u >> 5, qb = 31 - (u & 31);
            const unsigned long long mk_ = __ballot(myrank == r);
            const int h = __builtin_amdgcn_readfirstlane((int)__builtin_ctzll(mk_));
            const int t0 = __builtin_amdgcn_readfirstlane(t0tab[h * 32 + qb]);
            fa::attn_unit(b, h, qb, Q, K, V, Gt, O, QX, KX, F.lds, lds0, F.tid, t0, qctr + b, uq);
        }
    }
}

constexpr int NPH_PAIR = 19, NPH = 2 * NPH_PAIR;
#define OPAQUE_S(x) asm volatile("" : "+s"(x))
__global__ void __launch_bounds__(NWAVES * 64, 2) trunk_fwd(Args args) {
    extern __shared__ __attribute__((aligned(16))) unsigned char lds_raw[];
    const int tid0 = threadIdx.x;
    volatile LAS unsigned* MISC = (volatile LAS unsigned*)((LAS unsigned char*)lds_raw + MISC_OFF);
    for (int u = tid0; u < (LDS_BYTES - RING_BYTES) / 4; u += NWAVES * 64) ((LAS unsigned*)((LAS unsigned char*)lds_raw + RING_BYTES))[u] = 0u;
    __syncthreads();
    const int lo = args.ph_lo, hi = args.ph_hi;
    const bool use_bar = (hi - lo) > 1;
    XcdBarrier bar; bar.bar = (unsigned*)(args.ws + WS_CTL) + CW_BAR; bar.x = 0; bar.st = nullptr;
    if (use_bar) bar = xcd_barrier_post((unsigned*)(args.ws + WS_CTL) + CW_BAR, MISC + 8);

#ifndef PROBE_NULL_EPI
#define PROBE_NULL_EPI 0
#endif
#ifndef PROBE_DUP_MASK
#define PROBE_DUP_MASK 0u
#endif
#define PHASE(k) (lo <= base + (k) && base + (k) < hi)
#define DUP(k) (((PROBE_DUP_MASK) >> (k)) & 1u)
#define PHASE_FOR(k) for (int rep_ = 0; rep_ < (PHASE(k) ? 1 + (int)DUP(k) : 0); ++rep_)
#define SEAM(k) do { if (PHASE(k) && base + (k) + 1 < hi) xcd_barrier(bar); } while (0)
#define PH_BEGIN if (rep_) xcd_barrier(bar); unsigned char* ws = args.ws; OPAQUE_S(ws); int bx = blockIdx.x; OPAQUE_S(bx); float* xo = args.out; OPAQUE_S(xo); \
        Frame F; { int t_ = threadIdx.x; asm volatile("" : "+v"(t_)); F.lds = (LAS unsigned char*)lds_raw; F.ldsg = lds_raw; F.tid = t_; F.lane = t_ & 63; F.wave = __builtin_amdgcn_readfirstlane(t_ >> 6); \
          F.G = gridDim.x; F.bx = bx; F.vcu = (F.G % 8 == 0) ? (bx % 8) * (F.G / 8) + bx / 8 : bx; } \
        unsigned char* act = ws + WS_ACT; unsigned char* wl = ws + WS_WL; unsigned char* wf = ws + WS_WF; unsigned char* small = ws + WS_SMALL; bf16* HN = (bf16*)(ws + WS_HN); (void)act; (void)wl; (void)wf; (void)small; (void)HN; (void)bx; (void)xo;

    for (int j = 0; j < 2; ++j) {
        const int base = j * NPH_PAIR;
        PHASE_FOR(0) { PH_BEGIN
            cvt_phase<false>(F, j, wl);
            cvt_phase<true>(F, j, wf);
            if (bx == 0) { float* C8 = (float*)(small + SM_C8); const float* ll = inp(10) + (size_t)j * D; for (int c = F.tid; c < D; c += NWAVES * 64) { const float L = ll[c]; C8[c] = 8.0f * LOG2E * log1pf(__expf(-L)); } }
            if (bx == 1) { bf16* Wf = (bf16*)(wf + WF_IN) + (size_t)4 * D * D; unsigned char* Wf8 = (unsigned char*)(wf + WF_IN) + (size_t)4 * D * D; const float* src = inp(12) + (size_t)j * D * (4 * D + NH) + 4 * D;
                const bool f8 = FP8_FOXIN_J1 && (j == 1 || FP8_FOXIN_J0);
                for (int k = F.tid; k < D; k += NWAVES * 64) { const f32x4* p = (const f32x4*)(src + (size_t)k * (4 * D + NH));
#pragma unroll
                    for (int q4 = 0; q4 < 4; ++q4) { const f32x4 v = p[q4];
#pragma unroll
                        for (int e = 0; e < 4; ++e) { if (f8) Wf8[(size_t)(4 * q4 + e) * D + k] = (unsigned char)(pack4_fp8(v[e], 0.f, 0.f, 0.f, 64.f) & 0xffu); else Wf[(size_t)(4 * q4 + e) * D + k] = (bf16)f2bf(v[e]); } } } }
            __syncthreads();
            if (j == 0) norm0_phase(F, inp(0), inp(1), HN, (xr_t*)xo);
        }
        SEAM(0);
        PHASE_FOR(1) { PH_BEGIN
            pg8::StaticOrder S; S.init(T / 256, 2 * D / 256, F.G, bx);
            pg8::EpiLruIn E{(bf16*)(act), (bf16*)(act + ACT_SLOT), (j == 0) ? (const float*)nullptr : (const float*)(ws + WS_SS) + 8 * (size_t)T};
            if (FP8_LRUIN_J1 && j == 1) {
                pg8::GemmT<false, false, true> g8{HN, (bf16*)(wl + WL_IN), D / 2, D / 2, D / 128, 0, (long)256 * (D / 2), nullptr, nullptr, 0, 0x7d7d7d7d, 0x79797979};
                pg8::gemm_phase<pg8::EpiLruIn, pg8::StaticOrder, pg8::GemmT<false, false, true>, true>(F.lds, g8, S, E);
            } else {
                pg8::GemmT<false, false> g{HN, (bf16*)(wl + WL_IN), D, D, D / 64, 0, (long)256 * D, nullptr, nullptr, 0};
                pg8::gemm_phase<pg8::EpiLruIn, pg8::StaticOrder, pg8::GemmT<false, false>, true>(F.lds, g, S, E);
            }
        }
        SEAM(1);
        PHASE_FOR(2) { PH_BEGIN
            conv_phase(F, (const bf16*)(act + ACT_SLOT), inp(4) + (size_t)j * 4 * D, inp(5) + (size_t)j * D, (bf16*)(act + 2 * ACT_SLOT)); }
        SEAM(2);
        PHASE_FOR(3) { PH_BEGIN
            bf16* XC = (bf16*)(act + 2 * ACT_SLOT);
            pg8::GemmT<false, false> g{XC, (bf16*)(wl + WL_G), D, 128, 2, 128, (long)256 * 128, nullptr, nullptr, 0};
            pg8::StaticOrder S; S.init(T / 256, 8, F.G, bx);
            pg8::EpiGate E{XC, inp(7) + (size_t)j * D, inp(9) + (size_t)j * D, (const float*)(small + SM_C8), (unsigned*)(act + 3 * ACT_SLOT)};
            pg8::gemm_phase<pg8::EpiGate, pg8::StaticOrder, pg8::GemmT<false, false>, true>(F.lds, g, S, E);
        }
        SEAM(3);
        PHASE_FOR(4) { PH_BEGIN scan_agg_phase(F, (const unsigned*)(act + 3 * ACT_SLOT), (float*)(ws + WS_AGG)); }
        SEAM(4);
        PHASE_FOR(5) { PH_BEGIN scan_out_phase(F, (const unsigned*)(act + 3 * ACT_SLOT), (const float*)(ws + WS_AGG), (const bf16*)(act), (bf16*)(act + ACT_SLOT)); }
        SEAM(5);
        PHASE_FOR(6) { PH_BEGIN
            pg8::GemmT<false, false> g{(bf16*)(act + ACT_SLOT), (bf16*)(wl + WL_OUT), D, D, D / 64, 0, (long)256 * D, nullptr, nullptr, 0};
            pg8::StaticOrder S; S.init(T / 256, D / 256, F.G, bx);
            pg8::EpiResid E{(const xr_t*)xo, (xr_t*)xo, inp(2) + (size_t)(2 * j) * D, HN, (float*)(ws + WS_SS), F.lds, (FP8_L2_FFN && j == 1) ? 4.f : 0.f};
            pg8::gemm_phase<pg8::EpiResid, pg8::StaticOrder, pg8::GemmT<false, false>, true>(F.lds, g, S, E);
        }
        SEAM(6);
        PHASE_FOR(7) { PH_BEGIN
            pg8::StaticOrder S; S.init(T / 256, 2 * FF / 256, F.G, bx);
            if (FP8_L2_FFN && j == 1) {
                pg8::GemmT<false, false, true> g8{HN, (bf16*)(wl + WL_W1), D / 2, D / 2, D / 128, 0, (long)256 * (D / 2), nullptr, nullptr, 0, 0x7d7d7d7d, 0x79797979};
                pg8::EpiSwiglu8 E8{(unsigned char*)(act), FF, 8.f, (const float*)(ws + WS_SS)};
                pg8::gemm_phase<pg8::EpiSwiglu8, pg8::StaticOrder, pg8::GemmT<false, false, true>, true>(F.lds, g8, S, E8);
            } else if (FP8_L2_FFN && FP8_L0_FFN2) {
                pg8::GemmT<false, false> g{HN, (bf16*)(wl + WL_W1), D, D, D / 64, 0, (long)256 * D, nullptr, nullptr, 0};
                pg8::EpiSwiglu8 E8{(unsigned char*)(act), FF, 8.f, (const float*)(ws + WS_SS)};
                pg8::gemm_phase<pg8::EpiSwiglu8, pg8::StaticOrder, pg8::GemmT<false, false>, true>(F.lds, g, S, E8);
            } else {
                pg8::GemmT<false, false> g{HN, (bf16*)(wl + WL_W1), D, D, D / 64, 0, (long)256 * D, nullptr, nullptr, 0};
                pg8::EpiSwiglu E{(bf16*)(act), FF, (const float*)(ws + WS_SS), ((EMU_FP8 >= 2 && j == 1) || EMU_FP8 >= 3) ? 8.f : 0.f};
                pg8::gemm_phase<pg8::EpiSwiglu, pg8::StaticOrder, pg8::GemmT<false, false>, true>(F.lds, g, S, E);
            }
        }
        SEAM(7);
        PHASE_FOR(8) { PH_BEGIN
            pg8::StaticOrder S; S.init(T / 256, D / 256, F.G, bx);
            pg8::EpiResid E{(const xr_t*)xo, (xr_t*)xo, inp(1) + (size_t)(2 * j + 1) * D, HN, (float*)(ws + WS_SS) + 4 * (size_t)T, F.lds, (FP8_FOXIN_J1 && (j == 1 || FP8_FOXIN_J0)) ? 4.f : 0.f};
            if (FP8_L2_FFN && (j == 1 || FP8_L0_FFN2)) {
                pg8::GemmT<false, false, true> g8{(bf16*)(act), (bf16*)(wl + WL_W2), FF / 2, FF / 2, FF / 128, 0, (long)256 * (FF / 2), nullptr, nullptr, 0, 0x7c7c7c7c, 0x78787878};
                pg8::gemm_phase<pg8::EpiResid, pg8::StaticOrder, pg8::GemmT<false, false, true>, true>(F.lds, g8, S, E);
            } else {
                pg8::GemmT<false, false> g{(bf16*)(act), (bf16*)(wl + WL_W2), FF, FF, FF / 64, 0, (long)256 * FF, nullptr, nullptr, 0};
                pg8::gemm_phase<pg8::EpiResid, pg8::StaticOrder, pg8::GemmT<false, false>, true>(F.lds, g, S, E);
            }
        }
        SEAM(8);
        PHASE_FOR(9) { PH_BEGIN
            pg8::GemmT<false, false> g{HN, (bf16*)(wf + WF_IN), D, D, D / 64, 0, (long)256 * D, nullptr, nullptr, 0};
            pg8::StaticOrder S; S.init(T / 256, 4 * D / 256 + 1, F.G, bx);
            pg8::EpiFoxIn E{(bf16*)(act), (size_t)T * D, inp(14) + (size_t)j * HD, inp(15) + (size_t)j * HD, 0.125f * LOG2E, (const float*)(ws + WS_SS) + 4 * (size_t)T, inp(13) + (size_t)j * NH, (float*)(ws + WS_LOGF)};
#if PROBE_NULL_EPI
            if (rep_) { pg8::EpiNull E0{(float*)(ws + WS_AGG)}; pg8::gemm_phase<pg8::EpiNull, pg8::StaticOrder, pg8::GemmT<false, false>, true>(F.lds, g, S, E0); } else
#endif
            if (FP8_FOXIN_J1 && (j == 1 || FP8_FOXIN_J0)) {
                pg8::GemmT<false, false, true> g8{HN, (bf16*)(wf + WF_IN), D / 2, D / 2, D / 128, 0, (long)256 * (D / 2), nullptr, nullptr, 0, 0x7d7d7d7d, 0x79797979};
                pg8::gemm_phase<pg8::EpiFoxIn, pg8::StaticOrder, pg8::GemmT<false, false, true>, true>(F.lds, g8, S, E);
            } else
            pg8::gemm_phase<pg8::EpiFoxIn, pg8::StaticOrder, pg8::GemmT<false, false>, true>(F.lds, g, S, E);
        }
        SEAM(9);
        PHASE_FOR(10) { PH_BEGIN cumsum_phase(F, (const float*)(ws + WS_LOGF), (float*)(ws + WS_F2), (int*)(small + SM_T0), (bf16*)(act + 4 * ACT_SLOT + 32 * MiB), (bf16*)(act + 4 * ACT_SLOT), inp(14) + (size_t)j * HD, inp(15) + (size_t)j * HD); }
        SEAM(10);
        PHASE_FOR(11) { PH_BEGIN attn_phase(F, (const bf16*)(act), (const bf16*)(act + ACT_SLOT), (const bf16*)(act + 2 * ACT_SLOT), (const bf16*)(act + 3 * ACT_SLOT), HN, (const bf16*)(act + 4 * ACT_SLOT + 32 * MiB), (const bf16*)(act + 4 * ACT_SLOT), (const int*)(small + SM_T0), inp(13) + (size_t)j * NH, (gu32*)(ws + WS_CTL) + CW_QCTR + 64 * j + 16 * rep_); }
        SEAM(11);
        PHASE_FOR(12) { PH_BEGIN
            pg8::GemmT<false, false> g{HN, (bf16*)(wf + WF_OUT), D, D, D / 64, 0, (long)256 * D, nullptr, nullptr, 0};
            pg8::StaticOrder S; S.init(T / 256, D / 256, F.G, bx);
            pg8::EpiResid E{(const xr_t*)xo, (xr_t*)xo, nullptr, nullptr, nullptr, F.lds};
            pg8::gemm_phase<pg8::EpiResid, pg8::StaticOrder, pg8::GemmT<false, false>, true>(F.lds, g, S, E);
        }
        SEAM(12);
        PHASE_FOR(13) { PH_BEGIN
            if (FP8_LAST_MOE && (j == 1 || FP8_MOE_J0)) router_phase(F, (const xr_t*)xo, inp(2) + (size_t)(2 * j + 1) * D, (unsigned char*)HN, inp(20) + (size_t)j * D * NE, (unsigned*)(ws + WS_TOPE), (float*)(ws + WS_TOPW), (unsigned*)(small + SM_CNT), 4.f);
            else norm_phase<8, true>(F, xo, inp(2) + (size_t)(2 * j + 1) * D, HN, inp(20) + (size_t)j * D * NE, NE, nullptr, nullptr, (unsigned*)(ws + WS_TOPE), (float*)(ws + WS_TOPW), (unsigned*)(small + SM_CNT), (FP8_LAST_MOE && (j == 1 || FP8_MOE_J0)) ? -4.f : (((EMU_FP8 && j == 1) || EMU_FP8 >= 3) ? 4.f : 0.f)); }
        SEAM(13);
        PHASE_FOR(14) { PH_BEGIN moe_build_phase(F, (const unsigned*)(ws + WS_TOPE), (const float*)(ws + WS_TOPW), (unsigned*)(small + SM_CNT), (unsigned*)(ws + WS_LIST), (float*)(ws + WS_LISTW), (unsigned*)(small + SM_TILE) + j * 2 * 272, (unsigned*)(small + SM_NT) + j * 2); }
        SEAM(14);
#pragma unroll
        for (int p = 0; p < 2; ++p) {
            PHASE_FOR(15 + 2 * p) { PH_BEGIN
                unsigned* TILE = (unsigned*)(small + SM_TILE) + j * 2 * 272 + p * 272; unsigned* NTL = (unsigned*)(small + SM_NT) + j * 2 + p;
                const int ntl = __builtin_amdgcn_readfirstlane((int)__hip_atomic_load(NTL, RLX_AGENT));
                pg8::StaticOrder S; S.init(ntl, 2 * FF / 256, F.G, bx);
                if (FP8_LAST_MOE && (j == 1 || FP8_MOE_J0)) {
                    if (MOE_OVERLAP && p == 1) {
                        const int ntl0 = __builtin_amdgcn_readfirstlane((int)__hip_atomic_load((unsigned*)(small + SM_NT) + j * 2, RLX_AGENT));
                        const int ntail = ntl0 * (D / 256) - 4 * F.G, rnd = (ntl * (2 * FF / 256)) / F.G;
                        if (ntail > 0 && ntail <= F.G / 2 && rnd > 3) S.split(rnd - 3, ntail);
                    }
                    pg8::GemmT<true, true, true> g{HN, (bf16*)(wf + WF_W1), D / 2, D / 2, D / 128, 0, (long)256 * (D / 2), (const unsigned*)(ws + WS_LIST) + (size_t)p * LISTCAP, TILE, (long)2 * FF * (D / 2), 0x7d7d7d7d, 0x79797979};
                    pg8::EpiSwiglu8 E{(unsigned char*)(act) + (MOE_OVERLAP ? (size_t)p * LISTCAP * FF : (size_t)0), FF, 8.f};
                    pg8::gemm_phase<pg8::EpiSwiglu8, pg8::StaticOrder, pg8::GemmT<true, true, true>, true>(F.lds, g, S, E);
                } else {
                    pg8::GemmT<true, true> g{HN, (bf16*)(wf + WF_W1), D, D, D / 64, 0, (long)256 * D, (const unsigned*)(ws + WS_LIST) + (size_t)p * LISTCAP, TILE, (long)2 * FF * D};
                    pg8::EpiSwiglu E{(bf16*)(act), FF, nullptr, ((EMU_FP8 && j == 1) || EMU_FP8 >= 3) ? 8.f : 0.f};
                    pg8::gemm_phase<pg8::EpiSwiglu, pg8::StaticOrder, pg8::GemmT<true, true>, true>(F.lds, g, S, E);
                }
            }
            SEAM(15 + 2 * p);
            PHASE_FOR(16 + 2 * p) { PH_BEGIN
                unsigned* TILE = (unsigned*)(small + SM_TILE) + j * 2 * 272 + p * 272; unsigned* NTL = (unsigned*)(small + SM_NT) + j * 2 + p;
                const int ntl = __builtin_amdgcn_readfirstlane((int)__hip_atomic_load(NTL, RLX_AGENT));
                pg8::StaticOrder S; S.init(ntl, D / 256, F.G, bx);
                const bool fuse = (p == 1) && (j == 0);
                xr_t* XR2 = (xr_t*)(act + 480 * MiB);
                pg8::EpiScatter E{(j == 1 && p == 1) ? (const xr_t*)XR2 : (const xr_t*)xo, (j == 1 && p == 0) ? XR2 : (xr_t*)xo, (j == 1 && p == 1) ? xo : (float*)nullptr, (const unsigned*)(ws + WS_LIST) + (size_t)p * LISTCAP, (const float*)(ws + WS_LISTW) + (size_t)p * LISTCAP,
                                  fuse ? inp(1) + (size_t)(2 * j + 2) * D : (const float*)nullptr, fuse ? HN : (bf16*)nullptr, fuse ? (float*)(ws + WS_SS) + 8 * (size_t)T : (float*)nullptr, F.lds, FP8_LRUIN_J1 ? 4.f : 0.f};
                if (FP8_LAST_MOE && (j == 1 || FP8_MOE_J0)) {
                    pg8::GemmT<false, true, true> g{(bf16*)(act + (MOE_OVERLAP ? (size_t)p * LISTCAP * FF : (size_t)0)), (bf16*)(wf + WF_W2), FF / 2, FF / 2, FF / 128, 0, (long)256 * (FF / 2), nullptr, TILE, (long)D * (FF / 2), 0x7c7c7c7c, 0x78787878};
                    pg8::gemm_phase<pg8::EpiScatter, pg8::StaticOrder, pg8::GemmT<false, true, true>, true>(F.lds, g, S, E);
                } else {
                    pg8::GemmT<false, true> g{(bf16*)(act), (bf16*)(wf + WF_W2), FF, FF, FF / 64, 0, (long)256 * FF, nullptr, TILE, (long)D * FF};
                    pg8::gemm_phase<pg8::EpiScatter, pg8::StaticOrder, pg8::GemmT<false, true>, true>(F.lds, g, S, E);
                }
            }
            if (MOE_OVERLAP && p == 0 && FP8_LAST_MOE && (j == 1 || FP8_MOE_J0)) { if (PHASE(16) && PHASE(17)) __syncthreads(); else SEAM(16); }
            else SEAM(16 + 2 * p);
        }
    }
#undef PHASE
#undef SEAM
#undef PH_BEGIN
}

extern "C" void kernel_launch(void* const* d_in, const int* in_sizes, int n_in, void* d_out, int out_size, void* d_ws, size_t ws_size, hipStream_t stream) {
    static int grid = 0;
    if (grid == 0) {
        if (n_in != 24 || in_sizes[0] != T * D || out_size != T * D || ws_size < WS_END) { fprintf(stderr, "kernel_launch: unexpected problem (n_in %d in0 %d out %d ws %zu)\n", n_in, n_in > 0 ? in_sizes[0] : -1, out_size, ws_size); grid = -1; return; }
        int dev = 0, cus = 0, per_cu = 0;
        if (hipGetDevice(&dev) != hipSuccess || hipDeviceGetAttribute(&cus, hipDeviceAttributeMultiprocessorCount, dev) != hipSuccess) { grid = -1; return; }
        if (hipFuncSetAttribute((const void*)trunk_fwd, hipFuncAttributeMaxDynamicSharedMemorySize, LDS_BYTES) != hipSuccess) { fprintf(stderr, "kernel_launch: hipFuncSetAttribute failed\n"); grid = -1; return; }
        if (hipOccupancyMaxActiveBlocksPerMultiprocessor(&per_cu, (const void*)trunk_fwd, NWAVES * 64, LDS_BYTES) != hipSuccess || per_cu < 1)
            fprintf(stderr, "kernel_launch: occupancy query reports %d workgroups per CU\n", per_cu);
        (void)hipGetLastError();
        grid = cus;
        if (grid != 256) { fprintf(stderr, "kernel_launch: %d CUs; this kernel is built for 256\n", grid); grid = -1; return; }
    }
    if (grid < 0) return;
    if (hipMemsetAsync((char*)d_ws + WS_CTL, 0, CTL_ZERO_BYTES, stream) != hipSuccess) return;
    Args a{};
    for (int i = 0; i < 24; ++i) a.in[i] = (const float*)d_in[i];
    a.out = (float*)d_out; a.ws = (unsigned char*)d_ws;
#if MK_PER_PHASE
    for (int ph = 0; ph < NPH; ++ph) { a.ph_lo = ph; a.ph_hi = ph + 1; hipLaunchKernelGGL(trunk_fwd, dim3(grid), dim3(NWAVES * 64), LDS_BYTES, stream, a); }
#else
    a.ph_lo = 0; a.ph_hi = NPH;
    hipLaunchKernelGGL(trunk_fwd, dim3(grid), dim3(NWAVES * 64), LDS_BYTES, stream, a);
#endif
    const hipError_t le = hipPeekAtLastError();
    if (le != hipSuccess) fprintf(stderr, "kernel_launch: launch failed: %s\n", hipGetErrorName(le));
}
```
